# Optimizing an MI355X kernel written in HIP

```python
import jax, jax.numpy as jnp
from jax import lax
import numpy as np

D_MODEL = 1024
BATCH = 4
SEQ = 4096
DEPTH = 2

SB_HEAD_DIM = 64
SB_HEADS = D_MODEL // 128
SB_WIDTH = SB_HEADS * SB_HEAD_DIM
SB_BLOCK = 128
SSM_GROUP = 16
SSM_WIDTH = D_MODEL // 4
SSM_GROUPS = SSM_WIDTH // SSM_GROUP
SSM_STATE = 64
SSM_DT_MIN = 1e-3
SSM_DT_MAX = 1e-1
SSM_MAX_RE = -1e-4
CONV_WIDTH = D_MODEL // 4
CONV_K = 3
N_BRANCH = 3
IN_SIZES = (SB_WIDTH, SB_WIDTH, SB_WIDTH, SSM_WIDTH, CONV_WIDTH, CONV_WIDTH, CONV_WIDTH, N_BRANCH * D_MODEL)
IN_COLS = sum(IN_SIZES)
IN_SPLITS = [sum(IN_SIZES[:i + 1]) for i in range(len(IN_SIZES) - 1)]
FF_DIM = 7 * D_MODEL // 2
N_EXPERTS = 8
TOP_K = 2
N_DENSE = (DEPTH + 1) // 2
N_MOE = DEPTH // 2
EPS = 1e-6

kernel_name = 'hybrid_sb_s5_shortconv_moe_trunk'


def rms_norm(x, g):
    xf = x.astype(jnp.float32)
    y = xf * lax.rsqrt(jnp.mean(xf * xf, axis=-1, keepdims=True) + EPS)
    return (y * g.astype(jnp.float32)).astype(x.dtype)


def stick_breaking_attention(q, k, v):
    b, l, h, dh = q.shape
    nb = l // SB_BLOCK
    scale = dh ** -0.5
    kt = jnp.transpose(k, (0, 2, 1, 3))
    vt = jnp.transpose(v, (0, 2, 1, 3))
    qb = q.reshape(b, nb, SB_BLOCK, h, dh).transpose(1, 0, 3, 2, 4)
    key_pos = jnp.arange(l)

    def block(args):
        q_blk, blk = args
        z = jnp.einsum('bhqd,bhkd->bhqk', q_blk, kt).astype(jnp.float32) * scale
        q_pos = blk * SB_BLOCK + jnp.arange(SB_BLOCK)
        valid = key_pos[None, :] < q_pos[:, None]
        log_stay = jnp.where(valid, jax.nn.log_sigmoid(-z), 0.0)
        tail = lax.cumsum(log_stay, axis=3, reverse=True) - log_stay
        w = jnp.where(valid, jnp.exp(jax.nn.log_sigmoid(z) + tail), 0.0)
        return jnp.einsum('bhqk,bhkd->bhqd', w.astype(vt.dtype), vt)

    out = lax.map(block, (qb, jnp.arange(nb)))
    return out.transpose(1, 0, 3, 2, 4).reshape(b, l, h * dh)


def s5_ssm(u, lam_re, lam_im, log_dt, b_re, b_im, c_re, c_im, d_skip, w_glu):
    f32 = jnp.float32
    bsz, l, _ = u.shape
    uf = u.astype(f32)
    ug = uf.reshape(bsz, l, SSM_GROUPS, SSM_GROUP)
    lr = jnp.minimum(lam_re.astype(f32), SSM_MAX_RE)
    li = lam_im.astype(f32)
    dt = jnp.exp(log_dt.astype(f32))[:, None]
    mag = jnp.exp(lr * dt)
    ab_re = mag * jnp.cos(li * dt)
    ab_im = mag * jnp.sin(li * dt)
    den = lr * lr + li * li
    nr = ab_re - 1.0
    ni = ab_im
    f_re = (nr * lr + ni * li) / den
    f_im = (ni * lr - nr * li) / den
    br = b_re.astype(f32)
    bi = b_im.astype(f32)
    bb_re = f_re[..., None] * br - f_im[..., None] * bi
    bb_im = f_re[..., None] * bi + f_im[..., None] * br
    bu_re = jnp.einsum('gph,blgh->blgp', bb_re, ug)
    bu_im = jnp.einsum('gph,blgh->blgp', bb_im, ug)
    a_re = jnp.broadcast_to(ab_re, bu_re.shape)
    a_im = jnp.broadcast_to(ab_im, bu_im.shape)

    def combine(left, right):
        a1r, a1i, b1r, b1i = left
        a2r, a2i, b2r, b2i = right
        return (a2r * a1r - a2i * a1i, a2r * a1i + a2i * a1r,
                a2r * b1r - a2i * b1i + b2r, a2r * b1i + a2i * b1r + b2i)

    _, _, s_re, s_im = lax.associative_scan(combine, (a_re, a_im, bu_re, bu_im), axis=1)
    y = (jnp.einsum('ghp,blgp->blgh', c_re.astype(f32), s_re)
         - jnp.einsum('ghp,blgp->blgh', c_im.astype(f32), s_im))
    y = y.reshape(bsz, l, SSM_WIDTH) + d_skip.astype(f32) * uf
    y = jax.nn.gelu(y)
    y = y * jax.nn.sigmoid(y @ w_glu.astype(f32))
    return y.astype(u.dtype)


def short_conv(h, b_gate, c_gate, conv_w):
    u = c_gate * h
    y = lax.conv_general_dilated(u, conv_w[:, None, :].astype(u.dtype), window_strides=(1,),
                                 padding=((CONV_K - 1, 0),),
                                 dimension_numbers=('NWC', 'WIO', 'NWC'),
                                 feature_group_count=CONV_WIDTH)
    return b_gate * y


def hybrid_mixer(xn, w_in, lam_re, lam_im, log_dt, b_re, b_im, c_re, c_im, d_skip, w_glu,
                 conv_w, w_br_a, w_br_b, w_br_c, w_out):
    bsz, l, _ = xn.shape
    proj = xn @ w_in
    q, k, v, u_ssm, h_conv, b_gate, c_gate, gate_logits = jnp.split(proj, IN_SPLITS, axis=-1)
    heads = (bsz, l, SB_HEADS, SB_HEAD_DIM)
    y_a = stick_breaking_attention(q.reshape(heads), k.reshape(heads), v.reshape(heads)) @ w_br_a
    y_b = s5_ssm(u_ssm, lam_re, lam_im, log_dt, b_re, b_im, c_re, c_im, d_skip, w_glu) @ w_br_b
    y_c = short_conv(h_conv, b_gate, c_gate, conv_w) @ w_br_c
    g = jax.nn.sigmoid(gate_logits).reshape(bsz, l, N_BRANCH, D_MODEL)
    merged = g[:, :, 0] * y_a + g[:, :, 1] * y_b + g[:, :, 2] * y_c
    return merged @ w_out


def swiglu(x, w_gate, w_up, w_down):
    return (jax.nn.silu(x @ w_gate) * (x @ w_up)) @ w_down


def moe_swiglu(xn, w_router, w_gate, w_up, w_down):
    logits = (xn @ w_router).astype(jnp.float32)
    top_vals, top_idx = lax.top_k(logits, TOP_K)
    top_w = jax.nn.softmax(top_vals, axis=-1)
    combine = jnp.sum(jax.nn.one_hot(top_idx, N_EXPERTS, dtype=jnp.float32) * top_w[..., None], axis=-2)
    out = jnp.zeros_like(xn)
    for e in range(N_EXPERTS):
        out = out + combine[..., e:e + 1].astype(xn.dtype) * swiglu(xn, w_gate[e], w_up[e], w_down[e])
    return out


def setup_inputs(seed: int = 0) -> dict:
    key = jax.random.key(seed)
    ks = jax.random.split(key, 26)
    f32 = jnp.float32

    def nrm(k, shape, scale):
        return jax.random.normal(k, shape, f32) * scale

    def gain(k, shape):
        return 1.0 + 0.05 * jax.random.normal(k, shape, f32)

    ssm_shape = (DEPTH, SSM_GROUPS, SSM_STATE)
    n_idx = jnp.arange(SSM_STATE, dtype=f32)
    return {
        'x': nrm(ks[0], (BATCH, SEQ, D_MODEL), 1.0),
        'norm_mix': gain(ks[1], (DEPTH, D_MODEL)),
        'w_in': nrm(ks[2], (DEPTH, D_MODEL, IN_COLS), D_MODEL ** -0.5),
        'ssm_lambda_re': -0.5 + 0.01 * jax.random.normal(ks[3], ssm_shape, f32),
        'ssm_lambda_im': jnp.pi * n_idx + 0.01 * jax.random.normal(ks[4], ssm_shape, f32),
        'ssm_log_dt': jax.random.uniform(ks[5], (DEPTH, SSM_GROUPS), f32,
                                         float(np.log(SSM_DT_MIN)), float(np.log(SSM_DT_MAX))),
        'ssm_b_re': nrm(ks[6], (DEPTH, SSM_GROUPS, SSM_STATE, SSM_GROUP), (2 * SSM_GROUP) ** -0.5),
        'ssm_b_im': nrm(ks[7], (DEPTH, SSM_GROUPS, SSM_STATE, SSM_GROUP), (2 * SSM_GROUP) ** -0.5),
        'ssm_c_re': nrm(ks[8], (DEPTH, SSM_GROUPS, SSM_GROUP, SSM_STATE), SSM_STATE ** -0.5),
        'ssm_c_im': nrm(ks[9], (DEPTH, SSM_GROUPS, SSM_GROUP, SSM_STATE), SSM_STATE ** -0.5),
        'ssm_d': nrm(ks[10], (DEPTH, SSM_WIDTH), 1.0),
        'ssm_w_glu': nrm(ks[11], (DEPTH, SSM_WIDTH, SSM_WIDTH), SSM_WIDTH ** -0.5),
        'conv_w': nrm(ks[12], (DEPTH, CONV_K, CONV_WIDTH), CONV_K ** -0.5),
        'w_br_a': nrm(ks[13], (DEPTH, SB_WIDTH, D_MODEL), SB_WIDTH ** -0.5),
        'w_br_b': nrm(ks[14], (DEPTH, SSM_WIDTH, D_MODEL), SSM_WIDTH ** -0.5),
        'w_br_c': nrm(ks[15], (DEPTH, CONV_WIDTH, D_MODEL), CONV_WIDTH ** -0.5),
        'w_out': nrm(ks[16], (DEPTH, D_MODEL, D_MODEL), D_MODEL ** -0.5),
        'norm_ffn': gain(ks[17], (DEPTH, D_MODEL)),
        'dense_w_gate': nrm(ks[18], (N_DENSE, D_MODEL, FF_DIM), D_MODEL ** -0.5),
        'dense_w_up': nrm(ks[19], (N_DENSE, D_MODEL, FF_DIM), D_MODEL ** -0.5),
        'dense_w_down': nrm(ks[20], (N_DENSE, FF_DIM, D_MODEL), FF_DIM ** -0.5),
        'moe_w_router': nrm(ks[21], (N_MOE, D_MODEL, N_EXPERTS), D_MODEL ** -0.5),
        'moe_w_gate': nrm(ks[22], (N_MOE, N_EXPERTS, D_MODEL, FF_DIM), D_MODEL ** -0.5),
        'moe_w_up': nrm(ks[23], (N_MOE, N_EXPERTS, D_MODEL, FF_DIM), D_MODEL ** -0.5),
        'moe_w_down': nrm(ks[24], (N_MOE, N_EXPERTS, FF_DIM, D_MODEL), FF_DIM ** -0.5),
        'final_norm': gain(ks[25], (D_MODEL,)),
    }


def reference(x, norm_mix, w_in, ssm_lambda_re, ssm_lambda_im, ssm_log_dt, ssm_b_re, ssm_b_im,
              ssm_c_re, ssm_c_im, ssm_d, ssm_w_glu, conv_w, w_br_a, w_br_b, w_br_c, w_out,
              norm_ffn, dense_w_gate, dense_w_up, dense_w_down, moe_w_router, moe_w_gate,
              moe_w_up, moe_w_down, final_norm):
    h = x
    for i in range(DEPTH):
        xn = rms_norm(h, norm_mix[i])
        h = h + hybrid_mixer(xn, w_in[i], ssm_lambda_re[i], ssm_lambda_im[i], ssm_log_dt[i],
                             ssm_b_re[i], ssm_b_im[i], ssm_c_re[i], ssm_c_im[i], ssm_d[i],
                             ssm_w_glu[i], conv_w[i], w_br_a[i], w_br_b[i], w_br_c[i], w_out[i])
        xn = rms_norm(h, norm_ffn[i])
        if i % 2 == 0:
            j = i // 2
            h = h + swiglu(xn, dense_w_gate[j], dense_w_up[j], dense_w_down[j])
        else:
            j = i // 2
            h = h + moe_swiglu(xn, moe_w_router[j], moe_w_gate[j], moe_w_up[j], moe_w_down[j])
    return rms_norm(h, final_norm)
```

```cpp
#include <hip/hip_runtime.h>
#include <cstdio>
#include <cstdint>

#ifndef MK_ONE_LAUNCH
#define MK_ONE_LAUNCH 1
#endif

namespace pg8 {
#define PG8_LAS __attribute__((address_space(3)))
typedef unsigned short bf16_t;
typedef short bf16x8 __attribute__((ext_vector_type(8)));
typedef float f32x4 __attribute__((ext_vector_type(4)));
typedef float f32x2 __attribute__((ext_vector_type(2)));
typedef unsigned u32x4 __attribute__((ext_vector_type(4)));
constexpr int BM = 256, BK = 64, HALF = 128, HTB = HALF * BK * 2  , STAGE_BYTES = 8 * HTB, NXCD = 8, WGM = 8;

__host__ __device__ __forceinline__ int lds_byte(int r, int c) { const int st = (r >> 4) * 2 + (c >> 5), rr = r & 15, cc = c & 31, ob = rr * 64 + cc * 2; return st * 1024 + (ob ^ (((ob >> 9) & 1) << 5)); }
__host__ __device__ __forceinline__ void stage_rc(int b, int& R, int& C) { const int st = b / 1024, sb = b % 1024, swz = sb ^ (((sb >> 9) & 1) << 5); R = (st >> 1) * 16 + swz / 64; C = (st & 1) * 32 + (swz % 64) / 2; }
__host__ __device__ __forceinline__ int perm32(int rho) { const int n = rho >> 4, i = rho & 15; return 8 * (i >> 2) + 4 * n + (i & 3); }

struct Unit { int pm, pn; int nt, koff, aux; };
struct Gemm { const bf16_t* A; const bf16_t* Bt; int M, N, K; };

__host__ __device__ __forceinline__ void order_map(int L, int nM, int nN, Unit& u) {
    const int nwg = nM * nN;
    int wgid = L; { const int q = nwg / NXCD, r = nwg % NXCD, xcd = wgid % NXCD, off = wgid / NXCD; wgid = (xcd < r ? xcd * (q + 1) : r * (q + 1) + (xcd - r) * q) + off; }
    const int nig = WGM * nN, gid = wgid / nig, fm = gid * WGM, gsz = (nM - fm) < WGM ? (nM - fm) : WGM;
    u.pm = fm + ((wgid % nig) % gsz); u.pn = (wgid % nig) / gsz;
}
struct StaticOrder {
    static constexpr bool VARK = false;
    int nM, nN, nwg, G, c;
    __host__ __device__ void init(int M, int N, int G_, int c_) { nM = M / BM; nN = N / BM; nwg = nM * nN; G = G_; c = c_; }
    __host__ __device__ bool next(int i, Unit& u) const {
        const long L = (long)i * G + c; if (L >= nwg) return false;
        order_map((int)L, nM, nN, u); u.aux = i; return true;
    }
    __device__ __forceinline__ void a_ready(const Unit&) const {}
    __device__ __forceinline__ void done(const Unit&) const {}
};
typedef __bf16 bf16x2n __attribute__((ext_vector_type(2)));
__device__ __forceinline__ unsigned cvt_pk_bf16(float lo, float hi) { const f32x2 v = {lo, hi}; return __builtin_bit_cast(unsigned, __builtin_convertvector(v, bf16x2n)); }

template <class Epi, class Sched, bool ALIGN_EPI = false, bool SP2 = false, bool FP8 = false>
__device__ __forceinline__ void gemm_phase(PG8_LAS unsigned char* lds, const Gemm g, const Sched& S, const Epi& E) {
    int tid_ = threadIdx.x; asm volatile("" : "+v"(tid_));
    const int tid = tid_, wid = __builtin_amdgcn_readfirstlane(tid >> 6), lane = tid & 63, wr = wid >> 2, wc = wid & 3, fr = lane & 15, fq = lane >> 4;
    const int K = g.K, nt = K / BK;
    unsigned voffA[2], voffB[2];
#pragma unroll
    for (int i = 0; i < 2; ++i) { int R, C; stage_rc(tid * 16 + i * 8192, R, C); const int Rb = Epi::PERM ? ((R & ~31) + perm32(R & 31)) : R;
        voffA[i] = (unsigned)(R * K + C) * 2u; voffB[i] = (unsigned)(Rb * K + C) * 2u; }
    const size_t kstep = (size_t)(BK * 2);
    const size_t hstep = (size_t)HALF * K * 2;
    const size_t tstep = 2 * hstep;
    const unsigned ldsw = (unsigned)wid * 1024u;
    const int aoff = lds_byte(wr * 64 + fr, fq * 8), boff = lds_byte(wc * 32 + fr, fq * 8);
#define PG8_SA(b, h) (((b) * 2 + (h)) * HTB)
#define PG8_SB(b, h) ((4 + (b) * 2 + (h)) * HTB)
#define PG8_STAGE(bufoff, gbase, voff) do { _Pragma("unroll") for (int _i = 0; _i < 2; ++_i) \
        __builtin_amdgcn_global_load_lds((const unsigned*)((const char*)(gbase) + (voff)[_i]), (PG8_LAS unsigned*)(lds + (bufoff) + ldsw + _i * 8192), 16, 0, 0); } while (0)
#define PG8_LDA(dst, b, h) do { _Pragma("unroll") for (int m = 0; m < 4; ++m) { if constexpr (FP8) { dst##w[m] = __builtin_shufflevector(*(const PG8_LAS bf16x8*)(lds + PG8_SA(b, h) + aoff + m * 2048), *(const PG8_LAS bf16x8*)(lds + PG8_SA(b, h) + aoff + m * 2048 + 1024), 0, 1, 2, 3, 4, 5, 6, 7, 8, 9, 10, 11, 12, 13, 14, 15); } \
        else { _Pragma("unroll") for (int k = 0; k < 2; ++k) dst[m][k] = *(const PG8_LAS bf16x8*)(lds + PG8_SA(b, h) + aoff + m * 2048 + k * 1024); } } } while (0)
#define PG8_LDB(dst, b, h) do { _Pragma("unroll") for (int n = 0; n < 2; ++n) { if constexpr (FP8) { dst##w[n] = __builtin_shufflevector(*(const PG8_LAS bf16x8*)(lds + PG8_SB(b, h) + boff + n * 2048), *(const PG8_LAS bf16x8*)(lds + PG8_SB(b, h) + boff + n * 2048 + 1024), 0, 1, 2, 3, 4, 5, 6, 7, 8, 9, 10, 11, 12, 13, 14, 15); } \
        else { _Pragma("unroll") for (int k = 0; k < 2; ++k) dst[n][k] = *(const PG8_LAS bf16x8*)(lds + PG8_SB(b, h) + boff + n * 2048 + k * 1024); } } } while (0)
#define PG8_MMA(ai, bj, At, Bt) do { __builtin_amdgcn_s_setprio(1); _Pragma("unroll") for (int m = 0; m < 4; ++m) _Pragma("unroll") for (int n = 0; n < 2; ++n) { \
        if constexpr (FP8) { typedef int v8i_ __attribute__((ext_vector_type(8))); \
            asm volatile("v_mfma_scale_f32_16x16x128_f8f6f4 %0, %1, %2, %0, %3, %3 op_sel_hi:[0,0,0]" : "+v"(acc[ai][bj][m][n]) : "v"(__builtin_bit_cast(v8i_, Bt##w[n])), "v"(__builtin_bit_cast(v8i_, At##w[m])), "v"(sc8)); } \
        else { _Pragma("unroll") for (int k = 0; k < 2; ++k) acc[ai][bj][m][n] = __builtin_amdgcn_mfma_f32_16x16x32_bf16(Bt[n][k], At[m][k], acc[ai][bj][m][n], 0, 0, 0); } } \
        __builtin_amdgcn_s_setprio(0); } while (0)
#define PG8_WAIT_V(n) asm volatile("s_waitcnt vmcnt(" #n ")" ::: "memory")
#define PG8_WAIT_L(n) asm volatile("s_waitcnt lgkmcnt(" #n ")" ::: "memory")
#define PG8_BAR __builtin_amdgcn_s_barrier()
#define PG8_SCHED __builtin_amdgcn_sched_barrier(0)
    Unit cur, nxt; int ui = 0;
    if (!S.next(0, cur)) return;
    f32x4 acc[2][2][4][2];
#pragma unroll
    for (int a = 0; a < 2; ++a)
#pragma unroll
        for (int b = 0; b < 2; ++b)
#pragma unroll
            for (int m = 0; m < 4; ++m)
#pragma unroll
                for (int n = 0; n < 2; ++n) acc[a][b][m][n] = (f32x4){0.f, 0.f, 0.f, 0.f};
    bf16x8 At[4][2], B0[2][2], B1[2][2];
    typedef short bf16x16_ __attribute__((ext_vector_type(16))); bf16x16_ Atw[4], B0w[2], B1w[2];
    unsigned sc8 = 0x7F7F7F7Fu; asm volatile("" : "+v"(sc8));
    const char* cA = (const char*)g.A + (size_t)cur.pm * tstep; const char* cB = (const char*)g.Bt + (size_t)cur.pn * tstep;
    int cnt = nt;
    if constexpr (Sched::VARK) { cnt = cur.nt; cA += cur.koff; cB += cur.koff; }
    S.a_ready(cur);
    if constexpr (SP2) {
        PG8_STAGE(PG8_SB(0, 0), cB, voffB); PG8_STAGE(PG8_SB(0, 1), cB + hstep, voffB); PG8_STAGE(PG8_SA(0, 0), cA, voffA); PG8_STAGE(PG8_SA(0, 1), cA + hstep, voffA);
        if (wr == 1) PG8_BAR;
        PG8_WAIT_V(2); PG8_BAR;
        PG8_STAGE(PG8_SB(1, 0), cB + kstep, voffB); PG8_STAGE(PG8_SA(1, 0), cA + kstep, voffA); PG8_STAGE(PG8_SB(1, 1), cB + hstep + kstep, voffB);
        PG8_WAIT_V(6); PG8_BAR;
    } else {
        PG8_STAGE(PG8_SB(0, 0), cB, voffB); PG8_STAGE(PG8_SA(0, 0), cA, voffA); PG8_STAGE(PG8_SB(0, 1), cB + hstep, voffB); PG8_STAGE(PG8_SA(0, 1), cA + hstep, voffA);
        if (wr == 1) PG8_BAR;
        PG8_WAIT_V(4); PG8_BAR;
        PG8_STAGE(PG8_SB(1, 0), cB + kstep, voffB); PG8_STAGE(PG8_SA(1, 0), cA + kstep, voffA); PG8_STAGE(PG8_SB(1, 1), cB + hstep + kstep, voffB);
        PG8_WAIT_V(6); PG8_BAR;
    }
    for (;;) {
        const bool has_next = S.next(ui + 1, nxt);
        const char* nA = has_next ? (const char*)g.A + (size_t)nxt.pm * tstep : cA; const char* nB = has_next ? (const char*)g.Bt + (size_t)nxt.pn * tstep : cB;
        if constexpr (Sched::VARK) { if (has_next) { nA += nxt.koff; nB += nxt.koff; } }
        for (int t = 0; t < cnt; t += 2) {
            const bool last = (t == cnt - 2);
            const char* a1 = cA + (size_t)(t + 1) * kstep;
            const char* a2 = last ? nA : cA + (size_t)(t + 2) * kstep; const char* b2 = last ? nB : cB + (size_t)(t + 2) * kstep;
            const char* a3 = a2 + kstep; const char* b3 = b2 + kstep;
            if (last && has_next) S.a_ready(nxt);
            if constexpr (Epi::MIDK) { if (t == Epi::MID0 || t == Epi::MID1) { int tz_ = tid; asm volatile("" : "+v"(tz_)); const int ln_ = tz_ & 63; E.mid(acc, cur, t, wr, wc, ln_ & 15, ln_ >> 4); } }
            if constexpr (SP2) {
            PG8_LDB(B0, 0, 0); PG8_LDB(B1, 0, 1); PG8_SCHED; PG8_LDA(At, 0, 0); PG8_STAGE(PG8_SA(1, 1), a1 + hstep, voffA);
            PG8_WAIT_V(8); PG8_WAIT_L(0); PG8_BAR; PG8_MMA(0, 0, At, B0); PG8_MMA(0, 1, At, B1); PG8_BAR; PG8_SCHED;
            PG8_LDA(At, 0, 1); PG8_STAGE(PG8_SB(0, 0), b2, voffB); PG8_STAGE(PG8_SB(0, 1), b2 + hstep, voffB); PG8_STAGE(PG8_SA(0, 0), a2, voffA);
            PG8_WAIT_V(8); PG8_WAIT_L(0); PG8_BAR; PG8_MMA(1, 0, At, B0); PG8_MMA(1, 1, At, B1); PG8_BAR; PG8_SCHED;
            PG8_LDB(B0, 1, 0); PG8_LDB(B1, 1, 1); PG8_SCHED; PG8_LDA(At, 1, 0); PG8_STAGE(PG8_SA(0, 1), a2 + hstep, voffA);
            PG8_WAIT_V(8); PG8_WAIT_L(0); PG8_BAR; PG8_MMA(0, 0, At, B0); PG8_MMA(0, 1, At, B1); PG8_BAR; PG8_SCHED;
            PG8_LDA(At, 1, 1); PG8_STAGE(PG8_SB(1, 0), b3, voffB); PG8_STAGE(PG8_SB(1, 1), b3 + hstep, voffB); PG8_STAGE(PG8_SA(1, 0), a3, voffA);
            PG8_WAIT_V(8); PG8_WAIT_L(0); PG8_BAR; PG8_MMA(1, 0, At, B0); PG8_MMA(1, 1, At, B1); PG8_BAR; PG8_SCHED;
            } else {
            PG8_LDB(B0, 0, 0); PG8_SCHED; PG8_LDA(At, 0, 0); PG8_STAGE(PG8_SA(1, 1), a1 + hstep, voffA);
            PG8_WAIT_L(8); PG8_BAR; PG8_WAIT_L(0); PG8_MMA(0, 0, At, B0); PG8_BAR; PG8_SCHED;
            PG8_LDB(B1, 0, 1); PG8_STAGE(PG8_SB(0, 0), b2, voffB);
            PG8_BAR; PG8_WAIT_L(0); PG8_MMA(0, 1, At, B1); PG8_BAR;
            PG8_LDA(At, 0, 1); PG8_STAGE(PG8_SA(0, 0), a2, voffA);
            PG8_BAR; PG8_WAIT_L(0); PG8_MMA(1, 0, At, B0); PG8_BAR; PG8_SCHED;
            PG8_STAGE(PG8_SB(0, 1), b2 + hstep, voffB);
            PG8_WAIT_V(6); PG8_BAR; PG8_MMA(1, 1, At, B1); PG8_BAR;
            PG8_LDB(B0, 1, 0); PG8_SCHED; PG8_LDA(At, 1, 0); PG8_STAGE(PG8_SA(0, 1), a2 + hstep, voffA);
            PG8_WAIT_L(8); PG8_BAR; PG8_WAIT_L(0); PG8_MMA(0, 0, At, B0); PG8_BAR; PG8_SCHED;
            PG8_LDB(B1, 1, 1); PG8_STAGE(PG8_SB(1, 0), b3, voffB);
            PG8_BAR; PG8_WAIT_L(0); PG8_MMA(0, 1, At, B1); PG8_BAR;
            PG8_LDA(At, 1, 1); PG8_STAGE(PG8_SA(1, 0), a3, voffA);
            PG8_BAR; PG8_WAIT_L(0); PG8_MMA(1, 0, At, B0); PG8_BAR; PG8_SCHED;
            PG8_STAGE(PG8_SB(1, 1), b3 + hstep, voffB);
            PG8_WAIT_V(6); PG8_BAR; PG8_MMA(1, 1, At, B1); PG8_BAR;
            }
        }
        if constexpr (ALIGN_EPI) { if (wr == 0) PG8_BAR; }
        if constexpr (FP8) asm volatile("s_nop 15\n\ts_nop 15" ::: "memory");
        if constexpr (!Epi::AFTER_DRAIN) { int tz_ = tid; asm volatile("" : "+v"(tz_)); const int ln_ = tz_ & 63;
            E(acc, cur, wr, wc, ln_ & 15, ln_ >> 4); S.done(cur); }
        if (!has_next) break;
#pragma unroll
        for (int a = 0; a < 2; ++a)
#pragma unroll
            for (int b = 0; b < 2; ++b)
#pragma unroll
                for (int m = 0; m < 4; ++m)
#pragma unroll
                    for (int n = 0; n < 2; ++n) acc[a][b][m][n] = (f32x4){0.f, 0.f, 0.f, 0.f};
        cur = nxt; cA = nA; cB = nB; ++ui; if constexpr (Sched::VARK) cnt = cur.nt;
        if constexpr (ALIGN_EPI) { if (wr == 1) PG8_BAR; }
    }
    PG8_WAIT_V(0);
    if constexpr (!ALIGN_EPI) { if (wr == 0) PG8_BAR; }
    PG8_BAR;
    if constexpr (Epi::AFTER_DRAIN) { E.fused(acc, cur, wr, wc, fr, fq, lds, wid, lane); S.done(cur); }
#undef PG8_SA
#undef PG8_SB
#undef PG8_STAGE
#undef PG8_LDA
#undef PG8_LDB
#undef PG8_MMA
#undef PG8_WAIT_V
#undef PG8_WAIT_L
#undef PG8_BAR
#undef PG8_SCHED
}

__device__ __forceinline__ float bfl(unsigned w) { return __uint_as_float(w << 16); }
__device__ __forceinline__ float bfh(unsigned w) { return __uint_as_float(w & 0xffff0000u); }
__device__ __forceinline__ float sigmoid_clamped(float l) { l = fminf(fmaxf(l, -30.f), 30.f); return __builtin_amdgcn_rcpf(1.f + __expf(-l)); }
__device__ __forceinline__ float onepexp_clamped(float l) { l = fminf(fmaxf(l, -30.f), 30.f); return 1.f + __expf(-l); }

__device__ __forceinline__ float sum_fq(float x) {
    { const auto r = __builtin_amdgcn_permlane16_swap(__float_as_uint(x), __float_as_uint(x), false, false); x = __uint_as_float(r[0]) + __uint_as_float(r[1]); }
    { const auto r = __builtin_amdgcn_permlane32_swap(__float_as_uint(x), __float_as_uint(x), false, false); x = __uint_as_float(r[0]) + __uint_as_float(r[1]); }
    return x;
}
__device__ __forceinline__ float row_rstd(const float* ssp, int r, int fq) {
    const f32x4 p4 = *(const f32x4*)(ssp + (size_t)r * 16 + 4 * fq);
    float s = (p4[0] + p4[1]) + (p4[2] + p4[3]);
    s = sum_fq(s);
    return __builtin_amdgcn_rsqf(s * (1.0f / 1024.0f) + 1e-6f);
}
__device__ __forceinline__ void row_rstd8(const float* ssp, int row0, int fq, float (&rs)[2][4]) {
    f32x4 p4[2][4];
#pragma unroll
    for (int ai = 0; ai < 2; ++ai)
#pragma unroll
        for (int m = 0; m < 4; ++m) p4[ai][m] = *(const f32x4*)(ssp + (size_t)(row0 + ai * HALF + m * 16) * 16 + 4 * fq);
#pragma unroll
    for (int ai = 0; ai < 2; ++ai)
#pragma unroll
        for (int m = 0; m < 4; ++m) { float s = (p4[ai][m][0] + p4[ai][m][1]) + (p4[ai][m][2] + p4[ai][m][3]); s = sum_fq(s); rs[ai][m] = __builtin_amdgcn_rsqf(s * (1.0f / 1024.0f) + 1e-6f); }
}
__device__ __forceinline__ void rstd8(const PG8_LAS float* rtab, const float* ssp, const Unit& u, int row0, int rloc, int fq, float (&rs)[2][4]) {
    if (u.aux < 8) {
#pragma unroll
        for (int ai = 0; ai < 2; ++ai)
#pragma unroll
            for (int m = 0; m < 4; ++m) rs[ai][m] = rtab[u.aux * 256 + rloc + ai * HALF + m * 16];
    } else row_rstd8(ssp, row0, fq, rs);
}
struct EpiStoreBf16 {
    static constexpr bool PERM = true, AFTER_DRAIN = false, MIDK = false; static constexpr int MID0 = -1, MID1 = -1;
    bf16_t* O; int ldc; int nct;
    __device__ __forceinline__ void operator()(const f32x4 (&acc)[2][2][4][2], const Unit& u, int wr, int wc, int fr, int fq) const {
        const int row0 = u.pm * BM + wr * 64 + fr, col0 = (u.pn % nct) * BM + wc * 32 + 8 * fq;
#pragma unroll
        for (int ai = 0; ai < 2; ++ai)
#pragma unroll
            for (int m = 0; m < 4; ++m) { bf16_t* rowp = O + (size_t)(row0 + ai * HALF + m * 16) * ldc + col0;
#pragma unroll
                for (int bj = 0; bj < 2; ++bj) { const f32x4 v0 = acc[ai][bj][m][0], v1 = acc[ai][bj][m][1];
                    u32x4 w; w.x = cvt_pk_bf16(v0[0], v0[1]); w.y = cvt_pk_bf16(v0[2], v0[3]); w.z = cvt_pk_bf16(v1[0], v1[1]); w.w = cvt_pk_bf16(v1[2], v1[3]);
                    *(u32x4*)(rowp + bj * HALF) = w; } }
    }
};
struct EpiProj {
    static constexpr bool PERM = true, AFTER_DRAIN = false, MIDK = false; static constexpr int MID0 = -1, MID1 = -1;
    bf16_t* O; int ldc; int gate_tile0; const float* ssp; const PG8_LAS float* rtab; int col_off; float scale;
    __device__ __forceinline__ void operator()(const f32x4 (&acc)[2][2][4][2], const Unit& u, int wr, int wc, int fr, int fq) const {
        const int row0 = u.pm * BM + wr * 64 + fr, col0 = col_off + u.pn * BM + wc * 32 + 8 * fq;
        const bool gate = u.pn >= gate_tile0;
        float rsv[2][4]; rstd8(rtab, ssp, u, row0, wr * 64 + fr, fq, rsv);
#pragma unroll
        for (int ai = 0; ai < 2; ++ai)
#pragma unroll
            for (int m = 0; m < 4; ++m) { bf16_t* rowp = O + (size_t)(row0 + ai * HALF + m * 16) * ldc + col0;
                const float rs = rsv[ai][m] * scale;
                if (gate) { const float k1 = rs * -1.4426950408889634f;
#pragma unroll
                    for (int bj = 0; bj < 2; ++bj) { u32x4 w;
#pragma unroll
                        for (int q = 0; q < 4; ++q) { const f32x2 a2 = {acc[ai][bj][m][q >> 1][2 * (q & 1)], acc[ai][bj][m][q >> 1][2 * (q & 1) + 1]}; const f32x2 t = a2 * k1;
                            const f32x2 ex = {__builtin_amdgcn_exp2f(__builtin_amdgcn_fmed3f(t.x, -43.280851f, 43.280851f)), __builtin_amdgcn_exp2f(__builtin_amdgcn_fmed3f(t.y, -43.280851f, 43.280851f))};
                            const f32x2 o = ex + 1.0f; w[q] = cvt_pk_bf16(o.x, o.y); }
                        *(u32x4*)(rowp + bj * HALF) = w; } }
                else {
#pragma unroll
                    for (int bj = 0; bj < 2; ++bj) { const f32x4 v0 = acc[ai][bj][m][0] * rs, v1 = acc[ai][bj][m][1] * rs;
                        u32x4 w; w.x = cvt_pk_bf16(v0[0], v0[1]); w.y = cvt_pk_bf16(v0[2], v0[3]); w.z = cvt_pk_bf16(v1[0], v1[1]); w.w = cvt_pk_bf16(v1[2], v1[3]);
                        *(u32x4*)(rowp + bj * HALF) = w; } } }
    }
};
__device__ __forceinline__ unsigned pk4_fp8(float a, float b, float c, float d) {
    a = fminf(fmaxf(a, -448.f), 448.f); b = fminf(fmaxf(b, -448.f), 448.f); c = fminf(fmaxf(c, -448.f), 448.f); d = fminf(fmaxf(d, -448.f), 448.f);
    int p = __builtin_amdgcn_cvt_pk_fp8_f32(a, b, 0, false); p = __builtin_amdgcn_cvt_pk_fp8_f32(c, d, p, true); return (unsigned)p;
}
struct EpiSwiglu8 {
    static constexpr bool PERM = true, AFTER_DRAIN = false, MIDK = false; static constexpr int MID0 = -1, MID1 = -1;
    unsigned char* O; int ldc; int nct; float k1, cden;
    __device__ __forceinline__ void operator()(const f32x4 (&acc)[2][2][4][2], const Unit& u, int wr, int wc, int fr, int fq) const {
        const int row0 = u.pm * BM + wr * 64 + fr, col0 = (u.pn % nct) * HALF + wc * 32 + 8 * fq;
#pragma unroll
        for (int ai = 0; ai < 2; ++ai)
#pragma unroll
            for (int m = 0; m < 4; ++m) { unsigned char* rowp = O + (size_t)(row0 + ai * HALF + m * 16) * ldc + col0;
                float r[8];
#pragma unroll
                for (int n = 0; n < 2; ++n)
#pragma unroll
                    for (int h = 0; h < 2; ++h) { const f32x2 g2 = {acc[ai][0][m][n][2 * h], acc[ai][0][m][n][2 * h + 1]}, u2 = {acc[ai][1][m][n][2 * h], acc[ai][1][m][n][2 * h + 1]};
                        const f32x2 t = g2 * k1; const f32x2 ex = {__builtin_amdgcn_exp2f(t.x), __builtin_amdgcn_exp2f(t.y)}; const f32x2 d = ex * cden + cden;
                        const f32x2 rr = {__builtin_amdgcn_rcpf(d.x), __builtin_amdgcn_rcpf(d.y)}; const f32x2 o = (g2 * u2) * rr; r[n * 4 + 2 * h] = o.x; r[n * 4 + 2 * h + 1] = o.y; }
                typedef unsigned u32x2v __attribute__((ext_vector_type(2))); u32x2v w; w.x = pk4_fp8(r[0], r[1], r[2], r[3]); w.y = pk4_fp8(r[4], r[5], r[6], r[7]);
                *(u32x2v*)rowp = w; }
    }
};
struct EpiMoeDown {
    static constexpr bool PERM = true, AFTER_DRAIN = false, MIDK = false; static constexpr int MID0 = -1, MID1 = -1;
    bf16_t* O; int ldc; int nct; bf16_t* O2; float scale;
    __device__ __forceinline__ void operator()(const f32x4 (&acc)[2][2][4][2], const Unit& u, int wr, int wc, int fr, int fq) const {
        const bool second = u.aux >= 0;
        bf16_t* base = second ? O2 + (size_t)u.aux * 65536 + (size_t)(wr * 64 + fr) * 256 + wc * 32 + 8 * fq
                              : O + (size_t)(u.pm * BM + wr * 64 + fr) * ldc + (u.pn % nct) * BM + wc * 32 + 8 * fq;
        const int ld = second ? 256 : ldc;
#pragma unroll
        for (int ai = 0; ai < 2; ++ai)
#pragma unroll
            for (int m = 0; m < 4; ++m) { bf16_t* rowp = base + (size_t)(ai * HALF + m * 16) * ld;
#pragma unroll
                for (int bj = 0; bj < 2; ++bj) { const f32x4 v0 = acc[ai][bj][m][0] * scale, v1 = acc[ai][bj][m][1] * scale;
                    u32x4 w; w.x = cvt_pk_bf16(v0[0], v0[1]); w.y = cvt_pk_bf16(v0[2], v0[3]); w.z = cvt_pk_bf16(v1[0], v1[1]); w.w = cvt_pk_bf16(v1[2], v1[3]);
                    *(u32x4*)(rowp + bj * HALF) = w; } }
    }
};
template <int NORMOUT, bool BASE16> struct EpiResid {
    static constexpr bool PERM = true, AFTER_DRAIN = false, MIDK = false; static constexpr int MID0 = -1, MID1 = -1;
    const void* base; bf16_t* hb; int ldc; float* ssp; unsigned char* hb8; float hb8_scale;
    __device__ __forceinline__ void row_out(const f32x4 (&o)[2][2], size_t off, int r, int pn, int wc, int fq) const {
        float q = 0.f;
#pragma unroll
        for (int bj = 0; bj < 2; ++bj) { const f32x4 o0 = o[bj][0], o1 = o[bj][1];
            if (NORMOUT & 1) q += ((o0[0] * o0[0] + o0[1] * o0[1]) + (o0[2] * o0[2] + o0[3] * o0[3])) + ((o1[0] * o1[0] + o1[1] * o1[1]) + (o1[2] * o1[2] + o1[3] * o1[3]));
            u32x4 w; w.x = cvt_pk_bf16(o0[0], o0[1]); w.y = cvt_pk_bf16(o0[2], o0[3]); w.z = cvt_pk_bf16(o1[0], o1[1]); w.w = cvt_pk_bf16(o1[2], o1[3]); *(u32x4*)(hb + off + bj * HALF) = w;
            if (NORMOUT & 2) { typedef unsigned u32x2v __attribute__((ext_vector_type(2))); u32x2v w8; w8.x = pk4_fp8(o0[0] * hb8_scale, o0[1] * hb8_scale, o0[2] * hb8_scale, o0[3] * hb8_scale); w8.y = pk4_fp8(o1[0] * hb8_scale, o1[1] * hb8_scale, o1[2] * hb8_scale, o1[3] * hb8_scale); *(u32x2v*)(hb8 + off + bj * HALF) = w8; } }
        if (NORMOUT & 1) { q = sum_fq(q); if (fq == 0) ssp[(size_t)r * 16 + 4 * pn + wc] = q; }
    }
    __device__ __forceinline__ void operator()(const f32x4 (&acc)[2][2][4][2], const Unit& u, int wr, int wc, int fr, int fq) const {
        const int row0 = u.pm * BM + wr * 64 + fr, col0 = u.pn * BM + wc * 32 + 8 * fq;
        if constexpr (BASE16) { const bf16_t* b16 = (const bf16_t*)base;
#pragma unroll
            for (int ai = 0; ai < 2; ++ai) { u32x4 bs[4][2];
#pragma unroll
                for (int m = 0; m < 4; ++m)
#pragma unroll
                    for (int bj = 0; bj < 2; ++bj) bs[m][bj] = *(const u32x4*)(b16 + (size_t)(row0 + ai * HALF + m * 16) * ldc + col0 + bj * HALF);
#pragma unroll
                for (int m = 0; m < 4; ++m) { const int r = row0 + ai * HALF + m * 16; f32x4 o[2][2];
#pragma unroll
                    for (int bj = 0; bj < 2; ++bj) { const u32x4 b = bs[m][bj];
                        o[bj][0] = (f32x4){bfl(b.x), bfh(b.x), bfl(b.y), bfh(b.y)} + acc[ai][bj][m][0]; o[bj][1] = (f32x4){bfl(b.z), bfh(b.z), bfl(b.w), bfh(b.w)} + acc[ai][bj][m][1]; }
                    row_out(o, (size_t)r * ldc + col0, r, u.pn, wc, fq); }
                asm volatile("" ::: "memory"); }
        } else { const float* b32 = (const float*)base;
#pragma unroll
            for (int ai = 0; ai < 2; ++ai)
#pragma unroll
                for (int mp = 0; mp < 2; ++mp) { f32x4 bs[2][2][2];
#pragma unroll
                    for (int mm = 0; mm < 2; ++mm) { const size_t off = (size_t)(row0 + ai * HALF + (2 * mp + mm) * 16) * ldc + col0;
#pragma unroll
                        for (int bj = 0; bj < 2; ++bj)
#pragma unroll
                            for (int n = 0; n < 2; ++n) bs[mm][bj][n] = *(const f32x4*)(b32 + off + bj * HALF + n * 4); }
#pragma unroll
                    for (int mm = 0; mm < 2; ++mm) { const int r = row0 + ai * HALF + (2 * mp + mm) * 16; f32x4 o[2][2];
#pragma unroll
                        for (int bj = 0; bj < 2; ++bj) { o[bj][0] = bs[mm][bj][0] + acc[ai][bj][2 * mp + mm][0]; o[bj][1] = bs[mm][bj][1] + acc[ai][bj][2 * mp + mm][1]; }
                        row_out(o, (size_t)r * ldc + col0, r, u.pn, wc, fq); }
                    asm volatile("" ::: "memory"); }
        }
    }
};
template <bool RS> struct EpiSwiglu {
    static constexpr bool PERM = true, AFTER_DRAIN = false, MIDK = false; static constexpr int MID0 = -1, MID1 = -1;
    bf16_t* O; int ldc; int nct; const float* ssp; const PG8_LAS float* rtab;
    __device__ __forceinline__ void operator()(const f32x4 (&acc)[2][2][4][2], const Unit& u, int wr, int wc, int fr, int fq) const {
        const int row0 = u.pm * BM + wr * 64 + fr, col0 = (u.pn % nct) * HALF + wc * 32 + 8 * fq;
        float rsv[2][4]; if (RS) rstd8(rtab, ssp, u, row0, wr * 64 + fr, fq, rsv);
#pragma unroll
        for (int ai = 0; ai < 2; ++ai)
#pragma unroll
            for (int m = 0; m < 4; ++m) { bf16_t* rowp = O + (size_t)(row0 + ai * HALF + m * 16) * ldc + col0;
                float r[8]; float rs = 1.f; if (RS) rs = rsv[ai][m];
                const float k1 = rs * -1.4426950408889634f, cden = RS ? __builtin_amdgcn_rcpf(rs * rs) : 1.f;
#pragma unroll
                for (int n = 0; n < 2; ++n)
#pragma unroll
                    for (int h = 0; h < 2; ++h) { const f32x2 g2 = {acc[ai][0][m][n][2 * h], acc[ai][0][m][n][2 * h + 1]}, u2 = {acc[ai][1][m][n][2 * h], acc[ai][1][m][n][2 * h + 1]};
                        const f32x2 t = g2 * k1; const f32x2 ex = {__builtin_amdgcn_exp2f(t.x), __builtin_amdgcn_exp2f(t.y)}; const f32x2 d = ex * cden + cden;
                        const f32x2 rr = {__builtin_amdgcn_rcpf(d.x), __builtin_amdgcn_rcpf(d.y)}; const f32x2 o = (g2 * u2) * rr; r[n * 4 + 2 * h] = o.x; r[n * 4 + 2 * h + 1] = o.y; }
                u32x4 w; w.x = cvt_pk_bf16(r[0], r[1]); w.y = cvt_pk_bf16(r[2], r[3]); w.z = cvt_pk_bf16(r[4], r[5]); w.w = cvt_pk_bf16(r[6], r[7]);
                *(u32x4*)rowp = w; }
    }
};
struct EpiBranch {
    static constexpr bool PERM = true, AFTER_DRAIN = false, MIDK = true; static constexpr int MID0 = 8, MID1 = 12;
    const bf16_t* G; int ldg; bf16_t* O; int ldc;
    __device__ __forceinline__ void mid(f32x4 (&acc)[2][2][4][2], const Unit& u, int t, int wr, int wc, int fr, int fq) const {
        int row0 = u.pm * BM + wr * 64 + fr, col0 = u.pn * BM + wc * 32 + 8 * fq;
        asm volatile("" : "+v"(row0), "+v"(col0));
        const bf16_t* gp = G + (t == MID0 ? 0 : 1024);
        u32x4 ld_[2][2][2], ln_[2][2][2];
#define BR_LOAD(bf, ai, mp) do { _Pragma("unroll") for (int mm = 0; mm < 2; ++mm) { const bf16_t* rp = gp + (size_t)(row0 + (ai) * HALF + (2 * (mp) + mm) * 16) * ldg + col0; \
            _Pragma("unroll") for (int bj = 0; bj < 2; ++bj) { ld_[bf][mm][bj] = *(const u32x4*)(rp + bj * HALF); ln_[bf][mm][bj] = *(const u32x4*)(rp + bj * HALF + 1024); } } } while (0)
#define BR_APPLY(bf, ai, mp) do { _Pragma("unroll") for (int mm = 0; mm < 2; ++mm) _Pragma("unroll") for (int bj = 0; bj < 2; ++bj) _Pragma("unroll") for (int q = 0; q < 4; ++q) { \
            const unsigned dw = ld_[bf][mm][bj][q], nw = ln_[bf][mm][bj][q];        \
            const f32x2 rd = {__builtin_amdgcn_rcpf(bfl(dw)), __builtin_amdgcn_rcpf(bfh(dw))}, nm = {bfl(nw), bfh(nw)}; const f32x2 ra = nm * rd; \
            acc[ai][bj][2 * (mp) + mm][q >> 1][2 * (q & 1)] *= ra.x; acc[ai][bj][2 * (mp) + mm][q >> 1][2 * (q & 1) + 1] *= ra.y; } } while (0)
        BR_LOAD(0, 0, 0); BR_LOAD(1, 0, 1); asm volatile("" ::: "memory");
        BR_APPLY(0, 0, 0); asm volatile("" ::: "memory"); BR_LOAD(0, 1, 0); asm volatile("" ::: "memory");
        BR_APPLY(1, 0, 1); asm volatile("" ::: "memory"); BR_LOAD(1, 1, 1); asm volatile("" ::: "memory");
        BR_APPLY(0, 1, 0); asm volatile("" ::: "memory"); BR_APPLY(1, 1, 1); asm volatile("" ::: "memory");
#undef BR_LOAD
#undef BR_APPLY
    }
    __device__ __forceinline__ void operator()(const f32x4 (&acc)[2][2][4][2], const Unit& u, int wr, int wc, int fr, int fq) const {
        const int row0 = u.pm * BM + wr * 64 + fr, col0 = u.pn * BM + wc * 32 + 8 * fq;
        u32x4 l2[2][2][2];
#define BR_LOAD(bf, ai, mp) do { _Pragma("unroll") for (int mm = 0; mm < 2; ++mm) _Pragma("unroll") for (int bj = 0; bj < 2; ++bj) \
            l2[bf][mm][bj] = *(const u32x4*)(G + 2048 + (size_t)(row0 + (ai) * HALF + (2 * (mp) + mm) * 16) * ldg + col0 + bj * HALF); } while (0)
#define BR_APPLY(bf, ai, mp) do { _Pragma("unroll") for (int mm = 0; mm < 2; ++mm) _Pragma("unroll") for (int bj = 0; bj < 2; ++bj) { u32x4 w; \
            _Pragma("unroll") for (int q = 0; q < 4; ++q) { const unsigned dw = l2[bf][mm][bj][q]; const f32x2 rd = {__builtin_amdgcn_rcpf(bfl(dw)), __builtin_amdgcn_rcpf(bfh(dw))}; \
                const f32x2 a2 = {acc[ai][bj][2 * (mp) + mm][q >> 1][2 * (q & 1)], acc[ai][bj][2 * (mp) + mm][q >> 1][2 * (q & 1) + 1]}; const f32x2 o = a2 * rd; w[q] = cvt_pk_bf16(o.x, o.y); } \
            *(u32x4*)(O + (size_t)(row0 + (ai) * HALF + (2 * (mp) + mm) * 16) * ldc + col0 + bj * HALF) = w; } } while (0)
        BR_LOAD(0, 0, 0); BR_LOAD(1, 0, 1); asm volatile("" ::: "memory");
        BR_APPLY(0, 0, 0); asm volatile("" ::: "memory"); BR_LOAD(0, 1, 0); asm volatile("" ::: "memory");
        BR_APPLY(1, 0, 1); asm volatile("" ::: "memory"); BR_LOAD(1, 1, 1); asm volatile("" ::: "memory");
        BR_APPLY(0, 1, 0); asm volatile("" ::: "memory"); BR_APPLY(1, 1, 1);
#undef BR_LOAD
#undef BR_APPLY
    }
};

}

constexpr int NWAVES = 8, NTHR = 512;
constexpr int BATCH = 4, SEQ = 4096, D = 1024, M = BATCH * SEQ, INC = 5632, FF = 3584, NE = 8, NHEAD = 8, HD = 64;
constexpr int C_Q = 0, C_K = 512, C_V = 1024, C_U = 1536, C_CH = 1792, C_CB = 2048, C_CC = 2304, C_G = 2560;
constexpr int MPAD = 2 * M + 2048;
constexpr int NCHUNK = M / 64;
constexpr float EPS = 1e-6f;
constexpr float SB_EXIT = -150.1f;

constexpr size_t MiB = 1u << 20;
constexpr size_t WS_CTL = 0, CTL_ZERO_BYTES = 65536;
constexpr int CW_BAR = 4096, CW_MOECNT = 8192;
constexpr size_t WS_TOPI = 1 * MiB, WS_TOPW = WS_TOPI + 256 * 1024, WS_SLOT = WS_TOPI + 512 * 1024;
constexpr size_t WS_TAB = 2 * MiB, TAB_STRIDE = 512 * 1024, TAB_ABAR = 0, TAB_BBAR = 64 * 1024, TAB_CMATB = 256 * 1024, TAB_BBF = 320 * 1024;
constexpr size_t WS_HB8 = 236 * MiB;
constexpr size_t WS_WING8 = 77 * MiB;
constexpr size_t WS_Y2 = 224 * MiB;
constexpr size_t WS_E = 4 * MiB, WS_SSP = 6 * MiB;
constexpr size_t WS_XNN = 8 * MiB;
constexpr size_t WS_WIN0 = 72 * MiB, WS_WCAT0 = 83 * MiB, WS_WOUT0 = 85 * MiB, WS_WGLU0 = 87 * MiB, WS_WGU0 = 88 * MiB, WS_WD0 = 102 * MiB;
constexpr size_t WS_WIN1 = 109 * MiB, WS_WCAT1 = 120 * MiB, WS_WOUT1 = 122 * MiB, WS_WGLU1 = 124 * MiB;
constexpr size_t WS_LSTRIDE = WS_WIN1 - WS_WIN0;
static_assert(WS_WCAT1 - WS_WCAT0 == WS_LSTRIDE && WS_WOUT1 - WS_WOUT0 == WS_LSTRIDE && WS_WGLU1 - WS_WGLU0 == WS_LSTRIDE, "layer stride");
constexpr size_t WS_YCAT0 = 125 * MiB, WS_MERGED0 = 157 * MiB, WS_XN = 252 * MiB, WS_BIG = 284 * MiB;
constexpr size_t WS_YCAT1 = 72 * MiB, WS_MERGED1 = 460 * MiB;
constexpr size_t WS_XS = 72 * MiB, WS_WMOE = 140 * MiB, WS_WD8 = 196 * MiB, WS_ACTM = 284 * MiB, WS_YS = 404 * MiB, WS_END = 492 * MiB;
constexpr float SC_XS = 4.f, SC_W = 64.f, SC_ACT = 8.f;
static_assert(WS_XS + (size_t)MPAD * D <= WS_WIN1 && WS_WMOE + (size_t)NE * 2 * FF * D <= WS_WD8 && WS_WD8 + (size_t)NE * FF * D <= 224 * MiB && WS_ACTM + (size_t)MPAD * FF <= WS_YS && WS_YS + (size_t)MPAD * D * 2 <= WS_END, "MoE map");
static_assert(WS_BIG + (size_t)M * INC * 2 <= WS_END && WS_XN + (size_t)M * D * 2 <= WS_BIG && WS_MERGED0 + (size_t)M * D * 2 <= WS_XN && WS_MERGED1 + (size_t)M * D * 2 <= WS_END && WS_YCAT1 + (size_t)M * D * 2 <= WS_WIN1, "mixer map");

constexpr int RING_BYTES = 131072, MISC_OFF = RING_BYTES, LDS_BYTES = 147456;

#define LAS __attribute__((address_space(3)))
typedef unsigned short bf16;
typedef unsigned v4u __attribute__((ext_vector_type(4)));
typedef unsigned v2u __attribute__((ext_vector_type(2)));
typedef float f32x4 __attribute__((ext_vector_type(4)));
typedef float f32x16 __attribute__((ext_vector_type(16)));
typedef float f32x2v __attribute__((ext_vector_type(2)));
typedef short bf16x8 __attribute__((ext_vector_type(8)));
#define RLX_AGENT __ATOMIC_RELAXED, __HIP_MEMORY_SCOPE_AGENT
#define LDS_WAIT() asm volatile("s_waitcnt lgkmcnt(0)" ::: "memory")
__device__ __forceinline__ float bfl(unsigned w) { return __uint_as_float(w << 16); }
__device__ __forceinline__ float bfh(unsigned w) { return __uint_as_float(w & 0xffff0000u); }
__device__ __forceinline__ float bf2f(bf16 x) { return __uint_as_float(((unsigned)x) << 16); }
typedef float f32x2c __attribute__((ext_vector_type(2))); typedef __bf16 bf16x2c __attribute__((ext_vector_type(2)));
__device__ __forceinline__ unsigned pk2(float lo, float hi) { const f32x2c v = {lo, hi}; return __builtin_bit_cast(unsigned, __builtin_convertvector(v, bf16x2c)); }
__device__ __forceinline__ unsigned f2bf(float f) { return pk2(f, f) & 0xffffu; }
__device__ __forceinline__ float wave_sum(float v) {
#pragma unroll
    for (int o = 1; o < 64; o <<= 1) v += __shfl_xor(v, o);
    return v;
}

#define XB_TMO      128
#define XB_XCNT(j)  (256  + 64 * (j))
#define XB_XSUB(j)  (1280 + 64 * (j))
#define XB_XGEN(j)  (2304 + 64 * (j))
#define XB_TOP      3328
#define XB_TOPGEN   3392
#define XCD_BAR_WORDS 3456
#define XB_SPIN_CAP (1u << 18)
__device__ __forceinline__ unsigned xb_ld(unsigned* p)              { return __hip_atomic_load(p, __ATOMIC_RELAXED, __HIP_MEMORY_SCOPE_AGENT); }
__device__ __forceinline__ unsigned xb_add(unsigned* p, unsigned v) { return __hip_atomic_fetch_add(p, v, __ATOMIC_RELAXED, __HIP_MEMORY_SCOPE_AGENT); }
__device__ __forceinline__ unsigned xb_xcc_id() { return (unsigned)__builtin_amdgcn_s_getreg((3 << 11) | 20) & 0xFu; }
#define XB_SPIN(cond, bar) do { unsigned _sp = 0; while (cond) { __builtin_amdgcn_s_sleep(1); \
    if ((++_sp & 255u) == 0u) { if (xb_ld(&(bar)[XB_TMO])) break; if (_sp > XB_SPIN_CAP) { atomicAdd(&(bar)[XB_TMO], 1u); break; } } } } while (0)
struct XcdBarrier { unsigned* bar; unsigned x; volatile LAS unsigned* st; };
__device__ __forceinline__ XcdBarrier xcd_barrier_post(unsigned* bar, volatile LAS unsigned* st) {
    XcdBarrier b; b.bar = bar; b.x = xb_xcc_id(); b.st = st;
    if (threadIdx.x == 0) (void)xb_add(&bar[XB_XCNT(b.x)], 1u);
    return b;
}
__device__ __forceinline__ void xcd_barrier_complete(unsigned* bar, unsigned x, unsigned& nloc, unsigned& nx) {
    const unsigned G = gridDim.x * gridDim.y * gridDim.z;
    unsigned sum, cnt, mine, sp = 0u;
    for (;;) {
        sum = 0u; cnt = 0u; mine = 0u;
#pragma unroll
        for (unsigned j = 0; j < 16; ++j) { const unsigned c = xb_ld(&bar[XB_XCNT(j)]); sum += c; cnt += (c > 0u) ? 1u : 0u; mine = (j == x) ? c : mine; }
        if (sum == G) break;
        __builtin_amdgcn_s_sleep(1);
        if ((++sp & 255u) == 0u) { if (xb_ld(&bar[XB_TMO])) break; if (sp > XB_SPIN_CAP) { atomicAdd(&bar[XB_TMO], 1u); break; } }
    }
    nloc = mine > 0u ? mine : 1u; nx = cnt > 0u ? cnt : 1u;
}
__device__ __forceinline__ void xcd_barrier(const XcdBarrier& b) {
    asm volatile("s_waitcnt vmcnt(0)" ::: "memory");
    __syncthreads();
    if (threadIdx.x == 0) {
        unsigned* bar = b.bar;
        __builtin_amdgcn_s_waitcnt(0);
        unsigned nloc = b.st[0], nx = b.st[1];
        if (nloc == 0u) { xcd_barrier_complete(bar, b.x, nloc, nx); b.st[0] = nloc; b.st[1] = nx; }
        const unsigned old = xb_add(&bar[XB_XSUB(b.x)], 1u);
        const unsigned gen = old / nloc;
        if (old + 1u == (gen + 1u) * nloc) {
            __builtin_amdgcn_fence(__ATOMIC_RELEASE, "agent");
            asm volatile("s_waitcnt vmcnt(0)" ::: "memory");
            const unsigned og = xb_add(&bar[XB_TOP], 1u);
            const unsigned tg = og / nx;
            if (og + 1u == (tg + 1u) * nx) xb_add(&bar[XB_TOPGEN], 1u);
            else XB_SPIN(xb_ld(&bar[XB_TOPGEN]) == tg, bar);
            __builtin_amdgcn_fence(__ATOMIC_ACQUIRE, "agent");
            xb_add(&bar[XB_XGEN(b.x)], 1u);
            asm volatile("s_waitcnt vmcnt(0)" ::: "memory");
        } else {
            XB_SPIN(xb_ld(&bar[XB_XGEN(b.x)]) == gen, bar);
            __builtin_amdgcn_fence(__ATOMIC_ACQUIRE, "agent");
            asm volatile("s_waitcnt vmcnt(0)" ::: "memory");
        }
    }
    __syncthreads();
}

struct Args { const float* in[26]; float* out; unsigned char* ws; int ph_lo, ph_hi; };
enum InIdx { I_X = 0, I_NORM_MIX, I_W_IN, I_LAM_RE, I_LAM_IM, I_LOG_DT, I_B_RE, I_B_IM, I_C_RE, I_C_IM, I_SSM_D, I_W_GLU, I_CONV_W, I_W_BR_A, I_W_BR_B, I_W_BR_C, I_W_OUT,
             I_NORM_FFN, I_DW_GATE, I_DW_UP, I_DW_DOWN, I_ROUTER, I_MW_GATE, I_MW_UP, I_MW_DOWN, I_FINAL_NORM };
struct Frame {
    LAS unsigned char* lds;
    unsigned* ctl;
    unsigned char* ws;
    const float* const* in;
    float* out;
    int tid, lane, wave, vcu, G;
    size_t ycat_off;
};

struct CvtJob { const float* src; bf16* dst; int K, N, ld, koff, mode; const float* gain; int fp8; int src_ld, c0; };
__device__ __forceinline__ CvtJob get_job(const Frame& F, int j) {
    CvtJob J; J.koff = 0; J.mode = 0; J.gain = nullptr; J.fp8 = 0; J.src_ld = 0; J.c0 = 0;
    if (j >= 39) { const int l = j - 39;
        J.src = F.in[I_W_IN] + (size_t)l * D * INC; J.K = D; J.N = INC - C_G; J.src_ld = INC; J.c0 = C_G; J.dst = (bf16*)(F.ws + WS_WING8 + (size_t)l * WS_LSTRIDE); J.ld = D; J.gain = F.in[I_NORM_MIX] + l * D; J.fp8 = 1; return J; }
    if (j < 12) { const int l = j / 6, r = j % 6; unsigned char* wl = F.ws + (size_t)l * WS_LSTRIDE;
        if (r == 0)      { J.src = F.in[I_W_IN] + (size_t)l * D * INC;   J.K = D;   J.N = C_G; J.src_ld = INC; J.dst = (bf16*)(wl + WS_WIN0);  J.ld = D; J.gain = F.in[I_NORM_MIX] + l * D; }
        else if (r == 1) { J.src = F.in[I_W_BR_A] + (size_t)l * 512 * D; J.K = 512; J.N = D;   J.dst = (bf16*)(wl + WS_WCAT0); J.ld = D; }
        else if (r == 2) { J.src = F.in[I_W_BR_B] + (size_t)l * 256 * D; J.K = 256; J.N = D;   J.dst = (bf16*)(wl + WS_WCAT0); J.ld = D; J.koff = 512; }
        else if (r == 3) { J.src = F.in[I_W_BR_C] + (size_t)l * 256 * D; J.K = 256; J.N = D;   J.dst = (bf16*)(wl + WS_WCAT0); J.ld = D; J.koff = 768; }
        else if (r == 4) { J.src = F.in[I_W_OUT] + (size_t)l * D * D;    J.K = D;   J.N = D;   J.dst = (bf16*)(wl + WS_WOUT0); J.ld = D; }
        else             { J.src = F.in[I_W_GLU] + (size_t)l * 256 * 256; J.K = 256; J.N = 256; J.dst = (bf16*)(wl + WS_WGLU0); J.ld = 256; }
    } else if (j == 12) { J.src = F.in[I_DW_GATE]; J.K = D; J.N = FF; J.dst = (bf16*)(F.ws + WS_WGU0); J.ld = D; J.mode = 1; J.gain = F.in[I_NORM_FFN]; }
    else if (j == 13)   { J.src = F.in[I_DW_UP];   J.K = D; J.N = FF; J.dst = (bf16*)(F.ws + WS_WGU0); J.ld = D; J.mode = 2; J.gain = F.in[I_NORM_FFN]; }
    else if (j == 14)   { J.src = F.in[I_DW_DOWN]; J.K = FF; J.N = D; J.dst = (bf16*)(F.ws + WS_WD0);  J.ld = FF; }
    else if (j < 31)    { const int e = (j - 15) >> 1, up = (j - 15) & 1; const float* sg = F.in[I_MW_GATE]; const float* su = F.in[I_MW_UP]; J.src = (up ? su : sg) + (size_t)e * D * FF; J.K = D; J.N = FF;
                          J.dst = (bf16*)(F.ws + WS_WMOE + (size_t)e * 2 * FF * D); J.ld = D; J.mode = 1 + up; J.fp8 = 1; }
    else                { const int e = j - 31; J.src = F.in[I_MW_DOWN] + (size_t)e * FF * D; J.K = FF; J.N = D; J.dst = (bf16*)(F.ws + WS_WD8 + (size_t)e * D * FF); J.ld = FF; J.fp8 = 1; }
    if (!J.src_ld) J.src_ld = J.N;
    return J;
}
__device__ __forceinline__ void cvt_item(const CvtJob& J, int item, LAS float* scr, int lane) {
    const int nblk = J.N / 32, kb = item / nblk, nb = item % nblk, k0 = 64 * kb, n0 = 32 * nb;
    f32x4 ld[8];
#pragma unroll
    for (int i = 0; i < 8; ++i) ld[i] = *(const f32x4*)(J.src + (size_t)(k0 + (lane >> 3) + 8 * i) * J.src_ld + J.c0 + n0 + (lane & 7) * 4);
    if (J.gain) {
#pragma unroll
        for (int i = 0; i < 8; ++i) ld[i] = ld[i] * J.gain[k0 + (lane >> 3) + 8 * i]; }
#pragma unroll
    for (int i = 0; i < 8; ++i) { LAS float* d = scr + ((lane >> 3) + 8 * i) * 33 + (lane & 7) * 4; d[0] = ld[i].x; d[1] = ld[i].y; d[2] = ld[i].z; d[3] = ld[i].w; }
    LDS_WAIT(); asm volatile("" ::: "memory");
    const int drow0 = (J.mode == 0) ? n0 : ((n0 >> 7) * 256 + (n0 & 127) + (J.mode == 2 ? 128 : 0));
    const int c = lane & 7;
#pragma unroll
    for (int j = 0; j < 4; ++j) { const int n = (lane >> 3) + 8 * j; const LAS float* s = scr + (8 * c) * 33 + n;
        if (J.fp8) { v2u o8; o8.x = pg8::pk4_fp8(s[0 * 33] * SC_W, s[1 * 33] * SC_W, s[2 * 33] * SC_W, s[3 * 33] * SC_W); o8.y = pg8::pk4_fp8(s[4 * 33] * SC_W, s[5 * 33] * SC_W, s[6 * 33] * SC_W, s[7 * 33] * SC_W);
            *(v2u*)((unsigned char*)J.dst + (size_t)(drow0 + n) * J.ld + J.koff + k0 + 8 * c) = o8; }
        else { v4u o; o.x = pk2(s[0 * 33], s[1 * 33]); o.y = pk2(s[2 * 33], s[3 * 33]); o.z = pk2(s[4 * 33], s[5 * 33]); o.w = pk2(s[6 * 33], s[7 * 33]);
            *(v4u*)(J.dst + (size_t)(drow0 + n) * J.ld + J.koff + k0 + 8 * c) = o; } }
    LDS_WAIT(); asm volatile("" ::: "memory");
}
__device__ __forceinline__ void convert_jobs(const Frame& F, int jlo, int jhi, int widx, int nw) {
    if (widx < 0) return;
    LAS float* scr = (LAS float*)(F.lds + F.wave * 16384);
    int start = 0;
    for (int j = jlo; j < jhi; ++j) {
        const CvtJob J = get_job(F, j); const int n = (J.K / 64) * (J.N / 32);
        int it = widx - start; if (it < 0) it += nw;
        for (; it < n; it += nw) cvt_item(J, it, scr, F.lane);
        start = (start + n) % nw;
    }
}

__device__ __forceinline__ void ssm_tables(const Frame& F) {
    const int gt = blockIdx.x * NTHR + F.tid, NT = F.G * NTHR;
    for (int i = gt; i < 2 * 16 * 64; i += NT) {
        const int l = i >> 10, g = (i >> 6) & 15, p = i & 63;
        unsigned char* tab = F.ws + WS_TAB + (size_t)l * TAB_STRIDE;
        const float lr = fminf(F.in[I_LAM_RE][i], -1e-4f), li = F.in[I_LAM_IM][i], dt = expf(F.in[I_LOG_DT][l * 16 + g]);
        const float mag = expf(lr * dt), ar = mag * cosf(li * dt), ai = mag * sinf(li * dt);
        const float den = lr * lr + li * li, nr = ar - 1.0f, ni = ai;
        const float fr = (nr * lr + ni * li) / den, fi = (ni * lr - nr * li) / den;
        const double ang = (double)li * (double)dt * 64.0; const double rev = ang * 0.15915494309189535; const float rf = (float)((rev - rint(rev)) * 6.283185307179586);
        const float magT = expf(64.0f * lr * dt);
        ((f32x4*)(tab + TAB_ABAR))[g * 64 + p] = (f32x4){ar, ai, magT * cosf(rf), magT * sinf(rf)};
        float* bb = (float*)(tab + TAB_BBAR) + (size_t)(g * 64 + p) * 32;
        const float* bre = F.in[I_B_RE] + (size_t)i * 16; const float* bim = F.in[I_B_IM] + (size_t)i * 16;
#pragma unroll
        for (int h = 0; h < 16; ++h) { const float br = bre[h], bi = bim[h]; bb[2 * h] = fr * br - fi * bi; bb[2 * h + 1] = fr * bi + fi * br; }
    }
    for (int i = gt; i < 2 * 16 * 8 * 64; i += NT) {
        const int l = i >> 13, g = (i >> 9) & 15, cbk = (i >> 6) & 7, ln = i & 63;
        const int c = cbk * 16 + (ln & 15), p = c >> 1, ri = c & 1, kh = ln >> 4;
        unsigned w[4] = {0u, 0u, 0u, 0u};
        if (kh < 2) {
            const int idx = (l * 16 + g) * 64 + p;
            const float lr = fminf(F.in[I_LAM_RE][idx], -1e-4f), li = F.in[I_LAM_IM][idx], dt = expf(F.in[I_LOG_DT][l * 16 + g]);
            const float mag = expf(lr * dt), ar = mag * cosf(li * dt), ai = mag * sinf(li * dt);
            const float den = lr * lr + li * li, nr = ar - 1.0f, ni = ai;
            const float fr = (nr * lr + ni * li) / den, fi = (ni * lr - nr * li) / den;
            const float* bre = F.in[I_B_RE] + (size_t)idx * 16 + 8 * kh; const float* bim = F.in[I_B_IM] + (size_t)idx * 16 + 8 * kh;
            float v[8];
#pragma unroll
            for (int j = 0; j < 8; ++j) { const float br = bre[j], bi = bim[j]; v[j] = ri ? (fr * bi + fi * br) : (fr * br - fi * bi); }
            w[0] = pk2(v[0], v[1]); w[1] = pk2(v[2], v[3]); w[2] = pk2(v[4], v[5]); w[3] = pk2(v[6], v[7]);
        }
        ((v4u*)(F.ws + WS_TAB + (size_t)l * TAB_STRIDE + TAB_BBF))[i & 8191] = (v4u){w[0], w[1], w[2], w[3]};
    }
    for (int i = gt; i < 2 * 16 * 4 * 64; i += NT) {
        const int l = i >> 12, g = (i >> 8) & 15, ks = (i >> 6) & 3, ln = i & 63;
        const int hp = ln & 15;
        const float* cre = F.in[I_C_RE] + ((size_t)(l * 16 + g) * 16 + hp) * 64; const float* cim = F.in[I_C_IM] + ((size_t)(l * 16 + g) * 16 + hp) * 64;
        unsigned w[4];
#pragma unroll
        for (int jj = 0; jj < 4; ++jj) { const int k = ks * 32 + 8 * (ln >> 4) + 2 * jj, p = k >> 1; w[jj] = pk2(cre[p], -cim[p]); }
        ((v4u*)(F.ws + WS_TAB + (size_t)l * TAB_STRIDE + TAB_CMATB))[i & 4095] = (v4u){w[0], w[1], w[2], w[3]};
    }
}

template <bool ROUTER>
__device__ __forceinline__ void norm_rows(const Frame& F, const bf16* src, const float* gain, bf16* dst) {
    const int gw = F.vcu * NWAVES + F.wave, NGW = F.G * NWAVES;
    LAS float* wrt = (LAS float*)F.lds;
    if (ROUTER) {
        const float* wr = F.in[I_ROUTER];
        for (int i = F.tid; i < D * NE; i += NTHR) wrt[(i & 7) * D + (i >> 3)] = wr[i];
        __syncthreads();
    }
    f32x4 gv[4];
#pragma unroll
    for (int j = 0; j < 4; ++j) gv[j] = ((const f32x4*)gain)[F.lane + 64 * j];
    v2u nv[4];
    if (gw < M) {
#pragma unroll
        for (int j = 0; j < 4; ++j) nv[j] = ((const v2u*)(src + (size_t)gw * D) + F.lane)[64 * j]; }
    for (int m = gw; m < M; m += NGW) {
        f32x4 v[4]; float s = 0.f;
#pragma unroll
        for (int j = 0; j < 4; ++j) v[j] = (f32x4){bfl(nv[j].x), bfh(nv[j].x), bfl(nv[j].y), bfh(nv[j].y)};
        if (m + NGW < M) {
#pragma unroll
            for (int j = 0; j < 4; ++j) nv[j] = ((const v2u*)(src + (size_t)(m + NGW) * D) + F.lane)[64 * j]; }
#pragma unroll
        for (int j = 0; j < 4; ++j) s += (v[j].x * v[j].x + v[j].y * v[j].y) + (v[j].z * v[j].z + v[j].w * v[j].w);
        const float rstd = 1.0f / sqrtf(wave_sum(s) * (1.0f / D) + EPS);
        if (ROUTER) { unsigned* o4 = (unsigned*)((unsigned char*)dst + (size_t)m * D) + F.lane;
#pragma unroll
            for (int j = 0; j < 4; ++j) { v[j] = v[j] * rstd * gv[j]; o4[64 * j] = pg8::pk4_fp8(v[j].x * SC_XS, v[j].y * SC_XS, v[j].z * SC_XS, v[j].w * SC_XS); } }
        else { unsigned long long* o8 = (unsigned long long*)(dst + (size_t)m * D) + F.lane;
#pragma unroll
            for (int j = 0; j < 4; ++j) { v[j] = v[j] * rstd * gv[j]; o8[64 * j] = (unsigned long long)pk2(v[j].x, v[j].y) | ((unsigned long long)pk2(v[j].z, v[j].w) << 32); } }
        if (ROUTER) {
            float lg[8];
#pragma unroll
            for (int e = 0; e < 8; ++e) { float a = 0.f;
#pragma unroll
                for (int j = 0; j < 4; ++j) { const f32x4 w = *(const LAS f32x4*)(wrt + e * D + 4 * F.lane + 256 * j); a += (v[j].x * w.x + v[j].y * w.y) + (v[j].z * w.z + v[j].w * w.w); }
                lg[e] = wave_sum(a); }
            if (F.lane == 0) {
                int i1 = 0; float v1 = lg[0];
#pragma unroll
                for (int e = 1; e < 8; ++e) if (lg[e] > v1) { v1 = lg[e]; i1 = e; }
                int i2 = -1; float v2 = -INFINITY;
#pragma unroll
                for (int e = 0; e < 8; ++e) if (e != i1 && lg[e] > v2) { v2 = lg[e]; i2 = e; }
                const float e2 = expf(v2 - v1), w1 = 1.0f / (1.0f + e2);
                ((int2*)(F.ws + WS_TOPI))[m] = make_int2(i1, i2);
                ((float2*)(F.ws + WS_TOPW))[m] = make_float2(w1, e2 * w1);
            }
        }
    }
}

__device__ __forceinline__ void cast_rows(const Frame& F, const float* src, bf16* dst) {
    const int gw = F.vcu * NWAVES + F.wave, NGW = F.G * NWAVES;
    float* ssp = (float*)(F.ws + WS_SSP);
    f32x4 nv[4];
    if (gw < M) {
#pragma unroll
        for (int j = 0; j < 4; ++j) nv[j] = ((const f32x4*)(src + (size_t)gw * D) + F.lane)[64 * j]; }
    for (int m = gw; m < M; m += NGW) {
        f32x4 v[4]; float s = 0.f;
#pragma unroll
        for (int j = 0; j < 4; ++j) v[j] = nv[j];
        if (m + NGW < M) {
#pragma unroll
            for (int j = 0; j < 4; ++j) nv[j] = ((const f32x4*)(src + (size_t)(m + NGW) * D) + F.lane)[64 * j]; }
#pragma unroll
        for (int j = 0; j < 4; ++j) s += (v[j].x * v[j].x + v[j].y * v[j].y) + (v[j].z * v[j].z + v[j].w * v[j].w);
        s = wave_sum(s);
        unsigned long long* o8 = (unsigned long long*)(dst + (size_t)m * D) + F.lane;
#pragma unroll
        for (int j = 0; j < 4; ++j) o8[64 * j] = (unsigned long long)pk2(v[j].x, v[j].y) | ((unsigned long long)pk2(v[j].z, v[j].w) << 32);
        unsigned* o4 = (unsigned*)(F.ws + WS_HB8 + (size_t)m * D) + F.lane;
#pragma unroll
        for (int j = 0; j < 4; ++j) o4[64 * j] = pg8::pk4_fp8(v[j].x * SC_XS, v[j].y * SC_XS, v[j].z * SC_XS, v[j].w * SC_XS);
        if (F.lane < 16) ssp[(size_t)m * 16 + F.lane] = (F.lane == 0) ? s : 0.f;
    }
}
__device__ __forceinline__ void cfma(float& sr, float& si, float ar, float ai, float br, float bi) {
    float t1, t2, nr, ni; const float nai = -ai;
    asm volatile("v_fma_f32 %0, %1, %2, %3" : "=v"(t1) : "v"(ar), "v"(sr), "v"(br));
    asm volatile("v_fma_f32 %0, %1, %2, %3" : "=v"(nr) : "v"(nai), "v"(si), "v"(t1));
    asm volatile("v_fma_f32 %0, %1, %2, %3" : "=v"(t2) : "v"(ar), "v"(si), "v"(bi));
    asm volatile("v_fma_f32 %0, %1, %2, %3" : "=v"(ni) : "v"(ai), "v"(sr), "v"(t2));
    sr = nr; si = ni;
}
constexpr int BUP = 132;
__device__ __forceinline__ bf16x8 ssm_u_frag(const bf16* proj, int tokb, int g, int lane) {
    bf16x8 a = {0, 0, 0, 0, 0, 0, 0, 0};
    if ((lane >> 4) < 2) a = *(const bf16x8*)(proj + (size_t)(tokb + (lane & 15)) * INC + C_U + g * 16 + 8 * (lane >> 4));
    return a;
}
__device__ __forceinline__ void ssm_bu_block(LAS float* bu, const bf16x8 (&bbf)[8], bf16x8 a, int lane) {
    const int kh = lane >> 4;
#pragma unroll
    for (int cb = 0; cb < 8; ++cb) {
        const pg8::f32x4 d = __builtin_amdgcn_mfma_f32_16x16x32_bf16(a, bbf[cb], (pg8::f32x4){0.f, 0.f, 0.f, 0.f}, 0, 0, 0);
#pragma unroll
        for (int r = 0; r < 4; ++r) bu[(4 * kh + r) * BUP + cb * 16 + (lane & 15)] = d[r];
    }
    LDS_WAIT(); asm volatile("" ::: "memory");
}
#define SSM_STEP(tt_) do { const f32x2v b_ = *(const LAS f32x2v*)(bu + (tt_) * BUP + 2 * p); \
    cfma(sr, si, ab.x, ab.y, b_.x, b_.y); } while (0)

__device__ __forceinline__ void ssm_pass1_unit(const Frame& F, int l, int unit) {
    const bf16* proj = (const bf16*)(F.ws + WS_BIG);
    const unsigned char* tab = F.ws + WS_TAB + (size_t)l * TAB_STRIDE;
    LAS float* bu = (LAS float*)(F.lds + F.wave * (16 * BUP * 4));
    const int p = F.lane, tok0 = unit * 64;
    for (int gi = 0; gi < 2; ++gi) {
        const int g = F.wave * 2 + gi;
        bf16x8 bbf[8];
#pragma unroll
        for (int cb = 0; cb < 8; ++cb) bbf[cb] = ((const bf16x8*)(tab + TAB_BBF))[(g * 8 + cb) * 64 + F.lane];
        const f32x4 ab = ((const f32x4*)(tab + TAB_ABAR))[g * 64 + p];
        bf16x8 af[4];
#pragma unroll
        for (int tb = 0; tb < 4; ++tb) af[tb] = ssm_u_frag(proj, tok0 + tb * 16, g, F.lane);
        float sr = 0.f, si = 0.f;
#pragma unroll
        for (int tb = 0; tb < 4; ++tb) {
            ssm_bu_block(bu, bbf, af[tb], F.lane);
#pragma unroll
            for (int tt = 0; tt < 16; ++tt) SSM_STEP(tt);
        }
        ((float2*)(F.ws + WS_E))[((size_t)unit * 16 + g) * 64 + p] = make_float2(sr, si);
        LDS_WAIT(); asm volatile("" ::: "memory");
    }
}
__device__ __forceinline__ void conv_unit(const Frame& F, int l, int unit) {
    const bf16* proj = (const bf16*)(F.ws + WS_BIG); bf16* ycat = (bf16*)(F.ws + F.ycat_off);
    const float* cw = F.in[I_CONV_W] + (size_t)l * 3 * 256;
    for (int it = F.tid; it < 64 * 32; it += NTHR) {
        const int tt = it >> 5, cg = (it & 31) * 8, tok = unit * 64 + tt, tl = tok & (SEQ - 1);
        const bf16* row = proj + (size_t)tok * INC;
        float u[3][8];
        v4u hv[3], cv[3];
#pragma unroll
        for (int d = 0; d < 3; ++d) { const size_t back = (tl >= d) ? (size_t)d * INC : 0; hv[d] = *(const v4u*)(row - back + C_CH + cg); cv[d] = *(const v4u*)(row - back + C_CC + cg); }
#pragma unroll
        for (int d = 0; d < 3; ++d) {
            const float keep = (tl >= d) ? 1.f : 0.f;
            const unsigned hw[4] = {hv[d].x, hv[d].y, hv[d].z, hv[d].w}, cww[4] = {cv[d].x, cv[d].y, cv[d].z, cv[d].w};
#pragma unroll
            for (int q = 0; q < 4; ++q) { u[d][2 * q] = keep * (bfl(hw[q]) * bfl(cww[q])); u[d][2 * q + 1] = keep * (bfh(hw[q]) * bfh(cww[q])); }
        }
        const v4u bv = *(const v4u*)(row + C_CB + cg); const unsigned bw[4] = {bv.x, bv.y, bv.z, bv.w};
        float o[8];
#pragma unroll
        for (int q = 0; q < 8; ++q) { const float y = cw[cg + q] * u[2][q] + cw[256 + cg + q] * u[1][q] + cw[512 + cg + q] * u[0][q]; const float bg = (q & 1) ? bfh(bw[q >> 1]) : bfl(bw[q >> 1]); o[q] = bg * y; }
        *(v4u*)(ycat + (size_t)tok * D + 768 + cg) = (v4u){pk2(o[0], o[1]), pk2(o[2], o[3]), pk2(o[4], o[5]), pk2(o[6], o[7])};
    }
}
__device__ __forceinline__ int crow(int r, int hi) { return (r & 3) + 8 * (r >> 2) + 4 * hi; }
constexpr int VPITCH = 144;
typedef short v4i16_t __attribute__((ext_vector_type(4)));
__device__ __forceinline__ bf16x8 pack8(float a, float b, float c, float d, float e, float f, float g, float h) {
    v4u w = {pk2(a, b), pk2(c, d), pk2(e, f), pk2(g, h)}; return __builtin_bit_cast(bf16x8, w); }
__device__ __forceinline__ void attn_unit(const Frame& F, int uidx, LAS unsigned char* vl) {
    const int lane = F.lane, r32 = lane & 31, hh = lane >> 5;
    const int bh = uidx >> 7, qb = uidx & 127, b = bh >> 3, h = bh & 7, t0 = qb * 32, tq = t0 + r32;
    const bf16* P = (const bf16*)(F.ws + WS_BIG) + (size_t)b * SEQ * INC;
    bf16* ycat = (bf16*)(F.ws + F.ycat_off);
    bf16x8 qf[4];
#pragma unroll
    for (int ks = 0; ks < 4; ++ks) qf[ks] = *(const bf16x8*)(P + (size_t)tq * INC + C_Q + h * 64 + 16 * ks + 8 * hh);
    f32x16 o0 = {}, o1 = {};
    float carry = 0.f;
    const int trb = ((lane & 15) >> 2) * VPITCH + (16 * ((lane >> 4) & 1) + 4 * (lane & 3)) * 2 + 4 * hh * VPITCH;
    bf16x8 kf0[4], kf1[4];
    v4u vv[8];
    const unsigned vlo = (unsigned)(((lane >> 3) * INC + (lane & 7) * 8) * 2), klo = (unsigned)((r32 * INC + 8 * hh) * 2);
    const char* Pv = (const char*)(P + C_V + h * 64); const char* Pk = (const char*)(P + C_K + h * 64);
#define AT_LOADV(KSB) do { const char* vb_ = Pv + (size_t)(KSB) * (INC * 2); _Pragma("unroll") for (int i = 0; i < 8; ++i) vv[i] = *(const v4u*)(vb_ + (size_t)(8 * i) * (INC * 2) + vlo); } while (0)
#define AT_LOADK(KSB) do { const char* kb_ = Pk + (size_t)(KSB) * (INC * 2); \
            _Pragma("unroll") for (int ks = 0; ks < 4; ++ks) { kf0[ks] = *(const bf16x8*)(kb_ + klo + 32 * ks); kf1[ks] = *(const bf16x8*)(kb_ + (size_t)32 * (INC * 2) + klo + 32 * ks); } } while (0)
    { const int kb0 = t0 - 32 < 0 ? 0 : t0 - 32; AT_LOADV(kb0); AT_LOADK(kb0); }
    for (int kend = t0 + 32; kend > 0; kend -= 64) {
        const int ks0 = kend - 64;
        asm volatile("" : "+v"(vv[0]), "+v"(vv[1]), "+v"(vv[2]), "+v"(vv[3]), "+v"(vv[4]), "+v"(vv[5]), "+v"(vv[6]), "+v"(vv[7]));
#pragma unroll
        for (int i = 0; i < 8; ++i) { const int row = (lane >> 3) + 8 * i; *(LAS v4u*)(vl + row * VPITCH + (lane & 7) * 16) = vv[i]; }
        const int ksb = ks0 < 0 ? 0 : ks0, ksn = ks0 - 64 < 0 ? 0 : ks0 - 64;
        AT_LOADV(ksn); asm volatile("" ::: "memory");
        f32x16 s0 = {}, s1 = {};
#pragma unroll
        for (int ks = 0; ks < 4; ++ks) { s0 = __builtin_amdgcn_mfma_f32_32x32x16_bf16(kf0[ks], qf[ks], s0, 0, 0, 0); s1 = __builtin_amdgcn_mfma_f32_32x32x16_bf16(kf1[ks], qf[ks], s1, 0, 0, 0); }
        asm volatile("" : "+v"(s0), "+v"(s1));
        AT_LOADK(ksn); asm volatile("" ::: "memory");
        f32x16 c0, c1; float tot = 0.f; const int kmax = kend < tq ? kend : tq;
#define SP_ELEM(S, C, I, KEY, MASKED) do { const float z2 = 0.18033688011112042f * S[I]; const float sp = fmaxf(z2, 0.f) + __builtin_amdgcn_logf(1.f + __builtin_amdgcn_exp2f(-fabsf(z2))); \
            if (MASKED) { const bool valid = (KEY) < kmax; C[I] = valid ? (z2 - sp) + carry : -INFINITY; S[I] = valid ? -sp : 0.f; } else { C[I] = (z2 - sp) + carry; S[I] = -sp; } tot += S[I]; } while (0)
        if (ks0 >= 0 && kend <= t0) {
#pragma unroll
            for (int i = 0; i < 16; ++i) SP_ELEM(s1, c1, i, 0, false);
            tot += __shfl_xor(tot, 32); carry += tot; tot = 0.f;
#pragma unroll
            for (int i = 0; i < 16; ++i) SP_ELEM(s0, c0, i, 0, false);
        } else {
#pragma unroll
            for (int i = 0; i < 16; ++i) { const int key1 = ksb + 32 + crow(i, hh); SP_ELEM(s1, c1, i, key1, true); }
            tot += __shfl_xor(tot, 32); carry += tot; tot = 0.f;
#pragma unroll
            for (int i = 0; i < 16; ++i) { const int key0 = ksb + crow(i, hh); SP_ELEM(s0, c0, i, key0, true); }
        }
#undef SP_ELEM
        tot += __shfl_xor(tot, 32); carry += tot;
        {
#define HIW(S, q8) ((v4u){pk2(S[(q8)], S[(q8) + 1]), pk2(S[(q8) + 2], S[(q8) + 3]), pk2(S[(q8) + 4], S[(q8) + 5]), pk2(S[(q8) + 6], S[(q8) + 7])})
#define LOW(S, q8, H) ((v4u){pk2(S[(q8)] - bfl((H).x), S[(q8) + 1] - bfh((H).x)), pk2(S[(q8) + 2] - bfl((H).y), S[(q8) + 3] - bfh((H).y)), pk2(S[(q8) + 4] - bfl((H).z), S[(q8) + 5] - bfh((H).z)), pk2(S[(q8) + 6] - bfl((H).w), S[(q8) + 7] - bfh((H).w))})
#define CUM6(X00, X01, X10, X11) do { c0 = __builtin_amdgcn_mfma_f32_32x32x16_bf16(T0, X00, c0, 0, 0, 0); c0 = __builtin_amdgcn_mfma_f32_32x32x16_bf16(T1, X01, c0, 0, 0, 0); \
            c1 = __builtin_amdgcn_mfma_f32_32x32x16_bf16(T0, X10, c1, 0, 0, 0); c1 = __builtin_amdgcn_mfma_f32_32x32x16_bf16(T1, X11, c1, 0, 0, 0); } while (0)
            bf16x8 T0, T1;
            { int lt = lane; asm volatile("" : "+v"(lt)); const int rt = lt & 31, ht = lt >> 5;
#pragma unroll
              for (int j = 0; j < 8; ++j) { const int ko = 8 * (j >> 2) + 4 * ht + (j & 3); T0[j] = (ko > rt) ? (short)0x3F80 : (short)0; T1[j] = (16 + ko > rt) ? (short)0x3F80 : (short)0; } }
            const v4u h00 = HIW(s0, 0), h01 = HIW(s0, 8), h10 = HIW(s1, 0), h11 = HIW(s1, 8);
            CUM6(__builtin_bit_cast(bf16x8, h00), __builtin_bit_cast(bf16x8, h01), __builtin_bit_cast(bf16x8, h10), __builtin_bit_cast(bf16x8, h11));
            const v4u l00 = LOW(s0, 0, h00), l01 = LOW(s0, 8, h01), l10 = LOW(s1, 0, h10), l11 = LOW(s1, 8, h11);
            CUM6(__builtin_bit_cast(bf16x8, l00), __builtin_bit_cast(bf16x8, l01), __builtin_bit_cast(bf16x8, l10), __builtin_bit_cast(bf16x8, l11));
#undef HIW
#undef LOW
#undef CUM6
        }
#pragma unroll
        for (int i = 0; i < 16; ++i) { c0[i] = __builtin_amdgcn_exp2f(c0[i]); c1[i] = __builtin_amdgcn_exp2f(c1[i]); }
#pragma unroll
        for (int kq = 0; kq < 4; ++kq) {
            const bf16x8 wa = (kq & 2) ? pack8(c1[8 * (kq & 1)], c1[8 * (kq & 1) + 1], c1[8 * (kq & 1) + 2], c1[8 * (kq & 1) + 3], c1[8 * (kq & 1) + 4], c1[8 * (kq & 1) + 5], c1[8 * (kq & 1) + 6], c1[8 * (kq & 1) + 7])
                                       : pack8(c0[8 * (kq & 1)], c0[8 * (kq & 1) + 1], c0[8 * (kq & 1) + 2], c0[8 * (kq & 1) + 3], c0[8 * (kq & 1) + 4], c0[8 * (kq & 1) + 5], c0[8 * (kq & 1) + 6], c0[8 * (kq & 1) + 7]);
#pragma unroll
            for (int db = 0; db < 2; ++db) {
                LAS unsigned char* vp = vl + trb + 16 * kq * VPITCH + 64 * db;
                const v4i16_t lo = __builtin_amdgcn_ds_read_tr16_b64_v4i16((LAS v4i16_t*)vp), hi = __builtin_amdgcn_ds_read_tr16_b64_v4i16((LAS v4i16_t*)(vp + 8 * VPITCH));
                const bf16x8 vf = {lo[0], lo[1], lo[2], lo[3], hi[0], hi[1], hi[2], hi[3]};
                if (db == 0) o0 = __builtin_amdgcn_mfma_f32_32x32x16_bf16(wa, vf, o0, 0, 0, 0); else o1 = __builtin_amdgcn_mfma_f32_32x32x16_bf16(wa, vf, o1, 0, 0, 0);
            }
        }
        if (__all(carry < SB_EXIT)) break;
    }
#undef AT_LOADV
#undef AT_LOADK
    int lz = lane; asm volatile("" : "+v"(lz));
    bf16* op = ycat + (size_t)(b * SEQ + t0 + 4 * (lz >> 5)) * D + h * 64 + (lz & 31);
#pragma unroll
    for (int i = 0; i < 16; ++i) { const int q = crow(i, 0); op[(size_t)q * D] = (bf16)f2bf(o0[i]); op[(size_t)q * D + 32] = (bf16)f2bf(o1[i]); }
    LDS_WAIT(); asm volatile("" ::: "memory");
}
__device__ __forceinline__ void mixer_b(const Frame& F, int l, int nrep_s, int nrep_a) {
    for (int rep = 0; rep < nrep_s; ++rep)
    for (int u = blockIdx.x; u < NCHUNK; u += F.G) { ssm_pass1_unit(F, l, u); conv_unit(F, l, u); }
    __syncthreads();
    LAS unsigned char* vl = F.lds + 32768 + F.wave * (64 * VPITCH);
    const int gw = blockIdx.x * NWAVES + F.wave, NGW = F.G * NWAVES;
    for (int rep = 0; rep < nrep_a; ++rep)
    for (int uidx = gw; uidx < BATCH * NHEAD * (SEQ / 32); uidx += NGW) attn_unit(F, uidx, vl);
}

__device__ __forceinline__ void ssm_pass2_unit(const Frame& F, int l, int unit) {
    const bf16* proj = (const bf16*)(F.ws + WS_BIG); bf16* ycat = (bf16*)(F.ws + F.ycat_off);
    const unsigned char* tab = F.ws + WS_TAB + (size_t)l * TAB_STRIDE;
    const float* dsk = F.in[I_SSM_D] + l * 256;
    const bf16* wglu = (const bf16*)(F.ws + WS_WGLU0 + (size_t)l * WS_LSTRIDE);
    LAS float* bu = (LAS float*)(F.lds + F.wave * (16 * BUP * 4));
    LAS unsigned char* sst = (LAS unsigned char*)bu;
    LAS unsigned char* yg = F.lds + 8 * (16 * BUP * 4);
    const int lane = F.lane, p = lane, tok0 = unit * 64, cfirst = unit & ~63;
    float s0r = 0.f, s0i = 0.f, s1r = 0.f, s1i = 0.f;
    { const f32x4 ab0 = ((const f32x4*)(tab + TAB_ABAR))[(F.wave * 2) * 64 + p], ab1 = ((const f32x4*)(tab + TAB_ABAR))[(F.wave * 2 + 1) * 64 + p];
      const float2* ep = (const float2*)(F.ws + WS_E) + (size_t)(F.wave * 2) * 64 + p;
      float2 e0[8], e1[8], f0[8], f1[8];
#define HORNER_LOAD(A0, A1, CC) do { _Pragma("unroll") for (int q = 0; q < 8; ++q) { const int ci = ((CC) + q < unit) ? (CC) + q : cfirst; A0[q] = ep[(size_t)ci * 1024]; A1[q] = ep[(size_t)ci * 1024 + 64]; } } while (0)
#define HORNER_APPLY(A0, A1, CC) do { _Pragma("unroll") for (int q = 0; q < 8; ++q) if ((CC) + q < unit) { cfma(s0r, s0i, ab0.z, ab0.w, A0[q].x, A0[q].y); cfma(s1r, s1i, ab1.z, ab1.w, A1[q].x, A1[q].y); } } while (0)
      if (cfirst < unit) HORNER_LOAD(e0, e1, cfirst);
      for (int cc = cfirst; cc < unit; cc += 16) {
          if (cc + 8 < unit) HORNER_LOAD(f0, f1, cc + 8);
          asm volatile("" ::: "memory");
          HORNER_APPLY(e0, e1, cc);
          if (cc + 16 < unit) HORNER_LOAD(e0, e1, cc + 16);
          asm volatile("" ::: "memory");
          if (cc + 8 < unit) HORNER_APPLY(f0, f1, cc + 8);
      }
#undef HORNER_LOAD
#undef HORNER_APPLY
    }
    for (int gi = 0; gi < 2; ++gi) {
        const int g = F.wave * 2 + gi;
        bf16x8 bbf[8];
#pragma unroll
        for (int cb = 0; cb < 8; ++cb) bbf[cb] = ((const bf16x8*)(tab + TAB_BBF))[(g * 8 + cb) * 64 + lane];
        const f32x4 ab = ((const f32x4*)(tab + TAB_ABAR))[g * 64 + p];
        bf16x8 cb4[4];
#pragma unroll
        for (int ks = 0; ks < 4; ++ks) cb4[ks] = ((const bf16x8*)(tab + TAB_CMATB))[(g * 4 + ks) * 64 + lane];
        bf16x8 af[4]; bf16 uvs[4][4];
#pragma unroll
        for (int tb = 0; tb < 4; ++tb) { af[tb] = ssm_u_frag(proj, tok0 + tb * 16, g, lane);
#pragma unroll
            for (int r = 0; r < 4; ++r) uvs[tb][r] = proj[(size_t)(tok0 + tb * 16 + 4 * (lane >> 4) + r) * INC + C_U + g * 16 + (lane & 15)]; }
        float sr = gi ? s1r : s0r, si = gi ? s1i : s0i;
        const float dk = dsk[g * 16 + (lane & 15)];
#pragma unroll
        for (int tb = 0; tb < 4; ++tb) {
            ssm_bu_block(bu, bbf, af[tb], lane);
#pragma unroll
            for (int tt = 0; tt < 16; ++tt) { SSM_STEP(tt); *(LAS unsigned*)(sst + tt * (BUP * 4) + p * 4) = pk2(sr, si); }
            pg8::f32x4 acc = {0.f, 0.f, 0.f, 0.f};
#pragma unroll
            for (int ks = 0; ks < 4; ++ks) { const bf16x8 a = *(const LAS bf16x8*)(sst + (lane & 15) * (BUP * 4) + (ks * 32 + 8 * (lane >> 4)) * 2); acc = __builtin_amdgcn_mfma_f32_16x16x32_bf16(a, cb4[ks], acc, 0, 0, 0); }
#pragma unroll
            for (int r = 0; r < 4; ++r) { const int t = tb * 16 + 4 * (lane >> 4) + r; const float y = acc[r] + dk * bf2f(uvs[tb][r]);
                const float gl = y * __builtin_amdgcn_rcpf(1.f + __builtin_amdgcn_exp2f(-2.3022081986f * (y + 0.044715f * y * y * y)));
                *(LAS bf16*)(yg + t * 528 + (g * 16 + (lane & 15)) * 2) = (bf16)f2bf(gl); }
        }
        LDS_WAIT(); asm volatile("" ::: "memory");
    }
    const int n0 = 32 * F.wave, r32 = lane & 31, hh = lane >> 5;
    bf16x8 wfr[16];
    { const bf16* wrow = wglu + (size_t)(n0 + r32) * 256 + 8 * hh;
#pragma unroll
      for (int ks = 0; ks < 16; ++ks) wfr[ks] = *(const bf16x8*)(wrow + 16 * ks); }
    __syncthreads();
    {
        f32x16 a0 = {}, a1 = {};
#pragma unroll
        for (int ks = 0; ks < 16; ++ks) {
            const bf16x8 bfr = wfr[ks];
            const bf16x8 x0 = *(const LAS bf16x8*)(yg + r32 * 528 + (16 * ks + 8 * hh) * 2), x1 = *(const LAS bf16x8*)(yg + (32 + r32) * 528 + (16 * ks + 8 * hh) * 2);
            a0 = __builtin_amdgcn_mfma_f32_32x32x16_bf16(x0, bfr, a0, 0, 0, 0); a1 = __builtin_amdgcn_mfma_f32_32x32x16_bf16(x1, bfr, a1, 0, 0, 0);
        }
#pragma unroll
        for (int r = 0; r < 16; ++r) { const int t = crow(r, hh);
            { const float yv = bf2f(*(const LAS bf16*)(yg + t * 528 + (n0 + r32) * 2)); ycat[(size_t)(tok0 + t) * D + 512 + n0 + r32] = (bf16)f2bf(yv * __builtin_amdgcn_rcpf(1.f + __builtin_amdgcn_exp2f(-1.4426950409f * a0[r]))); }
            { const float yv = bf2f(*(const LAS bf16*)(yg + (32 + t) * 528 + (n0 + r32) * 2)); ycat[(size_t)(tok0 + 32 + t) * D + 512 + n0 + r32] = (bf16)f2bf(yv * __builtin_amdgcn_rcpf(1.f + __builtin_amdgcn_exp2f(-1.4426950409f * a1[r]))); } }
    }
    __syncthreads();
}

__device__ __forceinline__ void moe_gather(const Frame& F) {
    LAS int* cnt = (LAS int*)F.lds;
    LAS int* tot = (LAS int*)(F.lds + 16384);
    LAS int* slot_l = (LAS int*)(F.lds + 16384 + 256);
    const int2* topi = (const int2*)(F.ws + WS_TOPI);
    const unsigned char* xn = F.ws + WS_XNN; unsigned char* xs = F.ws + WS_XS;
    {   int c0 = 0, c1 = 0, c2 = 0, c3 = 0, c4 = 0, c5 = 0, c6 = 0, c7 = 0;
        for (int k = 0; k < 32; ++k) { const int2 ti = topi[F.tid * 32 + k];
            c0 += (ti.x == 0) + (ti.y == 0); c1 += (ti.x == 1) + (ti.y == 1); c2 += (ti.x == 2) + (ti.y == 2); c3 += (ti.x == 3) + (ti.y == 3);
            c4 += (ti.x == 4) + (ti.y == 4); c5 += (ti.x == 5) + (ti.y == 5); c6 += (ti.x == 6) + (ti.y == 6); c7 += (ti.x == 7) + (ti.y == 7); }
        cnt[0 * 512 + F.tid] = c0; cnt[1 * 512 + F.tid] = c1; cnt[2 * 512 + F.tid] = c2; cnt[3 * 512 + F.tid] = c3;
        cnt[4 * 512 + F.tid] = c4; cnt[5 * 512 + F.tid] = c5; cnt[6 * 512 + F.tid] = c6; cnt[7 * 512 + F.tid] = c7; }
    __syncthreads();
    {   LAS int* ce = cnt + F.wave * 512 + F.lane * 8;
        int v[8], s = 0;
#pragma unroll
        for (int q = 0; q < 8; ++q) { v[q] = ce[q]; s += v[q]; }
        int inc = s;
#pragma unroll
        for (int d = 1; d < 64; d <<= 1) { const int y = __shfl_up(inc, d); if (F.lane >= d) inc += y; }
        int run = inc - s;
#pragma unroll
        for (int q = 0; q < 8; ++q) { ce[q] = run; run += v[q]; }
        if (F.lane == 63) tot[F.wave] = inc; }
    __syncthreads();
    int seg[8]; { int a = 0;
#pragma unroll
        for (int e = 0; e < 8; ++e) { seg[e] = a; a += (tot[e] + 255) & ~255; } }
    if (blockIdx.x == 0 && F.tid < 8) __hip_atomic_store(F.ctl + CW_MOECNT + F.tid, (unsigned)tot[F.tid], RLX_AGENT);
    for (int u = blockIdx.x; u < NCHUNK; u += F.G) {
        if (F.wave == 0) {
            const int tk = 64 * u + F.lane, tp = tk >> 5; const int2 ti = topi[tk];
            const unsigned long long low = ((1ull << F.lane) - 1ull) & (F.lane >= 32 ? 0xFFFFFFFF00000000ull : 0x00000000FFFFFFFFull);
            int s1 = 0, s2 = 0;
#pragma unroll
            for (int e = 0; e < 8; ++e) { const unsigned long long mk = __ballot(ti.x == e || ti.y == e); const int within = __popcll(mk & low); const int pos = seg[e] + cnt[e * 512 + tp] + within;
                if (ti.x == e) s1 = pos; if (ti.y == e) s2 = pos; }
            ((int2*)(F.ws + WS_SLOT))[tk] = make_int2(s1, s2);
            slot_l[F.lane * 2] = s1; slot_l[F.lane * 2 + 1] = s2;
        }
        __syncthreads();
        {   v4u ra[8];
#pragma unroll
            for (int j = 0; j < 8; ++j) ra[j] = ((const v4u*)(xn + (size_t)(64 * u + F.wave * 8 + j) * D))[F.lane];
#pragma unroll
            for (int j = 0; j < 8; ++j) { const int s1 = slot_l[(F.wave * 8 + j) * 2], s2 = slot_l[(F.wave * 8 + j) * 2 + 1];
                ((v4u*)(xs + (size_t)s1 * D))[F.lane] = ra[j]; ((v4u*)(xs + (size_t)s2 * D))[F.lane] = ra[j]; }
        }
        __syncthreads();
    }
}
template <bool TS> struct MoeOrder {
    static constexpr bool VARK = TS;
    int nM, nN, G, c; int cs[9]; int nfull, nsplit, ntk, parts;
    __device__ __forceinline__ void init(unsigned* cntw, int nN_, int G_, int c_, int ntk_) { nN = nN_; G = G_; c = c_; ntk = ntk_; cs[0] = 0;
#pragma unroll
        for (int e = 0; e < 8; ++e) cs[e + 1] = cs[e] + (int)((__hip_atomic_load(cntw + e, RLX_AGENT) + 255u) >> 8);
        nM = cs[8]; const int total = nM * nN; nfull = TS ? (total / G) * G : total; nsplit = total - nfull;
        if (nsplit > 32) { nfull = total; nsplit = 0; }
        parts = 2; }
    __device__ __forceinline__ bool next(int i, pg8::Unit& u) const {
        const long L = (long)i * G + c; if (L >= (long)nfull + parts * nsplit) return false;
        int base = (int)L; u.nt = ntk; u.koff = 0; u.aux = -1;
        if (TS && L >= nfull) { const int q = ((int)L - nfull) / parts, part = ((int)L - nfull) % parts; base = nfull + q; u.nt = ntk / parts; u.koff = part * (ntk / parts) * 128; u.aux = part ? q * 3 + part - 1 : -1; }
        pg8::order_map(base, nM, nN, u);
        int e = 0;
#pragma unroll
        for (int k = 1; k < 8; ++k) e += (u.pm >= cs[k]) ? 1 : 0;
        u.pn += e * nN; return true; }
    __device__ __forceinline__ void a_ready(const pg8::Unit&) const {}
    __device__ __forceinline__ void done(const pg8::Unit&) const {}
};
__device__ __forceinline__ void final_rows(const Frame& F) {
    const int gw = F.vcu * NWAVES + F.wave, NGW = F.G * NWAVES;
    const bf16* H = (const bf16*)(F.ws + WS_XN); const bf16* ys = (const bf16*)(F.ws + WS_YS); const bf16* y2 = (const bf16*)(F.ws + WS_Y2);
    const int2* slot = (const int2*)(F.ws + WS_SLOT); const float2* tw = (const float2*)(F.ws + WS_TOPW);
    LAS int* stab = (LAS int*)F.lds;
    int nside;
    { MoeOrder<true> S; S.init(F.ctl + CW_MOECNT, D / 256, F.G, 0, FF / 128); nside = S.parts - 1;
      for (int i = F.tid; i < S.nM * 4; i += NTHR) stab[i] = -1;
      __syncthreads();
      for (int q = F.tid; q < S.nsplit; q += NTHR) { pg8::Unit u; pg8::order_map(S.nfull + q, S.nM, 4, u); stab[u.pm * 4 + u.pn] = q; }
      __syncthreads(); }
    f32x4 gv[4];
#pragma unroll
    for (int j = 0; j < 4; ++j) gv[j] = ((const f32x4*)F.in[I_FINAL_NORM])[F.lane + 64 * j];
    for (int m = gw; m < M; m += NGW) {
        const int2 sl = slot[m]; const float2 w = tw[m];
        const v2u* xr = (const v2u*)(H + (size_t)m * D) + F.lane;
        const v2u* y1p = (const v2u*)(ys + (size_t)sl.x * D) + F.lane; const v2u* y2p = (const v2u*)(ys + (size_t)sl.y * D) + F.lane;
        f32x4 v[4]; float s = 0.f;
#pragma unroll
        for (int j = 0; j < 4; ++j) { const v2u a = y1p[64 * j], b = y2p[64 * j];
            f32x4 ya = (f32x4){bfl(a.x), bfh(a.x), bfl(a.y), bfh(a.y)}, yb = (f32x4){bfl(b.x), bfh(b.x), bfl(b.y), bfh(b.y)};
            const int qa = stab[(sl.x >> 8) * 4 + j], qb = stab[(sl.y >> 8) * 4 + j];
            if (qa >= 0) { for (int pc = 0; pc < nside; ++pc) { const v2u t = *((const v2u*)(y2 + (size_t)(qa * 3 + pc) * 65536 + (size_t)(sl.x & 255) * 256) + F.lane); ya += (f32x4){bfl(t.x), bfh(t.x), bfl(t.y), bfh(t.y)}; } }
            if (qb >= 0) { for (int pc = 0; pc < nside; ++pc) { const v2u t = *((const v2u*)(y2 + (size_t)(qb * 3 + pc) * 65536 + (size_t)(sl.y & 255) * 256) + F.lane); yb += (f32x4){bfl(t.x), bfh(t.x), bfl(t.y), bfh(t.y)}; } }
            const v2u hx = xr[64 * j];
            v[j] = (f32x4){bfl(hx.x), bfh(hx.x), bfl(hx.y), bfh(hx.y)} + w.x * ya + w.y * yb;
            s += (v[j].x * v[j].x + v[j].y * v[j].y) + (v[j].z * v[j].z + v[j].w * v[j].w); }
        const float rstd = 1.0f / sqrtf(wave_sum(s) * (1.0f / D) + EPS);
        f32x4* o = (f32x4*)(F.out + (size_t)m * D) + F.lane;
#pragma unroll
        for (int j = 0; j < 4; ++j) o[64 * j] = v[j] * rstd * gv[j];
    }
}

constexpr int RTAB_OFF = MISC_OFF + 1024;
__device__ __forceinline__ void build_rstd_tables(const Frame& F, const pg8::StaticOrder& S, const float* ssp) {
    LAS float* rtab = (LAS float*)(F.lds + RTAB_OFF);
    const int r = F.tid & 255, ih = F.tid >> 8;
    f32x4 pa[4][4]; bool ok[4];
#pragma unroll
    for (int k = 0; k < 4; ++k) { pg8::Unit u; ok[k] = S.next(2 * k + ih, u); const int pm = ok[k] ? u.pm : 0;
        const f32x4* p = (const f32x4*)(ssp + (size_t)(pm * 256 + r) * 16);
#pragma unroll
        for (int q = 0; q < 4; ++q) pa[k][q] = p[q]; }
#pragma unroll
    for (int k = 0; k < 4; ++k) if (ok[k]) {
        const float P0 = (pa[k][0][0] + pa[k][0][1]) + (pa[k][0][2] + pa[k][0][3]), P1 = (pa[k][1][0] + pa[k][1][1]) + (pa[k][1][2] + pa[k][1][3]);
        const float P2 = (pa[k][2][0] + pa[k][2][1]) + (pa[k][2][2] + pa[k][2][3]), P3 = (pa[k][3][0] + pa[k][3][1]) + (pa[k][3][2] + pa[k][3][3]);
        rtab[(2 * k + ih) * 256 + r] = __builtin_amdgcn_rsqf(((P0 + P1) + (P2 + P3)) * (1.0f / 1024.0f) + 1e-6f); }
    __syncthreads();
}

#ifndef PHMASK
#define PHMASK 0xFFFFu
#endif
#define EN(b) ((PHMASK >> (b)) & 1u)
#ifndef PROBE_MASK
#define PROBE_MASK 0u
#endif
#define NREP(b) (1 + (int)((PROBE_MASK >> (b)) & 1u))
constexpr int PH_PRO = 0, PH_L = 1, PH_PER_LAYER = 10, PH_FINAL = 21, NPH = 22;
__global__ void __launch_bounds__(NTHR, 2) mk_fwd(Args args) {
    extern __shared__ __attribute__((aligned(16))) unsigned char lds_raw[];
    Frame F;
    F.lds = (LAS unsigned char*)lds_raw;
    F.tid = threadIdx.x; F.lane = F.tid & 63; F.wave = __builtin_amdgcn_readfirstlane(F.tid >> 6);
    F.G = gridDim.x; { const int bx = blockIdx.x; F.vcu = (F.G % 8 == 0) ? (bx % 8) * (F.G / 8) + bx / 8 : bx; }
    F.ws = args.ws; F.ctl = (unsigned*)(args.ws + WS_CTL); F.in = args.in; F.out = args.out;
    volatile LAS unsigned* MISC = (volatile LAS unsigned*)(F.lds + MISC_OFF);
    for (int u = F.tid; u < (LDS_BYTES - MISC_OFF) / 4; u += NTHR) MISC[u] = 0u;
    __syncthreads();
    const int lo = args.ph_lo, hi = args.ph_hi;
    XcdBarrier bar; bar.bar = F.ctl + CW_BAR; bar.x = 0; bar.st = nullptr;
    if (hi - lo > 1) bar = xcd_barrier_post(F.ctl + CW_BAR, MISC + 8);
#define IN(k) (lo <= (k) && (k) < hi)
#define FRESH() do { int tz_ = threadIdx.x; asm volatile("" : "+v"(tz_)); F.tid = tz_; F.lane = tz_ & 63; F.wave = __builtin_amdgcn_readfirstlane(tz_ >> 6); } while (0)
#define SEAM(k) do { if (IN(k) && IN((k) + 1)) xcd_barrier(bar); } while (0)
    unsigned char* ws = args.ws;
    bf16* XN = (bf16*)(ws + WS_XN); bf16* PROJ = (bf16*)(ws + WS_BIG);

    if (EN(0) && IN(PH_PRO)) { FRESH(); for (int rep = 0; rep < NREP(0); ++rep) { convert_jobs(F, 0, 1, F.vcu * NWAVES + F.wave, F.G * NWAVES); convert_jobs(F, 39, 40, F.vcu * NWAVES + F.wave, F.G * NWAVES); }   ssm_tables(F); for (int rep = 0; rep < NREP(6); ++rep) cast_rows(F, F.in[I_X], XN); }
    SEAM(PH_PRO);
    for (int l = 0; l < 2; ++l) {
        const int pb = PH_L + l * PH_PER_LAYER;
        unsigned char* wl = ws + (size_t)l * WS_LSTRIDE;
        F.ycat_off = l ? WS_YCAT1 : WS_YCAT0;
        bf16* YCAT = (bf16*)(ws + F.ycat_off); bf16* MERGED = (bf16*)(ws + (l ? WS_MERGED1 : WS_MERGED0));
        if (EN(1) && IN(pb + 0)) {
            pg8::Gemm g{XN, (const bf16*)(wl + WS_WIN0), M, C_G, D}; pg8::StaticOrder S; S.init(M, C_G, F.G, (int)blockIdx.x);
            FRESH(); build_rstd_tables(F, S, (const float*)(ws + WS_SSP));
            pg8::EpiProj E{PROJ, INC, 1 << 30, (const float*)(ws + WS_SSP), (const LAS float*)(F.lds + RTAB_OFF), 0, 1.f};
            for (int rep = 0; rep < NREP(1); ++rep) pg8::gemm_phase<pg8::EpiProj, pg8::StaticOrder, true, true>(F.lds, g, S, E);
            const int nfull = S.nwg % F.G;
            if (nfull != 0) { FRESH(); const int widx = ((int)blockIdx.x >= nfull) ? ((int)blockIdx.x - nfull) * NWAVES + F.wave : -1, nw = (F.G - nfull) * NWAVES;
                if (l == 0) { convert_jobs(F, 1, 15, widx, nw); convert_jobs(F, 40, 41, widx, nw); } else convert_jobs(F, 23, 27, widx, nw); }
            else { FRESH(); const int widx = F.vcu * NWAVES + F.wave, nw = F.G * NWAVES; if (l == 0) { convert_jobs(F, 1, 15, widx, nw); convert_jobs(F, 40, 41, widx, nw); } else convert_jobs(F, 23, 27, widx, nw); }
            __syncthreads();
            pg8::Gemm g8{(const bf16*)(ws + WS_HB8), (const bf16*)(wl + WS_WING8), M, INC - C_G, D / 2}; pg8::StaticOrder S8; S8.init(M, INC - C_G, F.G, (int)blockIdx.x);
            FRESH(); build_rstd_tables(F, S8, (const float*)(ws + WS_SSP));
            pg8::EpiProj E8{PROJ, INC, 0, (const float*)(ws + WS_SSP), (const LAS float*)(F.lds + RTAB_OFF), C_G, 1.0f / (SC_XS * SC_W)};
            for (int rep = 0; rep < NREP(1); ++rep) pg8::gemm_phase<pg8::EpiProj, pg8::StaticOrder, true, true, true>(F.lds, g8, S8, E8);
        }
        SEAM(pb + 0);
        if (EN(2) && IN(pb + 1)) { FRESH(); mixer_b(F, l, NREP(9), NREP(2)); }
        SEAM(pb + 1);
        if (EN(3) && IN(pb + 2)) { FRESH(); for (int rep = 0; rep < NREP(3); ++rep) for (int u = blockIdx.x; u < NCHUNK; u += F.G) ssm_pass2_unit(F, l, u); }
        SEAM(pb + 2);
        if (EN(4) && IN(pb + 3)) {
            pg8::Gemm g{YCAT, (const bf16*)(wl + WS_WCAT0), M, D, D}; pg8::StaticOrder S; S.init(M, D, F.G, (int)blockIdx.x);
            pg8::EpiBranch E{PROJ + C_G, INC, MERGED, D};
            for (int rep = 0; rep < NREP(4); ++rep) pg8::gemm_phase<pg8::EpiBranch, pg8::StaticOrder, false, true>(F.lds, g, S, E);
        }
        SEAM(pb + 3);
        if (EN(5) && IN(pb + 4)) {
            pg8::Gemm g{MERGED, (const bf16*)(wl + WS_WOUT0), M, D, D}; pg8::StaticOrder S; S.init(M, D, F.G, (int)blockIdx.x);
            if (l == 0) { pg8::EpiResid<1, false> E{F.in[I_X], (pg8::bf16_t*)XN, D, (float*)(ws + WS_SSP), nullptr, 1.f};
                pg8::gemm_phase<pg8::EpiResid<1, false>, pg8::StaticOrder, false, true>(F.lds, g, S, E); }
            else { for (int rep = 0; rep < NREP(5); ++rep) { pg8::EpiResid<0, true> E{XN, (rep + 1 < NREP(5)) ? (pg8::bf16_t*)PROJ : (pg8::bf16_t*)XN, D, nullptr, nullptr, 1.f};
                pg8::gemm_phase<pg8::EpiResid<0, true>, pg8::StaticOrder, false, true>(F.lds, g, S, E); } }
        }
        SEAM(pb + 4);
        if (l == 0) {
            if (EN(7) && IN(pb + 6)) {
                pg8::Gemm g{XN, (const bf16*)(ws + WS_WGU0), M, 2 * FF, D}; pg8::StaticOrder S; S.init(M, 2 * FF, F.G, (int)blockIdx.x);
                FRESH(); build_rstd_tables(F, S, (const float*)(ws + WS_SSP));
                pg8::EpiSwiglu<true> E{PROJ, FF, 2 * FF / 256, (const float*)(ws + WS_SSP), (const LAS float*)(F.lds + RTAB_OFF)};
                for (int rep = 0; rep < NREP(7); ++rep) pg8::gemm_phase<pg8::EpiSwiglu<true>, pg8::StaticOrder, true, true>(F.lds, g, S, E);
            }
            SEAM(pb + 6);
            if (EN(8) && IN(pb + 7)) {
                pg8::Gemm g{PROJ, (const bf16*)(ws + WS_WD0), M, D, FF}; pg8::StaticOrder S; S.init(M, D, F.G, (int)blockIdx.x);
                pg8::EpiResid<3, true> E{XN, (pg8::bf16_t*)XN, D, (float*)(ws + WS_SSP), ws + WS_HB8, SC_XS};
                pg8::gemm_phase<pg8::EpiResid<3, true>, pg8::StaticOrder, false, true>(F.lds, g, S, E);
            }
            SEAM(pb + 7);
        } else {
            if (EN(10) && IN(pb + 5)) { FRESH(); for (int rep = 0; rep < NREP(6); ++rep) { norm_rows<true>(F, XN, F.in[I_NORM_FFN] + D, (bf16*)(ws + WS_XNN)); __syncthreads(); } for (int rep = 0; rep < NREP(0); ++rep) { convert_jobs(F, 15, 23, F.vcu * NWAVES + F.wave, F.G * NWAVES); convert_jobs(F, 27, 39, F.vcu * NWAVES + F.wave, F.G * NWAVES); } }
            SEAM(pb + 5);
            if (EN(11) && IN(pb + 6)) { FRESH(); for (int rep = 0; rep < NREP(11); ++rep) moe_gather(F); }
            SEAM(pb + 6);
            if (EN(12) && IN(pb + 7)) {
                pg8::Gemm g{(const bf16*)(ws + WS_XS), (const bf16*)(ws + WS_WMOE), MPAD, 2 * FF, D / 2}; MoeOrder<false> S; S.init(F.ctl + CW_MOECNT, 2 * FF / 256, F.G, (int)blockIdx.x, D / 128);
                pg8::EpiSwiglu8 E{ws + WS_ACTM, FF, 2 * FF / 256, -1.4426950408889634f / (SC_XS * SC_W), (SC_XS * SC_W) * (SC_XS * SC_W) / SC_ACT};
                for (int rep = 0; rep < NREP(12); ++rep) pg8::gemm_phase<pg8::EpiSwiglu8, MoeOrder<false>, true, true, true>(F.lds, g, S, E);
            }
            if (IN(pb + 7) && IN(pb + 9)) xcd_barrier(bar);
            if (EN(14) && IN(pb + 9)) {
                pg8::Gemm g{(const bf16*)(ws + WS_ACTM), (const bf16*)(ws + WS_WD8), MPAD, D, FF / 2}; MoeOrder<true> S; S.init(F.ctl + CW_MOECNT, D / 256, F.G, (int)blockIdx.x, FF / 128);
                pg8::EpiMoeDown E{(bf16*)(ws + WS_YS), D, D / 256, (bf16*)(ws + WS_Y2), 1.0f / (SC_ACT * SC_W)};
                for (int rep = 0; rep < NREP(14); ++rep) pg8::gemm_phase<pg8::EpiMoeDown, MoeOrder<true>, true, true, true>(F.lds, g, S, E);
            }
            SEAM(pb + 9);
        }
    }
    if (EN(15) && IN(PH_FINAL)) { FRESH(); for (int rep = 0; rep < NREP(15); ++rep) final_rows(F); }
#undef IN
#undef SEAM
}

extern "C" void kernel_launch(void* const* d_in, const int* in_sizes, int n_in, void* d_out, int out_size, void* d_ws, size_t ws_size, hipStream_t stream) {
    static int grid = 0;
    if (grid == 0) {
        if (n_in != 26 || in_sizes[0] != M * D || out_size != M * D || ws_size < WS_END) { fprintf(stderr, "kernel_launch: unexpected shapes (n_in %d, in0 %d, out %d, ws %zu < %zu); nothing launched\n", n_in, n_in > 0 ? in_sizes[0] : -1, out_size, ws_size, (size_t)WS_END); grid = -1; return; }
        int dev = 0, cus = 0;
        if (hipGetDevice(&dev) != hipSuccess || hipDeviceGetAttribute(&cus, hipDeviceAttributeMultiprocessorCount, dev) != hipSuccess) { fprintf(stderr, "kernel_launch: device query failed\n"); grid = -1; return; }
        if (hipFuncSetAttribute((const void*)mk_fwd, hipFuncAttributeMaxDynamicSharedMemorySize, LDS_BYTES) != hipSuccess) { fprintf(stderr, "kernel_launch: hipFuncSetAttribute failed\n"); grid = -1; return; }
        int per_cu = 0;
        if (hipOccupancyMaxActiveBlocksPerMultiprocessor(&per_cu, (const void*)mk_fwd, NTHR, LDS_BYTES) != hipSuccess || per_cu < 1) fprintf(stderr, "kernel_launch: occupancy query reports %d blocks per CU\n", per_cu);
        (void)hipGetLastError();
        grid = cus;
    }
    if (grid < 0) return;
    if (hipMemsetAsync((char*)d_ws + WS_CTL, 0, CTL_ZERO_BYTES, stream) != hipSuccess) { fprintf(stderr, "kernel_launch: memset failed\n"); return; }
    Args a{};
    for (int i = 0; i < 26; ++i) a.in[i] = (const float*)d_in[i];
    a.out = (float*)d_out; a.ws = (unsigned char*)d_ws;
#if MK_ONE_LAUNCH
    a.ph_lo = 0; a.ph_hi = NPH;
    hipLaunchKernelGGL(mk_fwd, dim3(grid), dim3(NTHR), LDS_BYTES, stream, a);
#else
    for (int ph = 0; ph < NPH; ++ph) {
        if (ph == PH_L + 9) continue;
        a.ph_lo = ph; a.ph_hi = ph + 1;
        hipLaunchKernelGGL(mk_fwd, dim3(grid), dim3(NTHR), LDS_BYTES, stream, a);
    }
#endif
    const hipError_t le = hipPeekAtLastError();
    if (le != hipSuccess) fprintf(stderr, "kernel_launch: launch failed: %s\n", hipGetErrorName(le));
}
```

```cpp
#include <hip/hip_runtime.h>
#include <cstdio>
#include <cstdint>

#ifndef MK_ONE_LAUNCH
#define MK_ONE_LAUNCH 1
#endif

namespace pg8 {
#define PG8_LAS __attribute__((address_space(3)))
typedef unsigned short bf16_t;
typedef short bf16x8 __attribute__((ext_vector_type(8)));
typedef float f32x4 __attribute__((ext_vector_type(4)));
typedef float f32x2 __attribute__((ext_vector_type(2)));
typedef unsigned u32x4 __attribute__((ext_vector_type(4)));
constexpr int BM = 256, BK = 64, HALF = 128, HTB = HALF * BK * 2  , STAGE_BYTES = 8 * HTB, NXCD = 8, WGM = 8;

__host__ __device__ __forceinline__ int lds_byte(int r, int c) { const int st = (r >> 4) * 2 + (c >> 5), rr = r & 15, cc = c & 31, ob = rr * 64 + cc * 2; return st * 1024 + (ob ^ (((ob >> 9) & 1) << 5)); }
__host__ __device__ __forceinline__ void stage_rc(int b, int& R, int& C) { const int st = b / 1024, sb = b % 1024, swz = sb ^ (((sb >> 9) & 1) << 5); R = (st >> 1) * 16 + swz / 64; C = (st & 1) * 32 + (swz % 64) / 2; }
__host__ __device__ __forceinline__ int perm32(int rho) { const int n = rho >> 4, i = rho & 15; return 8 * (i >> 2) + 4 * n + (i & 3); }

struct Unit { int pm, pn; int nt, koff, aux; };
struct Gemm { const bf16_t* A; const bf16_t* Bt; int M, N, K; };

__host__ __device__ __forceinline__ void order_map(int L, int nM, int nN, Unit& u) {
    const int nwg = nM * nN;
    int wgid = L; { const int q = nwg / NXCD, r = nwg % NXCD, xcd = wgid % NXCD, off = wgid / NXCD; wgid = (xcd < r ? xcd * (q + 1) : r * (q + 1) + (xcd - r) * q) + off; }
    const int nig = WGM * nN, gid = wgid / nig, fm = gid * WGM, gsz = (nM - fm) < WGM ? (nM - fm) : WGM;
    u.pm = fm + ((wgid % nig) % gsz); u.pn = (wgid % nig) / gsz;
}
struct StaticOrder {
    static constexpr bool VARK = false;
    int nM, nN, nwg, G, c;
    __host__ __device__ void init(int M, int N, int G_, int c_) { nM = M / BM; nN = N / BM; nwg = nM * nN; G = G_; c = c_; }
    __host__ __device__ bool next(int i, Unit& u) const {
        const long L = (long)i * G + c; if (L >= nwg) return false;
        order_map((int)L, nM, nN, u); u.aux = i; return true;
    }
    __device__ __forceinline__ void a_ready(const Unit&) const {}
    __device__ __forceinline__ void done(const Unit&) const {}
};
typedef __bf16 bf16x2n __attribute__((ext_vector_type(2)));
__device__ __forceinline__ unsigned cvt_pk_bf16(float lo, float hi) { const f32x2 v = {lo, hi}; return __builtin_bit_cast(unsigned, __builtin_convertvector(v, bf16x2n)); }

template <class Epi, class Sched, bool ALIGN_EPI = false, bool SP2 = false, bool FP8 = false>
__device__ __forceinline__ void gemm_phase(PG8_LAS unsigned char* lds, const Gemm g, const Sched& S, const Epi& E) {
    int tid_ = threadIdx.x; asm volatile("" : "+v"(tid_));
    const int tid = tid_, wid = __builtin_amdgcn_readfirstlane(tid >> 6), lane = tid & 63, wr = wid >> 2, wc = wid & 3, fr = lane & 15, fq = lane >> 4;
    const int K = g.K, nt = K / BK;
    unsigned voffA[2], voffB[2];
#pragma unroll
    for (int i = 0; i < 2; ++i) { int R, C; stage_rc(tid * 16 + i * 8192, R, C); const int Rb = Epi::PERM ? ((R & ~31) + perm32(R & 31)) : R;
        voffA[i] = (unsigned)(R * K + C) * 2u; voffB[i] = (unsigned)(Rb * K + C) * 2u; }
    const size_t kstep = (size_t)(BK * 2);
    const size_t hstep = (size_t)HALF * K * 2;
    const size_t tstep = 2 * hstep;
    const unsigned ldsw = (unsigned)wid * 1024u;
    const int aoff = lds_byte(wr * 64 + fr, fq * 8), boff = lds_byte(wc * 32 + fr, fq * 8);
#define PG8_SA(b, h) (((b) * 2 + (h)) * HTB)
#define PG8_SB(b, h) ((4 + (b) * 2 + (h)) * HTB)
#define PG8_STAGE(bufoff, gbase, voff) do { _Pragma("unroll") for (int _i = 0; _i < 2; ++_i) \
        __builtin_amdgcn_global_load_lds((const unsigned*)((const char*)(gbase) + (voff)[_i]), (PG8_LAS unsigned*)(lds + (bufoff) + ldsw + _i * 8192), 16, 0, 0); } while (0)
#define PG8_LDA(dst, b, h) do { _Pragma("unroll") for (int m = 0; m < 4; ++m) { if constexpr (FP8) { dst##w[m] = __builtin_shufflevector(*(const PG8_LAS bf16x8*)(lds + PG8_SA(b, h) + aoff + m * 2048), *(const PG8_LAS bf16x8*)(lds + PG8_SA(b, h) + aoff + m * 2048 + 1024), 0, 1, 2, 3, 4, 5, 6, 7, 8, 9, 10, 11, 12, 13, 14, 15); } \
        else { _Pragma("unroll") for (int k = 0; k < 2; ++k) dst[m][k] = *(const PG8_LAS bf16x8*)(lds + PG8_SA(b, h) + aoff + m * 2048 + k * 1024); } } } while (0)
#define PG8_LDB(dst, b, h) do { _Pragma("unroll") for (int n = 0; n < 2; ++n) { if constexpr (FP8) { dst##w[n] = __builtin_shufflevector(*(const PG8_LAS bf16x8*)(lds + PG8_SB(b, h) + boff + n * 2048), *(const PG8_LAS bf16x8*)(lds + PG8_SB(b, h) + boff + n * 2048 + 1024), 0, 1, 2, 3, 4, 5, 6, 7, 8, 9, 10, 11, 12, 13, 14, 15); } \
        else { _Pragma("unroll") for (int k = 0; k < 2; ++k) dst[n][k] = *(const PG8_LAS bf16x8*)(lds + PG8_SB(b, h) + boff + n * 2048 + k * 1024); } } } while (0)
#define PG8_MMA(ai, bj, At, Bt) do { __builtin_amdgcn_s_setprio(1); _Pragma("unroll") for (int m = 0; m < 4; ++m) _Pragma("unroll") for (int n = 0; n < 2; ++n) { \
        if constexpr (FP8) { typedef int v8i_ __attribute__((ext_vector_type(8))); \
            asm volatile("v_mfma_scale_f32_16x16x128_f8f6f4 %0, %1, %2, %0, %3, %3 op_sel_hi:[0,0,0]" : "+v"(acc[ai][bj][m][n]) : "v"(__builtin_bit_cast(v8i_, Bt##w[n])), "v"(__builtin_bit_cast(v8i_, At##w[m])), "v"(sc8)); } \
        else { _Pragma("unroll") for (int k = 0; k < 2; ++k) acc[ai][bj][m][n] = __builtin_amdgcn_mfma_f32_16x16x32_bf16(Bt[n][k], At[m][k], acc[ai][bj][m][n], 0, 0, 0); } } \
        __builtin_amdgcn_s_setprio(0); } while (0)
#define PG8_WAIT_V(n) asm volatile("s_waitcnt vmcnt(" #n ")" ::: "memory")
#define PG8_WAIT_L(n) asm volatile("s_waitcnt lgkmcnt(" #n ")" ::: "memory")
#define PG8_BAR __builtin_amdgcn_s_barrier()
#define PG8_SCHED __builtin_amdgcn_sched_barrier(0)
    Unit cur, nxt; int ui = 0;
    if (!S.next(0, cur)) return;
    f32x4 acc[2][2][4][2];
#pragma unroll
    for (int a = 0; a < 2; ++a)
#pragma unroll
        for (int b = 0; b < 2; ++b)
#pragma unroll
            for (int m = 0; m < 4; ++m)
#pragma unroll
                for (int n = 0; n < 2; ++n) acc[a][b][m][n] = (f32x4){0.f, 0.f, 0.f, 0.f};
    bf16x8 At[4][2], B0[2][2], B1[2][2];
    typedef short bf16x16_ __attribute__((ext_vector_type(16))); bf16x16_ Atw[4], B0w[2], B1w[2];
    unsigned sc8 = 0x7F7F7F7Fu; asm volatile("" : "+v"(sc8));
    const char* cA = (const char*)g.A + (size_t)cur.pm * tstep; const char* cB = (const char*)g.Bt + (size_t)cur.pn * tstep;
    int cnt = nt;
    if constexpr (Sched::VARK) { cnt = cur.nt; cA += cur.koff; cB += cur.koff; }
    S.a_ready(cur);
    if constexpr (SP2) {
        PG8_STAGE(PG8_SB(0, 0), cB, voffB); PG8_STAGE(PG8_SB(0, 1), cB + hstep, voffB); PG8_STAGE(PG8_SA(0, 0), cA, voffA); PG8_STAGE(PG8_SA(0, 1), cA + hstep, voffA);
        if (wr == 1) PG8_BAR;
        PG8_WAIT_V(2); PG8_BAR;
        PG8_STAGE(PG8_SB(1, 0), cB + kstep, voffB); PG8_STAGE(PG8_SA(1, 0), cA + kstep, voffA); PG8_STAGE(PG8_SB(1, 1), cB + hstep + kstep, voffB);
        PG8_WAIT_V(6); PG8_BAR;
    } else {
        PG8_STAGE(PG8_SB(0, 0), cB, voffB); PG8_STAGE(PG8_SA(0, 0), cA, voffA); PG8_STAGE(PG8_SB(0, 1), cB + hstep, voffB); PG8_STAGE(PG8_SA(0, 1), cA + hstep, voffA);
        if (wr == 1) PG8_BAR;
        PG8_WAIT_V(4); PG8_BAR;
        PG8_STAGE(PG8_SB(1, 0), cB + kstep, voffB); PG8_STAGE(PG8_SA(1, 0), cA + kstep, voffA); PG8_STAGE(PG8_SB(1, 1), cB + hstep + kstep, voffB);
        PG8_WAIT_V(6); PG8_BAR;
    }
    for (;;) {
        const bool has_next = S.next(ui + 1, nxt);
        const char* nA = has_next ? (const char*)g.A + (size_t)nxt.pm * tstep : cA; const char* nB = has_next ? (const char*)g.Bt + (size_t)nxt.pn * tstep : cB;
        if constexpr (Sched::VARK) { if (has_next) { nA += nxt.koff; nB += nxt.koff; } }
        for (int t = 0; t < cnt; t += 2) {
            const bool last = (t == cnt - 2);
            const char* a1 = cA + (size_t)(t + 1) * kstep;
            const char* a2 = last ? nA : cA + (size_t)(t + 2) * kstep; const char* b2 = last ? nB : cB + (size_t)(t + 2) * kstep;
            const char* a3 = a2 + kstep; const char* b3 = b2 + kstep;
            if (last && has_next) S.a_ready(nxt);
            if constexpr (Epi::MIDK) { if (t == Epi::MID0 || t == Epi::MID1) { int tz_ = tid; asm volatile("" : "+v"(tz_)); const int ln_ = tz_ & 63; E.mid(acc, cur, t, wr, wc, ln_ & 15, ln_ >> 4); } }
            if constexpr (SP2) {
            PG8_LDB(B0, 0, 0); PG8_LDB(B1, 0, 1); PG8_SCHED; PG8_LDA(At, 0, 0); PG8_STAGE(PG8_SA(1, 1), a1 + hstep, voffA);
            PG8_WAIT_V(8); PG8_WAIT_L(0); PG8_BAR; PG8_MMA(0, 0, At, B0); PG8_MMA(0, 1, At, B1); PG8_BAR; PG8_SCHED;
            PG8_LDA(At, 0, 1); PG8_STAGE(PG8_SB(0, 0), b2, voffB); PG8_STAGE(PG8_SB(0, 1), b2 + hstep, voffB); PG8_STAGE(PG8_SA(0, 0), a2, voffA);
            PG8_WAIT_V(8); PG8_WAIT_L(0); PG8_BAR; PG8_MMA(1, 0, At, B0); PG8_MMA(1, 1, At, B1); PG8_BAR; PG8_SCHED;
            PG8_LDB(B0, 1, 0); PG8_LDB(B1, 1, 1); PG8_SCHED; PG8_LDA(At, 1, 0); PG8_STAGE(PG8_SA(0, 1), a2 + hstep, voffA);
            PG8_WAIT_V(8); PG8_WAIT_L(0); PG8_BAR; PG8_MMA(0, 0, At, B0); PG8_MMA(0, 1, At, B1); PG8_BAR; PG8_SCHED;
            PG8_LDA(At, 1, 1); PG8_STAGE(PG8_SB(1, 0), b3, voffB); PG8_STAGE(PG8_SB(1, 1), b3 + hstep, voffB); PG8_STAGE(PG8_SA(1, 0), a3, voffA);
            PG8_WAIT_V(8); PG8_WAIT_L(0); PG8_BAR; PG8_MMA(1, 0, At, B0); PG8_MMA(1, 1, At, B1); PG8_BAR; PG8_SCHED;
            } else {
            PG8_LDB(B0, 0, 0); PG8_SCHED; PG8_LDA(At, 0, 0); PG8_STAGE(PG8_SA(1, 1), a1 + hstep, voffA);
            PG8_WAIT_L(8); PG8_BAR; PG8_WAIT_L(0); PG8_MMA(0, 0, At, B0); PG8_BAR; PG8_SCHED;
            PG8_LDB(B1, 0, 1); PG8_STAGE(PG8_SB(0, 0), b2, voffB);
            PG8_BAR; PG8_WAIT_L(0); PG8_MMA(0, 1, At, B1); PG8_BAR;
            PG8_LDA(At, 0, 1); PG8_STAGE(PG8_SA(0, 0), a2, voffA);
            PG8_BAR; PG8_WAIT_L(0); PG8_MMA(1, 0, At, B0); PG8_BAR; PG8_SCHED;
            PG8_STAGE(PG8_SB(0, 1), b2 + hstep, voffB);
            PG8_WAIT_V(6); PG8_BAR; PG8_MMA(1, 1, At, B1); PG8_BAR;
            PG8_LDB(B0, 1, 0); PG8_SCHED; PG8_LDA(At, 1, 0); PG8_STAGE(PG8_SA(0, 1), a2 + hstep, voffA);
            PG8_WAIT_L(8); PG8_BAR; PG8_WAIT_L(0); PG8_MMA(0, 0, At, B0); PG8_BAR; PG8_SCHED;
            PG8_LDB(B1, 1, 1); PG8_STAGE(PG8_SB(1, 0), b3, voffB);
            PG8_BAR; PG8_WAIT_L(0); PG8_MMA(0, 1, At, B1); PG8_BAR;
            PG8_LDA(At, 1, 1); PG8_STAGE(PG8_SA(1, 0), a3, voffA);
            PG8_BAR; PG8_WAIT_L(0); PG8_MMA(1, 0, At, B0); PG8_BAR; PG8_SCHED;
            PG8_STAGE(PG8_SB(1, 1), b3 + hstep, voffB);
            PG8_WAIT_V(6); PG8_BAR; PG8_MMA(1, 1, At, B1); PG8_BAR;
            }
        }
        if constexpr (ALIGN_EPI) { if (wr == 0) PG8_BAR; }
        if constexpr (FP8) asm volatile("s_nop 15\n\ts_nop 15" ::: "memory");
        if constexpr (!Epi::AFTER_DRAIN) { int tz_ = tid; asm volatile("" : "+v"(tz_)); const int ln_ = tz_ & 63;
            E(acc, cur, wr, wc, ln_ & 15, ln_ >> 4); S.done(cur); }
        if (!has_next) break;
#pragma unroll
        for (int a = 0; a < 2; ++a)
#pragma unroll
            for (int b = 0; b < 2; ++b)
#pragma unroll
                for (int m = 0; m < 4; ++m)
#pragma unroll
                    for (int n = 0; n < 2; ++n) acc[a][b][m][n] = (f32x4){0.f, 0.f, 0.f, 0.f};
        cur = nxt; cA = nA; cB = nB; ++ui; if constexpr (Sched::VARK) cnt = cur.nt;
        if constexpr (ALIGN_EPI) { if (wr == 1) PG8_BAR; }
    }
    PG8_WAIT_V(0);
    if constexpr (!ALIGN_EPI) { if (wr == 0) PG8_BAR; }
    PG8_BAR;
    if constexpr (Epi::AFTER_DRAIN) { E.fused(acc, cur, wr, wc, fr, fq, lds, wid, lane); S.done(cur); }
#undef PG8_SA
#undef PG8_SB
#undef PG8_STAGE
#undef PG8_LDA
#undef PG8_LDB
#undef PG8_MMA
#undef PG8_WAIT_V
#undef PG8_WAIT_L
#undef PG8_BAR
#undef PG8_SCHED
}

__device__ __forceinline__ float bfl(unsigned w) { return __uint_as_float(w << 16); }
__device__ __forceinline__ float bfh(unsigned w) { return __uint_as_float(w & 0xffff0000u); }
__device__ __forceinline__ float sigmoid_clamped(float l) { l = fminf(fmaxf(l, -30.f), 30.f); return __builtin_amdgcn_rcpf(1.f + __expf(-l)); }
__device__ __forceinline__ float onepexp_clamped(float l) { l = fminf(fmaxf(l, -30.f), 30.f); return 1.f + __expf(-l); }

__device__ __forceinline__ float sum_fq(float x) {
    { const auto r = __builtin_amdgcn_permlane16_swap(__float_as_uint(x), __float_as_uint(x), false, false); x = __uint_as_float(r[0]) + __uint_as_float(r[1]); }
    { const auto r = __builtin_amdgcn_permlane32_swap(__float_as_uint(x), __float_as_uint(x), false, false); x = __uint_as_float(r[0]) + __uint_as_float(r[1]); }
    return x;
}
__device__ __forceinline__ float row_rstd(const float* ssp, int r, int fq) {
    const f32x4 p4 = *(const f32x4*)(ssp + (size_t)r * 16 + 4 * fq);
    float s = (p4[0] + p4[1]) + (p4[2] + p4[3]);
    s = sum_fq(s);
    return __builtin_amdgcn_rsqf(s * (1.0f / 1024.0f) + 1e-6f);
}
__device__ __forceinline__ void row_rstd8(const float* ssp, int row0, int fq, float (&rs)[2][4]) {
    f32x4 p4[2][4];
#pragma unroll
    for (int ai = 0; ai < 2; ++ai)
#pragma unroll
        for (int m = 0; m < 4; ++m) p4[ai][m] = *(const f32x4*)(ssp + (size_t)(row0 + ai * HALF + m * 16) * 16 + 4 * fq);
#pragma unroll
    for (int ai = 0; ai < 2; ++ai)
#pragma unroll
        for (int m = 0; m < 4; ++m) { float s = (p4[ai][m][0] + p4[ai][m][1]) + (p4[ai][m][2] + p4[ai][m][3]); s = sum_fq(s); rs[ai][m] = __builtin_amdgcn_rsqf(s * (1.0f / 1024.0f) + 1e-6f); }
}
__device__ __forceinline__ void rstd8(const PG8_LAS float* rtab, const float* ssp, const Unit& u, int row0, int rloc, int fq, float (&rs)[2][4]) {
    if (u.aux < 8) {
#pragma unroll
        for (int ai = 0; ai < 2; ++ai)
#pragma unroll
            for (int m = 0; m < 4; ++m) rs[ai][m] = rtab[u.aux * 256 + rloc + ai * HALF + m * 16];
    } else row_rstd8(ssp, row0, fq, rs);
}
struct EpiStoreBf16 {
    static constexpr bool PERM = true, AFTER_DRAIN = false, MIDK = false; static constexpr int MID0 = -1, MID1 = -1;
    bf16_t* O; int ldc; int nct;
    __device__ __forceinline__ void operator()(const f32x4 (&acc)[2][2][4][2], const Unit& u, int wr, int wc, int fr, int fq) const {
        const int row0 = u.pm * BM + wr * 64 + fr, col0 = (u.pn % nct) * BM + wc * 32 + 8 * fq;
#pragma unroll
        for (int ai = 0; ai < 2; ++ai)
#pragma unroll
            for (int m = 0; m < 4; ++m) { bf16_t* rowp = O + (size_t)(row0 + ai * HALF + m * 16) * ldc + col0;
#pragma unroll
                for (int bj = 0; bj < 2; ++bj) { const f32x4 v0 = acc[ai][bj][m][0], v1 = acc[ai][bj][m][1];
                    u32x4 w; w.x = cvt_pk_bf16(v0[0], v0[1]); w.y = cvt_pk_bf16(v0[2], v0[3]); w.z = cvt_pk_bf16(v1[0], v1[1]); w.w = cvt_pk_bf16(v1[2], v1[3]);
                    *(u32x4*)(rowp + bj * HALF) = w; } }
    }
};
struct EpiProj {
    static constexpr bool PERM = true, AFTER_DRAIN = false, MIDK = false; static constexpr int MID0 = -1, MID1 = -1;
    bf16_t* O; int ldc; int gate_tile0; const float* ssp; const PG8_LAS float* rtab; int col_off; float scale;
    __device__ __forceinline__ void operator()(const f32x4 (&acc)[2][2][4][2], const Unit& u, int wr, int wc, int fr, int fq) const {
        const int row0 = u.pm * BM + wr * 64 + fr, col0 = col_off + u.pn * BM + wc * 32 + 8 * fq;
        const bool gate = u.pn >= gate_tile0;
        float rsv[2][4]; rstd8(rtab, ssp, u, row0, wr * 64 + fr, fq, rsv);
#pragma unroll
        for (int ai = 0; ai < 2; ++ai)
#pragma unroll
            for (int m = 0; m < 4; ++m) { bf16_t* rowp = O + (size_t)(row0 + ai * HALF + m * 16) * ldc + col0;
                const float rs = rsv[ai][m] * scale;
                if (gate) { const float k1 = rs * -1.4426950408889634f;
#pragma unroll
                    for (int bj = 0; bj < 2; ++bj) { u32x4 w;
#pragma unroll
                        for (int q = 0; q < 4; ++q) { const f32x2 a2 = {acc[ai][bj][m][q >> 1][2 * (q & 1)], acc[ai][bj][m][q >> 1][2 * (q & 1) + 1]}; const f32x2 t = a2 * k1;
                            const f32x2 ex = {__builtin_amdgcn_exp2f(__builtin_amdgcn_fmed3f(t.x, -43.280851f, 43.280851f)), __builtin_amdgcn_exp2f(__builtin_amdgcn_fmed3f(t.y, -43.280851f, 43.280851f))};
                            const f32x2 o = ex + 1.0f; w[q] = cvt_pk_bf16(o.x, o.y); }
                        *(u32x4*)(rowp + bj * HALF) = w; } }
                else {
#pragma unroll
                    for (int bj = 0; bj < 2; ++bj) { const f32x4 v0 = acc[ai][bj][m][0] * rs, v1 = acc[ai][bj][m][1] * rs;
                        u32x4 w; w.x = cvt_pk_bf16(v0[0], v0[1]); w.y = cvt_pk_bf16(v0[2], v0[3]); w.z = cvt_pk_bf16(v1[0], v1[1]); w.w = cvt_pk_bf16(v1[2], v1[3]);
                        *(u32x4*)(rowp + bj * HALF) = w; } } }
    }
};
__device__ __forceinline__ unsigned pk4_fp8(float a, float b, float c, float d) {
    a = fminf(fmaxf(a, -448.f), 448.f); b = fminf(fmaxf(b, -448.f), 448.f); c = fminf(fmaxf(c, -448.f), 448.f); d = fminf(fmaxf(d, -448.f), 448.f);
    int p = __builtin_amdgcn_cvt_pk_fp8_f32(a, b, 0, false); p = __builtin_amdgcn_cvt_pk_fp8_f32(c, d, p, true); return (unsigned)p;
}
struct EpiSwiglu8 {
    static constexpr bool PERM = true, AFTER_DRAIN = false, MIDK = false; static constexpr int MID0 = -1, MID1 = -1;
    unsigned char* O; int ldc; int nct; float k1, cden;
    __device__ __forceinline__ void operator()(const f32x4 (&acc)[2][2][4][2], const Unit& u, int wr, int wc, int fr, int fq) const {
        const int row0 = u.pm * BM + wr * 64 + fr, col0 = (u.pn % nct) * HALF + wc * 32 + 8 * fq;
#pragma unroll
        for (int ai = 0; ai < 2; ++ai)
#pragma unroll
            for (int m = 0; m < 4; ++m) { unsigned char* rowp = O + (size_t)(row0 + ai * HALF + m * 16) * ldc + col0;
                float r[8];
#pragma unroll
                for (int n = 0; n < 2; ++n)
#pragma unroll
                    for (int h = 0; h < 2; ++h) { const f32x2 g2 = {acc[ai][0][m][n][2 * h], acc[ai][0][m][n][2 * h + 1]}, u2 = {acc[ai][1][m][n][2 * h], acc[ai][1][m][n][2 * h + 1]};
                        const f32x2 t = g2 * k1; const f32x2 ex = {__builtin_amdgcn_exp2f(t.x), __builtin_amdgcn_exp2f(t.y)}; const f32x2 d = ex * cden + cden;
                        const f32x2 rr = {__builtin_amdgcn_rcpf(d.x), __builtin_amdgcn_rcpf(d.y)}; const f32x2 o = (g2 * u2) * rr; r[n * 4 + 2 * h] = o.x; r[n * 4 + 2 * h + 1] = o.y; }
                typedef unsigned u32x2v __attribute__((ext_vector_type(2))); u32x2v w; w.x = pk4_fp8(r[0], r[1], r[2], r[3]); w.y = pk4_fp8(r[4], r[5], r[6], r[7]);
                *(u32x2v*)rowp = w; }
    }
};
struct EpiMoeDown {
    static constexpr bool PERM = true, AFTER_DRAIN = false, MIDK = false; static constexpr int MID0 = -1, MID1 = -1;
    bf16_t* O; int ldc; int nct; bf16_t* O2; float scale;
    __device__ __forceinline__ void operator()(const f32x4 (&acc)[2][2][4][2], const Unit& u, int wr, int wc, int fr, int fq) const {
        const bool second = u.aux >= 0;
        bf16_t* base = second ? O2 + (size_t)u.aux * 65536 + (size_t)(wr * 64 + fr) * 256 + wc * 32 + 8 * fq
                              : O + (size_t)(u.pm * BM + wr * 64 + fr) * ldc + (u.pn % nct) * BM + wc * 32 + 8 * fq;
        const int ld = second ? 256 : ldc;
#pragma unroll
        for (int ai = 0; ai < 2; ++ai)
#pragma unroll
            for (int m = 0; m < 4; ++m) { bf16_t* rowp = base + (size_t)(ai * HALF + m * 16) * ld;
#pragma unroll
                for (int bj = 0; bj < 2; ++bj) { const f32x4 v0 = acc[ai][bj][m][0] * scale, v1 = acc[ai][bj][m][1] * scale;
                    u32x4 w; w.x = cvt_pk_bf16(v0[0], v0[1]); w.y = cvt_pk_bf16(v0[2], v0[3]); w.z = cvt_pk_bf16(v1[0], v1[1]); w.w = cvt_pk_bf16(v1[2], v1[3]);
                    *(u32x4*)(rowp + bj * HALF) = w; } }
    }
};
template <int NORMOUT, bool BASE16> struct EpiResid {
    static constexpr bool PERM = true, AFTER_DRAIN = false, MIDK = false; static constexpr int MID0 = -1, MID1 = -1;
    const void* base; bf16_t* hb; int ldc; float* ssp; unsigned char* hb8; float hb8_scale; float ascale;
    __device__ __forceinline__ void row_out(const f32x4 (&o)[2][2], size_t off, int r, int pn, int wc, int fq) const {
        float q = 0.f;
#pragma unroll
        for (int bj = 0; bj < 2; ++bj) { const f32x4 o0 = o[bj][0], o1 = o[bj][1];
            if (NORMOUT & 1) q += ((o0[0] * o0[0] + o0[1] * o0[1]) + (o0[2] * o0[2] + o0[3] * o0[3])) + ((o1[0] * o1[0] + o1[1] * o1[1]) + (o1[2] * o1[2] + o1[3] * o1[3]));
            u32x4 w; w.x = cvt_pk_bf16(o0[0], o0[1]); w.y = cvt_pk_bf16(o0[2], o0[3]); w.z = cvt_pk_bf16(o1[0], o1[1]); w.w = cvt_pk_bf16(o1[2], o1[3]); *(u32x4*)(hb + off + bj * HALF) = w;
            if (NORMOUT & 2) { typedef unsigned u32x2v __attribute__((ext_vector_type(2))); u32x2v w8; w8.x = pk4_fp8(o0[0] * hb8_scale, o0[1] * hb8_scale, o0[2] * hb8_scale, o0[3] * hb8_scale); w8.y = pk4_fp8(o1[0] * hb8_scale, o1[1] * hb8_scale, o1[2] * hb8_scale, o1[3] * hb8_scale); *(u32x2v*)(hb8 + off + bj * HALF) = w8; } }
        if (NORMOUT & 1) { q = sum_fq(q); if (fq == 0) ssp[(size_t)r * 16 + 4 * pn + wc] = q; }
    }
    __device__ __forceinline__ void operator()(const f32x4 (&acc)[2][2][4][2], const Unit& u, int wr, int wc, int fr, int fq) const {
        const int row0 = u.pm * BM + wr * 64 + fr, col0 = u.pn * BM + wc * 32 + 8 * fq;
        if constexpr (BASE16) { const bf16_t* b16 = (const bf16_t*)base;
#pragma unroll
            for (int ai = 0; ai < 2; ++ai) { u32x4 bs[4][2];
#pragma unroll
                for (int m = 0; m < 4; ++m)
#pragma unroll
                    for (int bj = 0; bj < 2; ++bj) bs[m][bj] = *(const u32x4*)(b16 + (size_t)(row0 + ai * HALF + m * 16) * ldc + col0 + bj * HALF);
#pragma unroll
                for (int m = 0; m < 4; ++m) { const int r = row0 + ai * HALF + m * 16; f32x4 o[2][2];
#pragma unroll
                    for (int bj = 0; bj < 2; ++bj) { const u32x4 b = bs[m][bj];
                        o[bj][0] = (f32x4){bfl(b.x), bfh(b.x), bfl(b.y), bfh(b.y)} + acc[ai][bj][m][0] * ascale; o[bj][1] = (f32x4){bfl(b.z), bfh(b.z), bfl(b.w), bfh(b.w)} + acc[ai][bj][m][1] * ascale; }
                    row_out(o, (size_t)r * ldc + col0, r, u.pn, wc, fq); }
                asm volatile("" ::: "memory"); }
        } else { const float* b32 = (const float*)base;
#pragma unroll
            for (int ai = 0; ai < 2; ++ai)
#pragma unroll
                for (int mp = 0; mp < 2; ++mp) { f32x4 bs[2][2][2];
#pragma unroll
                    for (int mm = 0; mm < 2; ++mm) { const size_t off = (size_t)(row0 + ai * HALF + (2 * mp + mm) * 16) * ldc + col0;
#pragma unroll
                        for (int bj = 0; bj < 2; ++bj)
#pragma unroll
                            for (int n = 0; n < 2; ++n) bs[mm][bj][n] = *(const f32x4*)(b32 + off + bj * HALF + n * 4); }
#pragma unroll
                    for (int mm = 0; mm < 2; ++mm) { const int r = row0 + ai * HALF + (2 * mp + mm) * 16; f32x4 o[2][2];
#pragma unroll
                        for (int bj = 0; bj < 2; ++bj) { o[bj][0] = bs[mm][bj][0] + acc[ai][bj][2 * mp + mm][0] * ascale; o[bj][1] = bs[mm][bj][1] + acc[ai][bj][2 * mp + mm][1] * ascale; }
                        row_out(o, (size_t)r * ldc + col0, r, u.pn, wc, fq); }
                    asm volatile("" ::: "memory"); }
        }
    }
};
template <bool RS, bool OUT8 = false> struct EpiSwiglu {
    static constexpr bool PERM = true, AFTER_DRAIN = false, MIDK = false; static constexpr int MID0 = -1, MID1 = -1;
    bf16_t* O; int ldc; int nct; const float* ssp; const PG8_LAS float* rtab; float out_scale;
    __device__ __forceinline__ void operator()(const f32x4 (&acc)[2][2][4][2], const Unit& u, int wr, int wc, int fr, int fq) const {
        const int row0 = u.pm * BM + wr * 64 + fr, col0 = (u.pn % nct) * HALF + wc * 32 + 8 * fq;
        float rsv[2][4]; if (RS) rstd8(rtab, ssp, u, row0, wr * 64 + fr, fq, rsv);
#pragma unroll
        for (int ai = 0; ai < 2; ++ai)
#pragma unroll
            for (int m = 0; m < 4; ++m) { bf16_t* rowp = O + (size_t)(row0 + ai * HALF + m * 16) * ldc + col0;
                float r[8]; float rs = 1.f; if (RS) rs = rsv[ai][m];
                const float k1 = rs * -1.4426950408889634f, cden = (RS || OUT8) ? __builtin_amdgcn_rcpf(rs * rs * (OUT8 ? out_scale : 1.f)) : 1.f;
#pragma unroll
                for (int n = 0; n < 2; ++n)
#pragma unroll
                    for (int h = 0; h < 2; ++h) { const f32x2 g2 = {acc[ai][0][m][n][2 * h], acc[ai][0][m][n][2 * h + 1]}, u2 = {acc[ai][1][m][n][2 * h], acc[ai][1][m][n][2 * h + 1]};
                        const f32x2 t = g2 * k1; const f32x2 ex = {__builtin_amdgcn_exp2f(t.x), __builtin_amdgcn_exp2f(t.y)}; const f32x2 d = ex * cden + cden;
                        const f32x2 rr = {__builtin_amdgcn_rcpf(d.x), __builtin_amdgcn_rcpf(d.y)}; const f32x2 o = (g2 * u2) * rr; r[n * 4 + 2 * h] = o.x; r[n * 4 + 2 * h + 1] = o.y; }
                if constexpr (OUT8) { typedef unsigned u32x2v __attribute__((ext_vector_type(2))); u32x2v w; w.x = pk4_fp8(r[0], r[1], r[2], r[3]); w.y = pk4_fp8(r[4], r[5], r[6], r[7]);
                    *(u32x2v*)((unsigned char*)O + (size_t)(row0 + ai * HALF + m * 16) * ldc + col0) = w; }
                else { u32x4 w; w.x = cvt_pk_bf16(r[0], r[1]); w.y = cvt_pk_bf16(r[2], r[3]); w.z = cvt_pk_bf16(r[4], r[5]); w.w = cvt_pk_bf16(r[6], r[7]);
                    *(u32x4*)rowp = w; } }
    }
};
struct EpiBranch {
    static constexpr bool PERM = true, AFTER_DRAIN = false, MIDK = true; static constexpr int MID0 = 8, MID1 = 12;
    const bf16_t* G; int ldg; bf16_t* O; int ldc;
    __device__ __forceinline__ void mid(f32x4 (&acc)[2][2][4][2], const Unit& u, int t, int wr, int wc, int fr, int fq) const {
        int row0 = u.pm * BM + wr * 64 + fr, col0 = u.pn * BM + wc * 32 + 8 * fq;
        asm volatile("" : "+v"(row0), "+v"(col0));
        const bf16_t* gp = G + (t == MID0 ? 0 : 1024);
        u32x4 ld_[2][2][2], ln_[2][2][2];
#define BR_LOAD(bf, ai, mp) do { _Pragma("unroll") for (int mm = 0; mm < 2; ++mm) { const bf16_t* rp = gp + (size_t)(row0 + (ai) * HALF + (2 * (mp) + mm) * 16) * ldg + col0; \
            _Pragma("unroll") for (int bj = 0; bj < 2; ++bj) { ld_[bf][mm][bj] = *(const u32x4*)(rp + bj * HALF); ln_[bf][mm][bj] = *(const u32x4*)(rp + bj * HALF + 1024); } } } while (0)
#define BR_APPLY(bf, ai, mp) do { _Pragma("unroll") for (int mm = 0; mm < 2; ++mm) _Pragma("unroll") for (int bj = 0; bj < 2; ++bj) _Pragma("unroll") for (int q = 0; q < 4; ++q) { \
            const unsigned dw = ld_[bf][mm][bj][q], nw = ln_[bf][mm][bj][q];        \
            const f32x2 rd = {__builtin_amdgcn_rcpf(bfl(dw)), __builtin_amdgcn_rcpf(bfh(dw))}, nm = {bfl(nw), bfh(nw)}; const f32x2 ra = nm * rd; \
            acc[ai][bj][2 * (mp) + mm][q >> 1][2 * (q & 1)] *= ra.x; acc[ai][bj][2 * (mp) + mm][q >> 1][2 * (q & 1) + 1] *= ra.y; } } while (0)
        BR_LOAD(0, 0, 0); BR_LOAD(1, 0, 1); asm volatile("" ::: "memory");
        BR_APPLY(0, 0, 0); asm volatile("" ::: "memory"); BR_LOAD(0, 1, 0); asm volatile("" ::: "memory");
        BR_APPLY(1, 0, 1); asm volatile("" ::: "memory"); BR_LOAD(1, 1, 1); asm volatile("" ::: "memory");
        BR_APPLY(0, 1, 0); asm volatile("" ::: "memory"); BR_APPLY(1, 1, 1); asm volatile("" ::: "memory");
#undef BR_LOAD
#undef BR_APPLY
    }
    __device__ __forceinline__ void operator()(const f32x4 (&acc)[2][2][4][2], const Unit& u, int wr, int wc, int fr, int fq) const {
        const int row0 = u.pm * BM + wr * 64 + fr, col0 = u.pn * BM + wc * 32 + 8 * fq;
        u32x4 l2[2][2][2];
#define BR_LOAD(bf, ai, mp) do { _Pragma("unroll") for (int mm = 0; mm < 2; ++mm) _Pragma("unroll") for (int bj = 0; bj < 2; ++bj) \
            l2[bf][mm][bj] = *(const u32x4*)(G + 2048 + (size_t)(row0 + (ai) * HALF + (2 * (mp) + mm) * 16) * ldg + col0 + bj * HALF); } while (0)
#define BR_APPLY(bf, ai, mp) do { _Pragma("unroll") for (int mm = 0; mm < 2; ++mm) _Pragma("unroll") for (int bj = 0; bj < 2; ++bj) { u32x4 w; \
            _Pragma("unroll") for (int q = 0; q < 4; ++q) { const unsigned dw = l2[bf][mm][bj][q]; const f32x2 rd = {__builtin_amdgcn_rcpf(bfl(dw)), __builtin_amdgcn_rcpf(bfh(dw))}; \
                const f32x2 a2 = {acc[ai][bj][2 * (mp) + mm][q >> 1][2 * (q & 1)], acc[ai][bj][2 * (mp) + mm][q >> 1][2 * (q & 1) + 1]}; const f32x2 o = a2 * rd; w[q] = cvt_pk_bf16(o.x, o.y); } \
            *(u32x4*)(O + (size_t)(row0 + (ai) * HALF + (2 * (mp) + mm) * 16) * ldc + col0 + bj * HALF) = w; } } while (0)
        BR_LOAD(0, 0, 0); BR_LOAD(1, 0, 1); asm volatile("" ::: "memory");
        BR_APPLY(0, 0, 0); asm volatile("" ::: "memory"); BR_LOAD(0, 1, 0); asm volatile("" ::: "memory");
        BR_APPLY(1, 0, 1); asm volatile("" ::: "memory"); BR_LOAD(1, 1, 1); asm volatile("" ::: "memory");
        BR_APPLY(0, 1, 0); asm volatile("" ::: "memory"); BR_APPLY(1, 1, 1);
#undef BR_LOAD
#undef BR_APPLY
    }
};

}

constexpr int NWAVES = 8, NTHR = 512;
constexpr int BATCH = 4, SEQ = 4096, D = 1024, M = BATCH * SEQ, INC = 5632, FF = 3584, NE = 8, NHEAD = 8, HD = 64;
constexpr int C_Q = 0, C_K = 512, C_V = 1024, C_U = 1536, C_CH = 1792, C_CB = 2048, C_CC = 2304, C_G = 2560;
constexpr int MPAD = 2 * M + 2048;
constexpr int NCHUNK = M / 64;
constexpr float EPS = 1e-6f;
constexpr float SB_EXIT = -150.1f;

constexpr size_t MiB = 1u << 20;
constexpr size_t WS_CTL = 0, CTL_ZERO_BYTES = 65536;
constexpr int CW_BAR = 4096, CW_MOECNT = 8192;
constexpr size_t WS_TOPI = 1 * MiB, WS_TOPW = WS_TOPI + 256 * 1024, WS_SLOT = WS_TOPI + 512 * 1024;
constexpr size_t WS_TAB = 2 * MiB, TAB_STRIDE = 512 * 1024, TAB_ABAR = 0, TAB_BBAR = 64 * 1024, TAB_CMATB = 256 * 1024, TAB_BBF = 320 * 1024;
constexpr size_t WS_HB8 = 236 * MiB;
constexpr size_t WS_WING8 = 77 * MiB;
constexpr size_t WS_Y2 = 224 * MiB;
constexpr size_t WS_E = 4 * MiB, WS_SSP = 6 * MiB;
constexpr size_t WS_XNN = 8 * MiB;
constexpr size_t WS_WIN0 = 72 * MiB, WS_WCAT0 = 83 * MiB, WS_WOUT0 = 85 * MiB, WS_WGLU0 = 87 * MiB, WS_WGU0 = 88 * MiB, WS_WD0 = 102 * MiB;
constexpr size_t WS_WIN1 = 109 * MiB, WS_WCAT1 = 120 * MiB, WS_WOUT1 = 122 * MiB, WS_WGLU1 = 124 * MiB;
constexpr size_t WS_LSTRIDE = WS_WIN1 - WS_WIN0;
static_assert(WS_WCAT1 - WS_WCAT0 == WS_LSTRIDE && WS_WOUT1 - WS_WOUT0 == WS_LSTRIDE && WS_WGLU1 - WS_WGLU0 == WS_LSTRIDE, "layer stride");
constexpr size_t WS_YCAT0 = 125 * MiB, WS_MERGED0 = 157 * MiB, WS_XN = 252 * MiB, WS_BIG = 284 * MiB;
constexpr size_t WS_YCAT1 = 72 * MiB, WS_MERGED1 = 460 * MiB;
constexpr size_t WS_XS = 72 * MiB, WS_WMOE = 140 * MiB, WS_WD8 = 196 * MiB, WS_ACTM = 284 * MiB, WS_YS = 404 * MiB, WS_END = 492 * MiB;
constexpr float SC_XS = 4.f, SC_W = 64.f, SC_ACT = 8.f;
static_assert(WS_XS + (size_t)MPAD * D <= WS_WIN1 && WS_WMOE + (size_t)NE * 2 * FF * D <= WS_WD8 && WS_WD8 + (size_t)NE * FF * D <= 224 * MiB && WS_ACTM + (size_t)MPAD * FF <= WS_YS && WS_YS + (size_t)MPAD * D * 2 <= WS_END, "MoE map");
static_assert(WS_BIG + (size_t)M * INC * 2 <= WS_END && WS_XN + (size_t)M * D * 2 <= WS_BIG && WS_MERGED0 + (size_t)M * D * 2 <= WS_XN && WS_MERGED1 + (size_t)M * D * 2 <= WS_END && WS_YCAT1 + (size_t)M * D * 2 <= WS_WIN1, "mixer map");

constexpr int RING_BYTES = 131072, MISC_OFF = RING_BYTES, LDS_BYTES = 147456;

#define LAS __attribute__((address_space(3)))
typedef unsigned short bf16;
typedef unsigned v4u __attribute__((ext_vector_type(4)));
typedef unsigned v2u __attribute__((ext_vector_type(2)));
typedef float f32x4 __attribute__((ext_vector_type(4)));
typedef float f32x16 __attribute__((ext_vector_type(16)));
typedef float f32x2v __attribute__((ext_vector_type(2)));
typedef short bf16x8 __attribute__((ext_vector_type(8)));
#define RLX_AGENT __ATOMIC_RELAXED, __HIP_MEMORY_SCOPE_AGENT
#define LDS_WAIT() asm volatile("s_waitcnt lgkmcnt(0)" ::: "memory")
__device__ __forceinline__ float bfl(unsigned w) { return __uint_as_float(w << 16); }
__device__ __forceinline__ float bfh(unsigned w) { return __uint_as_float(w & 0xffff0000u); }
__device__ __forceinline__ float bf2f(bf16 x) { return __uint_as_float(((unsigned)x) << 16); }
typedef float f32x2c __attribute__((ext_vector_type(2))); typedef __bf16 bf16x2c __attribute__((ext_vector_type(2)));
__device__ __forceinline__ unsigned pk2(float lo, float hi) { const f32x2c v = {lo, hi}; return __builtin_bit_cast(unsigned, __builtin_convertvector(v, bf16x2c)); }
__device__ __forceinline__ unsigned f2bf(float f) { return pk2(f, f) & 0xffffu; }
__device__ __forceinline__ float wave_sum(float v) {
#pragma unroll
    for (int o = 1; o < 64; o <<= 1) v += __shfl_xor(v, o);
    return v;
}

#define XB_TMO      128
#define XB_XCNT(j)  (256  + 64 * (j))
#define XB_XSUB(j)  (1280 + 64 * (j))
#define XB_XGEN(j)  (2304 + 64 * (j))
#define XB_TOP      3328
#define XB_TOPGEN   3392
#define XCD_BAR_WORDS 3456
#define XB_SPIN_CAP (1u << 18)
__device__ __forceinline__ unsigned xb_ld(unsigned* p)              { return __hip_atomic_load(p, __ATOMIC_RELAXED, __HIP_MEMORY_SCOPE_AGENT); }
__device__ __forceinline__ unsigned xb_add(unsigned* p, unsigned v) { return __hip_atomic_fetch_add(p, v, __ATOMIC_RELAXED, __HIP_MEMORY_SCOPE_AGENT); }
__device__ __forceinline__ unsigned xb_xcc_id() { return (unsigned)__builtin_amdgcn_s_getreg((3 << 11) | 20) & 0xFu; }
#define XB_SPIN(cond, bar) do { unsigned _sp = 0; while (cond) { __builtin_amdgcn_s_sleep(1); \
    if ((++_sp & 255u) == 0u) { if (xb_ld(&(bar)[XB_TMO])) break; if (_sp > XB_SPIN_CAP) { atomicAdd(&(bar)[XB_TMO], 1u); break; } } } } while (0)
struct XcdBarrier { unsigned* bar; unsigned x; volatile LAS unsigned* st; };
__device__ __forceinline__ XcdBarrier xcd_barrier_post(unsigned* bar, volatile LAS unsigned* st) {
    XcdBarrier b; b.bar = bar; b.x = xb_xcc_id(); b.st = st;
    if (threadIdx.x == 0) (void)xb_add(&bar[XB_XCNT(b.x)], 1u);
    return b;
}
__device__ __forceinline__ void xcd_barrier_complete(unsigned* bar, unsigned x, unsigned& nloc, unsigned& nx) {
    const unsigned G = gridDim.x * gridDim.y * gridDim.z;
    unsigned sum, cnt, mine, sp = 0u;
    for (;;) {
        sum = 0u; cnt = 0u; mine = 0u;
#pragma unroll
        for (unsigned j = 0; j < 16; ++j) { const unsigned c = xb_ld(&bar[XB_XCNT(j)]); sum += c; cnt += (c > 0u) ? 1u : 0u; mine = (j == x) ? c : mine; }
        if (sum == G) break;
        __builtin_amdgcn_s_sleep(1);
        if ((++sp & 255u) == 0u) { if (xb_ld(&bar[XB_TMO])) break; if (sp > XB_SPIN_CAP) { atomicAdd(&bar[XB_TMO], 1u); break; } }
    }
    nloc = mine > 0u ? mine : 1u; nx = cnt > 0u ? cnt : 1u;
}
__device__ __forceinline__ void xcd_barrier(const XcdBarrier& b) {
    asm volatile("s_waitcnt vmcnt(0)" ::: "memory");
    __syncthreads();
    if (threadIdx.x == 0) {
        unsigned* bar = b.bar;
        __builtin_amdgcn_s_waitcnt(0);
        unsigned nloc = b.st[0], nx = b.st[1];
        if (nloc == 0u) { xcd_barrier_complete(bar, b.x, nloc, nx); b.st[0] = nloc; b.st[1] = nx; }
        const unsigned old = xb_add(&bar[XB_XSUB(b.x)], 1u);
        const unsigned gen = old / nloc;
        if (old + 1u == (gen + 1u) * nloc) {
            __builtin_amdgcn_fence(__ATOMIC_RELEASE, "agent");
            asm volatile("s_waitcnt vmcnt(0)" ::: "memory");
            const unsigned og = xb_add(&bar[XB_TOP], 1u);
            const unsigned tg = og / nx;
            if (og + 1u == (tg + 1u) * nx) xb_add(&bar[XB_TOPGEN], 1u);
            else XB_SPIN(xb_ld(&bar[XB_TOPGEN]) == tg, bar);
            __builtin_amdgcn_fence(__ATOMIC_ACQUIRE, "agent");
            xb_add(&bar[XB_XGEN(b.x)], 1u);
            asm volatile("s_waitcnt vmcnt(0)" ::: "memory");
        } else {
            XB_SPIN(xb_ld(&bar[XB_XGEN(b.x)]) == gen, bar);
            __builtin_amdgcn_fence(__ATOMIC_ACQUIRE, "agent");
            asm volatile("s_waitcnt vmcnt(0)" ::: "memory");
        }
    }
    __syncthreads();
}

struct Args { const float* in[26]; float* out; unsigned char* ws; int ph_lo, ph_hi; };
enum InIdx { I_X = 0, I_NORM_MIX, I_W_IN, I_LAM_RE, I_LAM_IM, I_LOG_DT, I_B_RE, I_B_IM, I_C_RE, I_C_IM, I_SSM_D, I_W_GLU, I_CONV_W, I_W_BR_A, I_W_BR_B, I_W_BR_C, I_W_OUT,
             I_NORM_FFN, I_DW_GATE, I_DW_UP, I_DW_DOWN, I_ROUTER, I_MW_GATE, I_MW_UP, I_MW_DOWN, I_FINAL_NORM };
struct Frame {
    LAS unsigned char* lds;
    unsigned* ctl;
    unsigned char* ws;
    const float* const* in;
    float* out;
    int tid, lane, wave, vcu, G;
    size_t ycat_off;
};

struct CvtJob { const float* src; bf16* dst; int K, N, ld, koff, mode; const float* gain; int fp8; int src_ld, c0; };
__device__ __forceinline__ CvtJob get_job(const Frame& F, int j) {
    CvtJob J; J.koff = 0; J.mode = 0; J.gain = nullptr; J.fp8 = 0; J.src_ld = 0; J.c0 = 0;
    if (j >= 39) { const int l = j - 39;
        J.src = F.in[I_W_IN] + (size_t)l * D * INC; J.K = D; J.N = INC - C_G; J.src_ld = INC; J.c0 = C_G; J.dst = (bf16*)(F.ws + WS_WING8 + (size_t)l * WS_LSTRIDE); J.ld = D; J.gain = F.in[I_NORM_MIX] + l * D; J.fp8 = 1; return J; }
    if (j < 12) { const int l = j / 6, r = j % 6; unsigned char* wl = F.ws + (size_t)l * WS_LSTRIDE;
        if (r == 0)      { J.src = F.in[I_W_IN] + (size_t)l * D * INC;   J.K = D;   J.N = C_G; J.src_ld = INC; J.dst = (bf16*)(wl + WS_WIN0);  J.ld = D; J.gain = F.in[I_NORM_MIX] + l * D; }
        else if (r == 1) { J.src = F.in[I_W_BR_A] + (size_t)l * 512 * D; J.K = 512; J.N = D;   J.dst = (bf16*)(wl + WS_WCAT0); J.ld = D; }
        else if (r == 2) { J.src = F.in[I_W_BR_B] + (size_t)l * 256 * D; J.K = 256; J.N = D;   J.dst = (bf16*)(wl + WS_WCAT0); J.ld = D; J.koff = 512; }
        else if (r == 3) { J.src = F.in[I_W_BR_C] + (size_t)l * 256 * D; J.K = 256; J.N = D;   J.dst = (bf16*)(wl + WS_WCAT0); J.ld = D; J.koff = 768; }
        else if (r == 4) { J.src = F.in[I_W_OUT] + (size_t)l * D * D;    J.K = D;   J.N = D;   J.dst = (bf16*)(wl + WS_WOUT0); J.ld = D; }
        else             { J.src = F.in[I_W_GLU] + (size_t)l * 256 * 256; J.K = 256; J.N = 256; J.dst = (bf16*)(wl + WS_WGLU0); J.ld = 256; }
    } else if (j == 12) { J.src = F.in[I_DW_GATE]; J.K = D; J.N = FF; J.dst = (bf16*)(F.ws + WS_WGU0); J.ld = D; J.mode = 1; J.gain = F.in[I_NORM_FFN]; }
    else if (j == 13)   { J.src = F.in[I_DW_UP];   J.K = D; J.N = FF; J.dst = (bf16*)(F.ws + WS_WGU0); J.ld = D; J.mode = 2; J.gain = F.in[I_NORM_FFN]; }
    else if (j == 14)   { J.src = F.in[I_DW_DOWN]; J.K = FF; J.N = D; J.dst = (bf16*)(F.ws + WS_WD0);  J.ld = FF; J.fp8 = 1; }
    else if (j < 31)    { const int e = (j - 15) >> 1, up = (j - 15) & 1; const float* sg = F.in[I_MW_GATE]; const float* su = F.in[I_MW_UP]; J.src = (up ? su : sg) + (size_t)e * D * FF; J.K = D; J.N = FF;
                          J.dst = (bf16*)(F.ws + WS_WMOE + (size_t)e * 2 * FF * D); J.ld = D; J.mode = 1 + up; J.fp8 = 1; }
    else                { const int e = j - 31; J.src = F.in[I_MW_DOWN] + (size_t)e * FF * D; J.K = FF; J.N = D; J.dst = (bf16*)(F.ws + WS_WD8 + (size_t)e * D * FF); J.ld = FF; J.fp8 = 1; }
    if (!J.src_ld) J.src_ld = J.N;
    return J;
}
__device__ __forceinline__ void cvt_item(const CvtJob& J, int item, LAS float* scr, int lane) {
    const int nblk = J.N / 32, kb = item / nblk, nb = item % nblk, k0 = 64 * kb, n0 = 32 * nb;
    f32x4 ld[8];
#pragma unroll
    for (int i = 0; i < 8; ++i) ld[i] = *(const f32x4*)(J.src + (size_t)(k0 + (lane >> 3) + 8 * i) * J.src_ld + J.c0 + n0 + (lane & 7) * 4);
    if (J.gain) {
#pragma unroll
        for (int i = 0; i < 8; ++i) ld[i] = ld[i] * J.gain[k0 + (lane >> 3) + 8 * i]; }
#pragma unroll
    for (int i = 0; i < 8; ++i) { LAS float* d = scr + ((lane >> 3) + 8 * i) * 33 + (lane & 7) * 4; d[0] = ld[i].x; d[1] = ld[i].y; d[2] = ld[i].z; d[3] = ld[i].w; }
    LDS_WAIT(); asm volatile("" ::: "memory");
    const int drow0 = (J.mode == 0) ? n0 : ((n0 >> 7) * 256 + (n0 & 127) + (J.mode == 2 ? 128 : 0));
    const int c = lane & 7;
#pragma unroll
    for (int j = 0; j < 4; ++j) { const int n = (lane >> 3) + 8 * j; const LAS float* s = scr + (8 * c) * 33 + n;
        if (J.fp8) { v2u o8; o8.x = pg8::pk4_fp8(s[0 * 33] * SC_W, s[1 * 33] * SC_W, s[2 * 33] * SC_W, s[3 * 33] * SC_W); o8.y = pg8::pk4_fp8(s[4 * 33] * SC_W, s[5 * 33] * SC_W, s[6 * 33] * SC_W, s[7 * 33] * SC_W);
            *(v2u*)((unsigned char*)J.dst + (size_t)(drow0 + n) * J.ld + J.koff + k0 + 8 * c) = o8; }
        else { v4u o; o.x = pk2(s[0 * 33], s[1 * 33]); o.y = pk2(s[2 * 33], s[3 * 33]); o.z = pk2(s[4 * 33], s[5 * 33]); o.w = pk2(s[6 * 33], s[7 * 33]);
            *(v4u*)(J.dst + (size_t)(drow0 + n) * J.ld + J.koff + k0 + 8 * c) = o; } }
    LDS_WAIT(); asm volatile("" ::: "memory");
}
__device__ __forceinline__ void convert_jobs(const Frame& F, int jlo, int jhi, int widx, int nw) {
    if (widx < 0) return;
    LAS float* scr = (LAS float*)(F.lds + F.wave * 16384);
    int start = 0;
    for (int j = jlo; j < jhi; ++j) {
        const CvtJob J = get_job(F, j); const int n = (J.K / 64) * (J.N / 32);
        int it = widx - start; if (it < 0) it += nw;
        for (; it < n; it += nw) cvt_item(J, it, scr, F.lane);
        start = (start + n) % nw;
    }
}

__device__ __forceinline__ void ssm_tables(const Frame& F) {
    const int gt = blockIdx.x * NTHR + F.tid, NT = F.G * NTHR;
    for (int i = gt; i < 2 * 16 * 64; i += NT) {
        const int l = i >> 10, g = (i >> 6) & 15, p = i & 63;
        unsigned char* tab = F.ws + WS_TAB + (size_t)l * TAB_STRIDE;
        const float lr = fminf(F.in[I_LAM_RE][i], -1e-4f), li = F.in[I_LAM_IM][i], dt = expf(F.in[I_LOG_DT][l * 16 + g]);
        const float mag = expf(lr * dt), ar = mag * cosf(li * dt), ai = mag * sinf(li * dt);
        const float den = lr * lr + li * li, nr = ar - 1.0f, ni = ai;
        const float fr = (nr * lr + ni * li) / den, fi = (ni * lr - nr * li) / den;
        const double ang = (double)li * (double)dt * 64.0; const double rev = ang * 0.15915494309189535; const float rf = (float)((rev - rint(rev)) * 6.283185307179586);
        const float magT = expf(64.0f * lr * dt);
        ((f32x4*)(tab + TAB_ABAR))[g * 64 + p] = (f32x4){ar, ai, magT * cosf(rf), magT * sinf(rf)};
        float* bb = (float*)(tab + TAB_BBAR) + (size_t)(g * 64 + p) * 32;
        const float* bre = F.in[I_B_RE] + (size_t)i * 16; const float* bim = F.in[I_B_IM] + (size_t)i * 16;
#pragma unroll
        for (int h = 0; h < 16; ++h) { const float br = bre[h], bi = bim[h]; bb[2 * h] = fr * br - fi * bi; bb[2 * h + 1] = fr * bi + fi * br; }
    }
    for (int i = gt; i < 2 * 16 * 8 * 64; i += NT) {
        const int l = i >> 13, g = (i >> 9) & 15, cbk = (i >> 6) & 7, ln = i & 63;
        const int c = cbk * 16 + (ln & 15), p = c >> 1, ri = c & 1, kh = ln >> 4;
        unsigned w[4] = {0u, 0u, 0u, 0u};
        if (kh < 2) {
            const int idx = (l * 16 + g) * 64 + p;
            const float lr = fminf(F.in[I_LAM_RE][idx], -1e-4f), li = F.in[I_LAM_IM][idx], dt = expf(F.in[I_LOG_DT][l * 16 + g]);
            const float mag = expf(lr * dt), ar = mag * cosf(li * dt), ai = mag * sinf(li * dt);
            const float den = lr * lr + li * li, nr = ar - 1.0f, ni = ai;
            const float fr = (nr * lr + ni * li) / den, fi = (ni * lr - nr * li) / den;
            const float* bre = F.in[I_B_RE] + (size_t)idx * 16 + 8 * kh; const float* bim = F.in[I_B_IM] + (size_t)idx * 16 + 8 * kh;
            float v[8];
#pragma unroll
            for (int j = 0; j < 8; ++j) { const float br = bre[j], bi = bim[j]; v[j] = ri ? (fr * bi + fi * br) : (fr * br - fi * bi); }
            w[0] = pk2(v[0], v[1]); w[1] = pk2(v[2], v[3]); w[2] = pk2(v[4], v[5]); w[3] = pk2(v[6], v[7]);
        }
        ((v4u*)(F.ws + WS_TAB + (size_t)l * TAB_STRIDE + TAB_BBF))[i & 8191] = (v4u){w[0], w[1], w[2], w[3]};
    }
    for (int i = gt; i < 2 * 16 * 4 * 64; i += NT) {
        const int l = i >> 12, g = (i >> 8) & 15, ks = (i >> 6) & 3, ln = i & 63;
        const int hp = ln & 15;
        const float* cre = F.in[I_C_RE] + ((size_t)(l * 16 + g) * 16 + hp) * 64; const float* cim = F.in[I_C_IM] + ((size_t)(l * 16 + g) * 16 + hp) * 64;
        unsigned w[4];
#pragma unroll
        for (int jj = 0; jj < 4; ++jj) { const int k = ks * 32 + 8 * (ln >> 4) + 2 * jj, p = k >> 1; w[jj] = pk2(cre[p], -cim[p]); }
        ((v4u*)(F.ws + WS_TAB + (size_t)l * TAB_STRIDE + TAB_CMATB))[i & 4095] = (v4u){w[0], w[1], w[2], w[3]};
    }
}

template <bool ROUTER>
__device__ __forceinline__ void norm_rows(const Frame& F, const bf16* src, const float* gain, bf16* dst) {
    const int gw = F.vcu * NWAVES + F.wave, NGW = F.G * NWAVES;
    LAS float* wrt = (LAS float*)F.lds;
    if (ROUTER) {
        const float* wr = F.in[I_ROUTER];
        for (int i = F.tid; i < D * NE; i += NTHR) wrt[(i & 7) * D + (i >> 3)] = wr[i];
        __syncthreads();
    }
    f32x4 gv[4];
#pragma unroll
    for (int j = 0; j < 4; ++j) gv[j] = ((const f32x4*)gain)[F.lane + 64 * j];
    v2u nv[4];
    if (gw < M) {
#pragma unroll
        for (int j = 0; j < 4; ++j) nv[j] = ((const v2u*)(src + (size_t)gw * D) + F.lane)[64 * j]; }
    for (int m = gw; m < M; m += NGW) {
        f32x4 v[4]; float s = 0.f;
#pragma unroll
        for (int j = 0; j < 4; ++j) v[j] = (f32x4){bfl(nv[j].x), bfh(nv[j].x), bfl(nv[j].y), bfh(nv[j].y)};
        if (m + NGW < M) {
#pragma unroll
            for (int j = 0; j < 4; ++j) nv[j] = ((const v2u*)(src + (size_t)(m + NGW) * D) + F.lane)[64 * j]; }
#pragma unroll
        for (int j = 0; j < 4; ++j) s += (v[j].x * v[j].x + v[j].y * v[j].y) + (v[j].z * v[j].z + v[j].w * v[j].w);
        const float rstd = 1.0f / sqrtf(wave_sum(s) * (1.0f / D) + EPS);
        if (ROUTER) { unsigned* o4 = (unsigned*)((unsigned char*)dst + (size_t)m * D) + F.lane;
#pragma unroll
            for (int j = 0; j < 4; ++j) { v[j] = v[j] * rstd * gv[j]; o4[64 * j] = pg8::pk4_fp8(v[j].x * SC_XS, v[j].y * SC_XS, v[j].z * SC_XS, v[j].w * SC_XS); } }
        else { unsigned long long* o8 = (unsigned long long*)(dst + (size_t)m * D) + F.lane;
#pragma unroll
            for (int j = 0; j < 4; ++j) { v[j] = v[j] * rstd * gv[j]; o8[64 * j] = (unsigned long long)pk2(v[j].x, v[j].y) | ((unsigned long long)pk2(v[j].z, v[j].w) << 32); } }
        if (ROUTER) {
            float lg[8];
#pragma unroll
            for (int e = 0; e < 8; ++e) { float a = 0.f;
#pragma unroll
                for (int j = 0; j < 4; ++j) { const f32x4 w = *(const LAS f32x4*)(wrt + e * D + 4 * F.lane + 256 * j); a += (v[j].x * w.x + v[j].y * w.y) + (v[j].z * w.z + v[j].w * w.w); }
                lg[e] = wave_sum(a); }
            if (F.lane == 0) {
                int i1 = 0; float v1 = lg[0];
#pragma unroll
                for (int e = 1; e < 8; ++e) if (lg[e] > v1) { v1 = lg[e]; i1 = e; }
                int i2 = -1; float v2 = -INFINITY;
#pragma unroll
                for (int e = 0; e < 8; ++e) if (e != i1 && lg[e] > v2) { v2 = lg[e]; i2 = e; }
                const float e2 = expf(v2 - v1), w1 = 1.0f / (1.0f + e2);
                ((int2*)(F.ws + WS_TOPI))[m] = make_int2(i1, i2);
                ((float2*)(F.ws + WS_TOPW))[m] = make_float2(w1, e2 * w1);
            }
        }
    }
}

__device__ __forceinline__ void cast_rows(const Frame& F, const float* src, bf16* dst) {
    const int gw = F.vcu * NWAVES + F.wave, NGW = F.G * NWAVES;
    float* ssp = (float*)(F.ws + WS_SSP);
    f32x4 nv[4];
    if (gw < M) {
#pragma unroll
        for (int j = 0; j < 4; ++j) nv[j] = ((const f32x4*)(src + (size_t)gw * D) + F.lane)[64 * j]; }
    for (int m = gw; m < M; m += NGW) {
        f32x4 v[4]; float s = 0.f;
#pragma unroll
        for (int j = 0; j < 4; ++j) v[j] = nv[j];
        if (m + NGW < M) {
#pragma unroll
            for (int j = 0; j < 4; ++j) nv[j] = ((const f32x4*)(src + (size_t)(m + NGW) * D) + F.lane)[64 * j]; }
#pragma unroll
        for (int j = 0; j < 4; ++j) s += (v[j].x * v[j].x + v[j].y * v[j].y) + (v[j].z * v[j].z + v[j].w * v[j].w);
        s = wave_sum(s);
        unsigned long long* o8 = (unsigned long long*)(dst + (size_t)m * D) + F.lane;
#pragma unroll
        for (int j = 0; j < 4; ++j) o8[64 * j] = (unsigned long long)pk2(v[j].x, v[j].y) | ((unsigned long long)pk2(v[j].z, v[j].w) << 32);
        unsigned* o4 = (unsigned*)(F.ws + WS_HB8 + (size_t)m * D) + F.lane;
#pragma unroll
        for (int j = 0; j < 4; ++j) o4[64 * j] = pg8::pk4_fp8(v[j].x * SC_XS, v[j].y * SC_XS, v[j].z * SC_XS, v[j].w * SC_XS);
        if (F.lane < 16) ssp[(size_t)m * 16 + F.lane] = (F.lane == 0) ? s : 0.f;
    }
}
__device__ __forceinline__ void cfma(float& sr, float& si, float ar, float ai, float br, float bi) {
    float t1, t2, nr, ni; const float nai = -ai;
    asm volatile("v_fma_f32 %0, %1, %2, %3" : "=v"(t1) : "v"(ar), "v"(sr), "v"(br));
    asm volatile("v_fma_f32 %0, %1, %2, %3" : "=v"(nr) : "v"(nai), "v"(si), "v"(t1));
    asm volatile("v_fma_f32 %0, %1, %2, %3" : "=v"(t2) : "v"(ar), "v"(si), "v"(bi));
    asm volatile("v_fma_f32 %0, %1, %2, %3" : "=v"(ni) : "v"(ai), "v"(sr), "v"(t2));
    sr = nr; si = ni;
}
constexpr int BUP = 132;
__device__ __forceinline__ bf16x8 ssm_u_frag(const bf16* proj, int tokb, int g, int lane) {
    bf16x8 a = {0, 0, 0, 0, 0, 0, 0, 0};
    if ((lane >> 4) < 2) a = *(const bf16x8*)(proj + (size_t)(tokb + (lane & 15)) * INC + C_U + g * 16 + 8 * (lane >> 4));
    return a;
}
__device__ __forceinline__ void ssm_bu_block(LAS float* bu, const bf16x8 (&bbf)[8], bf16x8 a, int lane) {
    const int kh = lane >> 4;
#pragma unroll
    for (int cb = 0; cb < 8; ++cb) {
        const pg8::f32x4 d = __builtin_amdgcn_mfma_f32_16x16x32_bf16(a, bbf[cb], (pg8::f32x4){0.f, 0.f, 0.f, 0.f}, 0, 0, 0);
#pragma unroll
        for (int r = 0; r < 4; ++r) bu[(4 * kh + r) * BUP + cb * 16 + (lane & 15)] = d[r];
    }
    LDS_WAIT(); asm volatile("" ::: "memory");
}
#define SSM_STEP(tt_) do { const f32x2v b_ = *(const LAS f32x2v*)(bu + (tt_) * BUP + 2 * p); \
    cfma(sr, si, ab.x, ab.y, b_.x, b_.y); } while (0)

__device__ __forceinline__ void ssm_pass1_unit(const Frame& F, int l, int unit) {
    const bf16* proj = (const bf16*)(F.ws + WS_BIG);
    const unsigned char* tab = F.ws + WS_TAB + (size_t)l * TAB_STRIDE;
    LAS float* bu = (LAS float*)(F.lds + F.wave * (16 * BUP * 4));
    const int p = F.lane, tok0 = unit * 64;
    for (int gi = 0; gi < 2; ++gi) {
        const int g = F.wave * 2 + gi;
        bf16x8 bbf[8];
#pragma unroll
        for (int cb = 0; cb < 8; ++cb) bbf[cb] = ((const bf16x8*)(tab + TAB_BBF))[(g * 8 + cb) * 64 + F.lane];
        const f32x4 ab = ((const f32x4*)(tab + TAB_ABAR))[g * 64 + p];
        bf16x8 af[4];
#pragma unroll
        for (int tb = 0; tb < 4; ++tb) af[tb] = ssm_u_frag(proj, tok0 + tb * 16, g, F.lane);
        float sr = 0.f, si = 0.f;
#pragma unroll
        for (int tb = 0; tb < 4; ++tb) {
            ssm_bu_block(bu, bbf, af[tb], F.lane);
#pragma unroll
            for (int tt = 0; tt < 16; ++tt) SSM_STEP(tt);
        }
        ((float2*)(F.ws + WS_E))[((size_t)unit * 16 + g) * 64 + p] = make_float2(sr, si);
        LDS_WAIT(); asm volatile("" ::: "memory");
    }
}
__device__ __forceinline__ void conv_unit(const Frame& F, int l, int unit) {
    const bf16* proj = (const bf16*)(F.ws + WS_BIG); bf16* ycat = (bf16*)(F.ws + F.ycat_off);
    const float* cw = F.in[I_CONV_W] + (size_t)l * 3 * 256;
    for (int it = F.tid; it < 64 * 32; it += NTHR) {
        const int tt = it >> 5, cg = (it & 31) * 8, tok = unit * 64 + tt, tl = tok & (SEQ - 1);
        const bf16* row = proj + (size_t)tok * INC;
        float u[3][8];
        v4u hv[3], cv[3];
#pragma unroll
        for (int d = 0; d < 3; ++d) { const size_t back = (tl >= d) ? (size_t)d * INC : 0; hv[d] = *(const v4u*)(row - back + C_CH + cg); cv[d] = *(const v4u*)(row - back + C_CC + cg); }
#pragma unroll
        for (int d = 0; d < 3; ++d) {
            const float keep = (tl >= d) ? 1.f : 0.f;
            const unsigned hw[4] = {hv[d].x, hv[d].y, hv[d].z, hv[d].w}, cww[4] = {cv[d].x, cv[d].y, cv[d].z, cv[d].w};
#pragma unroll
            for (int q = 0; q < 4; ++q) { u[d][2 * q] = keep * (bfl(hw[q]) * bfl(cww[q])); u[d][2 * q + 1] = keep * (bfh(hw[q]) * bfh(cww[q])); }
        }
        const v4u bv = *(const v4u*)(row + C_CB + cg); const unsigned bw[4] = {bv.x, bv.y, bv.z, bv.w};
        float o[8];
#pragma unroll
        for (int q = 0; q < 8; ++q) { const float y = cw[cg + q] * u[2][q] + cw[256 + cg + q] * u[1][q] + cw[512 + cg + q] * u[0][q]; const float bg = (q & 1) ? bfh(bw[q >> 1]) : bfl(bw[q >> 1]); o[q] = bg * y; }
        *(v4u*)(ycat + (size_t)tok * D + 768 + cg) = (v4u){pk2(o[0], o[1]), pk2(o[2], o[3]), pk2(o[4], o[5]), pk2(o[6], o[7])};
    }
}
__device__ __forceinline__ int crow(int r, int hi) { return (r & 3) + 8 * (r >> 2) + 4 * hi; }
constexpr int VPITCH = 144;
typedef short v4i16_t __attribute__((ext_vector_type(4)));
__device__ __forceinline__ bf16x8 pack8(float a, float b, float c, float d, float e, float f, float g, float h) {
    v4u w = {pk2(a, b), pk2(c, d), pk2(e, f), pk2(g, h)}; return __builtin_bit_cast(bf16x8, w); }
__device__ __forceinline__ void attn_unit(const Frame& F, int uidx, LAS unsigned char* vl) {
    const int lane = F.lane, r32 = lane & 31, hh = lane >> 5;
    const int bh = uidx >> 7, qb = uidx & 127, b = bh >> 3, h = bh & 7, t0 = qb * 32, tq = t0 + r32;
    const bf16* P = (const bf16*)(F.ws + WS_BIG) + (size_t)b * SEQ * INC;
    bf16* ycat = (bf16*)(F.ws + F.ycat_off);
    bf16x8 qf[4];
#pragma unroll
    for (int ks = 0; ks < 4; ++ks) qf[ks] = *(const bf16x8*)(P + (size_t)tq * INC + C_Q + h * 64 + 16 * ks + 8 * hh);
    f32x16 o0 = {}, o1 = {};
    float carry = 0.f;
    const int trb = ((lane & 15) >> 2) * VPITCH + (16 * ((lane >> 4) & 1) + 4 * (lane & 3)) * 2 + 4 * hh * VPITCH;
    bf16x8 kf0[4], kf1[4];
    v4u vv[8];
    const unsigned vlo = (unsigned)(((lane >> 3) * INC + (lane & 7) * 8) * 2), klo = (unsigned)((r32 * INC + 8 * hh) * 2);
    const char* Pv = (const char*)(P + C_V + h * 64); const char* Pk = (const char*)(P + C_K + h * 64);
#define AT_LOADV(KSB) do { const char* vb_ = Pv + (size_t)(KSB) * (INC * 2); _Pragma("unroll") for (int i = 0; i < 8; ++i) vv[i] = *(const v4u*)(vb_ + (size_t)(8 * i) * (INC * 2) + vlo); } while (0)
#define AT_LOADK(KSB) do { const char* kb_ = Pk + (size_t)(KSB) * (INC * 2); \
            _Pragma("unroll") for (int ks = 0; ks < 4; ++ks) { kf0[ks] = *(const bf16x8*)(kb_ + klo + 32 * ks); kf1[ks] = *(const bf16x8*)(kb_ + (size_t)32 * (INC * 2) + klo + 32 * ks); } } while (0)
    { const int kb0 = t0 - 32 < 0 ? 0 : t0 - 32; AT_LOADV(kb0); AT_LOADK(kb0); }
    for (int kend = t0 + 32; kend > 0; kend -= 64) {
        const int ks0 = kend - 64;
        asm volatile("" : "+v"(vv[0]), "+v"(vv[1]), "+v"(vv[2]), "+v"(vv[3]), "+v"(vv[4]), "+v"(vv[5]), "+v"(vv[6]), "+v"(vv[7]));
#pragma unroll
        for (int i = 0; i < 8; ++i) { const int row = (lane >> 3) + 8 * i; *(LAS v4u*)(vl + row * VPITCH + (lane & 7) * 16) = vv[i]; }
        const int ksb = ks0 < 0 ? 0 : ks0, ksn = ks0 - 64 < 0 ? 0 : ks0 - 64;
        AT_LOADV(ksn); asm volatile("" ::: "memory");
        f32x16 s0 = {}, s1 = {};
#pragma unroll
        for (int ks = 0; ks < 4; ++ks) { s0 = __builtin_amdgcn_mfma_f32_32x32x16_bf16(kf0[ks], qf[ks], s0, 0, 0, 0); s1 = __builtin_amdgcn_mfma_f32_32x32x16_bf16(kf1[ks], qf[ks], s1, 0, 0, 0); }
        asm volatile("" : "+v"(s0), "+v"(s1));
        AT_LOADK(ksn); asm volatile("" ::: "memory");
        f32x16 c0, c1; float tot = 0.f; const int kmax = kend < tq ? kend : tq;
#define SP_ELEM(S, C, I, KEY, MASKED) do { const float z2 = 0.18033688011112042f * S[I]; const float sp = fmaxf(z2, 0.f) + __builtin_amdgcn_logf(1.f + __builtin_amdgcn_exp2f(-fabsf(z2))); \
            if (MASKED) { const bool valid = (KEY) < kmax; C[I] = valid ? (z2 - sp) + carry : -INFINITY; S[I] = valid ? -sp : 0.f; } else { C[I] = (z2 - sp) + carry; S[I] = -sp; } tot += S[I]; } while (0)
        if (ks0 >= 0 && kend <= t0) {
#pragma unroll
            for (int i = 0; i < 16; ++i) SP_ELEM(s1, c1, i, 0, false);
            tot += __shfl_xor(tot, 32); carry += tot; tot = 0.f;
#pragma unroll
            for (int i = 0; i < 16; ++i) SP_ELEM(s0, c0, i, 0, false);
        } else {
#pragma unroll
            for (int i = 0; i < 16; ++i) { const int key1 = ksb + 32 + crow(i, hh); SP_ELEM(s1, c1, i, key1, true); }
            tot += __shfl_xor(tot, 32); carry += tot; tot = 0.f;
#pragma unroll
            for (int i = 0; i < 16; ++i) { const int key0 = ksb + crow(i, hh); SP_ELEM(s0, c0, i, key0, true); }
        }
#undef SP_ELEM
        tot += __shfl_xor(tot, 32); carry += tot;
        {
#define HIW(S, q8) ((v4u){pk2(S[(q8)], S[(q8) + 1]), pk2(S[(q8) + 2], S[(q8) + 3]), pk2(S[(q8) + 4], S[(q8) + 5]), pk2(S[(q8) + 6], S[(q8) + 7])})
#define LOW(S, q8, H) ((v4u){pk2(S[(q8)] - bfl((H).x), S[(q8) + 1] - bfh((H).x)), pk2(S[(q8) + 2] - bfl((H).y), S[(q8) + 3] - bfh((H).y)), pk2(S[(q8) + 4] - bfl((H).z), S[(q8) + 5] - bfh((H).z)), pk2(S[(q8) + 6] - bfl((H).w), S[(q8) + 7] - bfh((H).w))})
#define CUM6(X00, X01, X10, X11) do { c0 = __builtin_amdgcn_mfma_f32_32x32x16_bf16(T0, X00, c0, 0, 0, 0); c0 = __builtin_amdgcn_mfma_f32_32x32x16_bf16(T1, X01, c0, 0, 0, 0); \
            c1 = __builtin_amdgcn_mfma_f32_32x32x16_bf16(T0, X10, c1, 0, 0, 0); c1 = __builtin_amdgcn_mfma_f32_32x32x16_bf16(T1, X11, c1, 0, 0, 0); } while (0)
            bf16x8 T0, T1;
            { int lt = lane; asm volatile("" : "+v"(lt)); const int rt = lt & 31, ht = lt >> 5;
#pragma unroll
              for (int j = 0; j < 8; ++j) { const int ko = 8 * (j >> 2) + 4 * ht + (j & 3); T0[j] = (ko > rt) ? (short)0x3F80 : (short)0; T1[j] = (16 + ko > rt) ? (short)0x3F80 : (short)0; } }
            const v4u h00 = HIW(s0, 0), h01 = HIW(s0, 8), h10 = HIW(s1, 0), h11 = HIW(s1, 8);
            CUM6(__builtin_bit_cast(bf16x8, h00), __builtin_bit_cast(bf16x8, h01), __builtin_bit_cast(bf16x8, h10), __builtin_bit_cast(bf16x8, h11));
            const v4u l00 = LOW(s0, 0, h00), l01 = LOW(s0, 8, h01), l10 = LOW(s1, 0, h10), l11 = LOW(s1, 8, h11);
            CUM6(__builtin_bit_cast(bf16x8, l00), __builtin_bit_cast(bf16x8, l01), __builtin_bit_cast(bf16x8, l10), __builtin_bit_cast(bf16x8, l11));
#undef HIW
#undef LOW
#undef CUM6
        }
#pragma unroll
        for (int i = 0; i < 16; ++i) { c0[i] = __builtin_amdgcn_exp2f(c0[i]); c1[i] = __builtin_amdgcn_exp2f(c1[i]); }
#pragma unroll
        for (int kq = 0; kq < 4; ++kq) {
            const bf16x8 wa = (kq & 2) ? pack8(c1[8 * (kq & 1)], c1[8 * (kq & 1) + 1], c1[8 * (kq & 1) + 2], c1[8 * (kq & 1) + 3], c1[8 * (kq & 1) + 4], c1[8 * (kq & 1) + 5], c1[8 * (kq & 1) + 6], c1[8 * (kq & 1) + 7])
                                       : pack8(c0[8 * (kq & 1)], c0[8 * (kq & 1) + 1], c0[8 * (kq & 1) + 2], c0[8 * (kq & 1) + 3], c0[8 * (kq & 1) + 4], c0[8 * (kq & 1) + 5], c0[8 * (kq & 1) + 6], c0[8 * (kq & 1) + 7]);
#pragma unroll
            for (int db = 0; db < 2; ++db) {
                LAS unsigned char* vp = vl + trb + 16 * kq * VPITCH + 64 * db;
                const v4i16_t lo = __builtin_amdgcn_ds_read_tr16_b64_v4i16((LAS v4i16_t*)vp), hi = __builtin_amdgcn_ds_read_tr16_b64_v4i16((LAS v4i16_t*)(vp + 8 * VPITCH));
                const bf16x8 vf = {lo[0], lo[1], lo[2], lo[3], hi[0], hi[1], hi[2], hi[3]};
                if (db == 0) o0 = __builtin_amdgcn_mfma_f32_32x32x16_bf16(wa, vf, o0, 0, 0, 0); else o1 = __builtin_amdgcn_mfma_f32_32x32x16_bf16(wa, vf, o1, 0, 0, 0);
            }
        }
        if (__all(carry < SB_EXIT)) break;
    }
#undef AT_LOADV
#undef AT_LOADK
    int lz = lane; asm volatile("" : "+v"(lz));
    bf16* op = ycat + (size_t)(b * SEQ + t0 + 4 * (lz >> 5)) * D + h * 64 + (lz & 31);
#pragma unroll
    for (int i = 0; i < 16; ++i) { const int q = crow(i, 0); op[(size_t)q * D] = (bf16)f2bf(o0[i]); op[(size_t)q * D + 32] = (bf16)f2bf(o1[i]); }
    LDS_WAIT(); asm volatile("" ::: "memory");
}
__device__ __forceinline__ void mixer_b(const Frame& F, int l, int nrep_s, int nrep_a) {
    for (int rep = 0; rep < nrep_s; ++rep)
    for (int u = blockIdx.x; u < NCHUNK; u += F.G) { ssm_pass1_unit(F, l, u); conv_unit(F, l, u); }
    __syncthreads();
    LAS unsigned char* vl = F.lds + 32768 + F.wave * (64 * VPITCH);
    const int gw = blockIdx.x * NWAVES + F.wave, NGW = F.G * NWAVES;
    for (int rep = 0; rep < nrep_a; ++rep)
    for (int uidx = gw; uidx < BATCH * NHEAD * (SEQ / 32); uidx += NGW) attn_unit(F, uidx, vl);
}

__device__ __forceinline__ void ssm_pass2_unit(const Frame& F, int l, int unit) {
    const bf16* proj = (const bf16*)(F.ws + WS_BIG); bf16* ycat = (bf16*)(F.ws + F.ycat_off);
    const unsigned char* tab = F.ws + WS_TAB + (size_t)l * TAB_STRIDE;
    const float* dsk = F.in[I_SSM_D] + l * 256;
    const bf16* wglu = (const bf16*)(F.ws + WS_WGLU0 + (size_t)l * WS_LSTRIDE);
    LAS float* bu = (LAS float*)(F.lds + F.wave * (16 * BUP * 4));
    LAS unsigned char* sst = (LAS unsigned char*)bu;
    LAS unsigned char* yg = F.lds + 8 * (16 * BUP * 4);
    const int lane = F.lane, p = lane, tok0 = unit * 64, cfirst = unit & ~63;
    float s0r = 0.f, s0i = 0.f, s1r = 0.f, s1i = 0.f;
    { const f32x4 ab0 = ((const f32x4*)(tab + TAB_ABAR))[(F.wave * 2) * 64 + p], ab1 = ((const f32x4*)(tab + TAB_ABAR))[(F.wave * 2 + 1) * 64 + p];
      const float2* ep = (const float2*)(F.ws + WS_E) + (size_t)(F.wave * 2) * 64 + p;
      float2 e0[8], e1[8], f0[8], f1[8];
#define HORNER_LOAD(A0, A1, CC) do { _Pragma("unroll") for (int q = 0; q < 8; ++q) { const int ci = ((CC) + q < unit) ? (CC) + q : cfirst; A0[q] = ep[(size_t)ci * 1024]; A1[q] = ep[(size_t)ci * 1024 + 64]; } } while (0)
#define HORNER_APPLY(A0, A1, CC) do { _Pragma("unroll") for (int q = 0; q < 8; ++q) if ((CC) + q < unit) { cfma(s0r, s0i, ab0.z, ab0.w, A0[q].x, A0[q].y); cfma(s1r, s1i, ab1.z, ab1.w, A1[q].x, A1[q].y); } } while (0)
      if (cfirst < unit) HORNER_LOAD(e0, e1, cfirst);
      for (int cc = cfirst; cc < unit; cc += 16) {
          if (cc + 8 < unit) HORNER_LOAD(f0, f1, cc + 8);
          asm volatile("" ::: "memory");
          HORNER_APPLY(e0, e1, cc);
          if (cc + 16 < unit) HORNER_LOAD(e0, e1, cc + 16);
          asm volatile("" ::: "memory");
          if (cc + 8 < unit) HORNER_APPLY(f0, f1, cc + 8);
      }
#undef HORNER_LOAD
#undef HORNER_APPLY
    }
    for (int gi = 0; gi < 2; ++gi) {
        const int g = F.wave * 2 + gi;
        bf16x8 bbf[8];
#pragma unroll
        for (int cb = 0; cb < 8; ++cb) bbf[cb] = ((const bf16x8*)(tab + TAB_BBF))[(g * 8 + cb) * 64 + lane];
        const f32x4 ab = ((const f32x4*)(tab + TAB_ABAR))[g * 64 + p];
        bf16x8 cb4[4];
#pragma unroll
        for (int ks = 0; ks < 4; ++ks) cb4[ks] = ((const bf16x8*)(tab + TAB_CMATB))[(g * 4 + ks) * 64 + lane];
        bf16x8 af[4]; bf16 uvs[4][4];
#pragma unroll
        for (int tb = 0; tb < 4; ++tb) { af[tb] = ssm_u_frag(proj, tok0 + tb * 16, g, lane);
#pragma unroll
            for (int r = 0; r < 4; ++r) uvs[tb][r] = proj[(size_t)(tok0 + tb * 16 + 4 * (lane >> 4) + r) * INC + C_U + g * 16 + (lane & 15)]; }
        float sr = gi ? s1r : s0r, si = gi ? s1i : s0i;
        const float dk = dsk[g * 16 + (lane & 15)];
#pragma unroll
        for (int tb = 0; tb < 4; ++tb) {
            ssm_bu_block(bu, bbf, af[tb], lane);
#pragma unroll
            for (int tt = 0; tt < 16; ++tt) { SSM_STEP(tt); *(LAS unsigned*)(sst + tt * (BUP * 4) + p * 4) = pk2(sr, si); }
            pg8::f32x4 acc = {0.f, 0.f, 0.f, 0.f};
#pragma unroll
            for (int ks = 0; ks < 4; ++ks) { const bf16x8 a = *(const LAS bf16x8*)(sst + (lane & 15) * (BUP * 4) + (ks * 32 + 8 * (lane >> 4)) * 2); acc = __builtin_amdgcn_mfma_f32_16x16x32_bf16(a, cb4[ks], acc, 0, 0, 0); }
#pragma unroll
            for (int r = 0; r < 4; ++r) { const int t = tb * 16 + 4 * (lane >> 4) + r; const float y = acc[r] + dk * bf2f(uvs[tb][r]);
                const float gl = y * __builtin_amdgcn_rcpf(1.f + __builtin_amdgcn_exp2f(-2.3022081986f * (y + 0.044715f * y * y * y)));
                *(LAS bf16*)(yg + t * 528 + (g * 16 + (lane & 15)) * 2) = (bf16)f2bf(gl); }
        }
        LDS_WAIT(); asm volatile("" ::: "memory");
    }
    const int n0 = 32 * F.wave, r32 = lane & 31, hh = lane >> 5;
    bf16x8 wfr[16];
    { const bf16* wrow = wglu + (size_t)(n0 + r32) * 256 + 8 * hh;
#pragma unroll
      for (int ks = 0; ks < 16; ++ks) wfr[ks] = *(const bf16x8*)(wrow + 16 * ks); }
    __syncthreads();
    {
        f32x16 a0 = {}, a1 = {};
#pragma unroll
        for (int ks = 0; ks < 16; ++ks) {
            const bf16x8 bfr = wfr[ks];
            const bf16x8 x0 = *(const LAS bf16x8*)(yg + r32 * 528 + (16 * ks + 8 * hh) * 2), x1 = *(const LAS bf16x8*)(yg + (32 + r32) * 528 + (16 * ks + 8 * hh) * 2);
            a0 = __builtin_amdgcn_mfma_f32_32x32x16_bf16(x0, bfr, a0, 0, 0, 0); a1 = __builtin_amdgcn_mfma_f32_32x32x16_bf16(x1, bfr, a1, 0, 0, 0);
        }
#pragma unroll
        for (int r = 0; r < 16; ++r) { const int t = crow(r, hh);
            { const float yv = bf2f(*(const LAS bf16*)(yg + t * 528 + (n0 + r32) * 2)); ycat[(size_t)(tok0 + t) * D + 512 + n0 + r32] = (bf16)f2bf(yv * __builtin_amdgcn_rcpf(1.f + __builtin_amdgcn_exp2f(-1.4426950409f * a0[r]))); }
            { const float yv = bf2f(*(const LAS bf16*)(yg + (32 + t) * 528 + (n0 + r32) * 2)); ycat[(size_t)(tok0 + 32 + t) * D + 512 + n0 + r32] = (bf16)f2bf(yv * __builtin_amdgcn_rcpf(1.f + __builtin_amdgcn_exp2f(-1.4426950409f * a1[r]))); } }
    }
    __syncthreads();
}

__device__ __forceinline__ void moe_gather(const Frame& F) {
    LAS int* cnt = (LAS int*)F.lds;
    LAS int* tot = (LAS int*)(F.lds + 16384);
    LAS int* slot_l = (LAS int*)(F.lds + 16384 + 256);
    const int2* topi = (const int2*)(F.ws + WS_TOPI);
    const unsigned char* xn = F.ws + WS_XNN; unsigned char* xs = F.ws + WS_XS;
    {   int c0 = 0, c1 = 0, c2 = 0, c3 = 0, c4 = 0, c5 = 0, c6 = 0, c7 = 0;
        for (int k = 0; k < 32; ++k) { const int2 ti = topi[F.tid * 32 + k];
            c0 += (ti.x == 0) + (ti.y == 0); c1 += (ti.x == 1) + (ti.y == 1); c2 += (ti.x == 2) + (ti.y == 2); c3 += (ti.x == 3) + (ti.y == 3);
            c4 += (ti.x == 4) + (ti.y == 4); c5 += (ti.x == 5) + (ti.y == 5); c6 += (ti.x == 6) + (ti.y == 6); c7 += (ti.x == 7) + (ti.y == 7); }
        cnt[0 * 512 + F.tid] = c0; cnt[1 * 512 + F.tid] = c1; cnt[2 * 512 + F.tid] = c2; cnt[3 * 512 + F.tid] = c3;
        cnt[4 * 512 + F.tid] = c4; cnt[5 * 512 + F.tid] = c5; cnt[6 * 512 + F.tid] = c6; cnt[7 * 512 + F.tid] = c7; }
    __syncthreads();
    {   LAS int* ce = cnt + F.wave * 512 + F.lane * 8;
        int v[8], s = 0;
#pragma unroll
        for (int q = 0; q < 8; ++q) { v[q] = ce[q]; s += v[q]; }
        int inc = s;
#pragma unroll
        for (int d = 1; d < 64; d <<= 1) { const int y = __shfl_up(inc, d); if (F.lane >= d) inc += y; }
        int run = inc - s;
#pragma unroll
        for (int q = 0; q < 8; ++q) { ce[q] = run; run += v[q]; }
        if (F.lane == 63) tot[F.wave] = inc; }
    __syncthreads();
    int seg[8]; { int a = 0;
#pragma unroll
        for (int e = 0; e < 8; ++e) { seg[e] = a; a += (tot[e] + 255) & ~255; } }
    if (blockIdx.x == 0 && F.tid < 8) __hip_atomic_store(F.ctl + CW_MOECNT + F.tid, (unsigned)tot[F.tid], RLX_AGENT);
    for (int u = blockIdx.x; u < NCHUNK; u += F.G) {
        if (F.wave == 0) {
            const int tk = 64 * u + F.lane, tp = tk >> 5; const int2 ti = topi[tk];
            const unsigned long long low = ((1ull << F.lane) - 1ull) & (F.lane >= 32 ? 0xFFFFFFFF00000000ull : 0x00000000FFFFFFFFull);
            int s1 = 0, s2 = 0;
#pragma unroll
            for (int e = 0; e < 8; ++e) { const unsigned long long mk = __ballot(ti.x == e || ti.y == e); const int within = __popcll(mk & low); const int pos = seg[e] + cnt[e * 512 + tp] + within;
                if (ti.x == e) s1 = pos; if (ti.y == e) s2 = pos; }
            ((int2*)(F.ws + WS_SLOT))[tk] = make_int2(s1, s2);
            slot_l[F.lane * 2] = s1; slot_l[F.lane * 2 + 1] = s2;
        }
        __syncthreads();
        {   v4u ra[8];
#pragma unroll
            for (int j = 0; j < 8; ++j) ra[j] = ((const v4u*)(xn + (size_t)(64 * u + F.wave * 8 + j) * D))[F.lane];
#pragma unroll
            for (int j = 0; j < 8; ++j) { const int s1 = slot_l[(F.wave * 8 + j) * 2], s2 = slot_l[(F.wave * 8 + j) * 2 + 1];
                ((v4u*)(xs + (size_t)s1 * D))[F.lane] = ra[j]; ((v4u*)(xs + (size_t)s2 * D))[F.lane] = ra[j]; }
        }
        __syncthreads();
    }
}
template <bool TS> struct MoeOrder {
    static constexpr bool VARK = TS;
    int nM, nN, G, c; int cs[9]; int nfull, nsplit, ntk, parts;
    __device__ __forceinline__ void init(unsigned* cntw, int nN_, int G_, int c_, int ntk_) { nN = nN_; G = G_; c = c_; ntk = ntk_; cs[0] = 0;
#pragma unroll
        for (int e = 0; e < 8; ++e) cs[e + 1] = cs[e] + (int)((__hip_atomic_load(cntw + e, RLX_AGENT) + 255u) >> 8);
        nM = cs[8]; const int total = nM * nN; nfull = TS ? (total / G) * G : total; nsplit = total - nfull;
        if (nsplit > 32) { nfull = total; nsplit = 0; }
        parts = 2; }
    __device__ __forceinline__ bool next(int i, pg8::Unit& u) const {
        const long L = (long)i * G + c; if (L >= (long)nfull + parts * nsplit) return false;
        int base = (int)L; u.nt = ntk; u.koff = 0; u.aux = -1;
        if (TS && L >= nfull) { const int q = ((int)L - nfull) / parts, part = ((int)L - nfull) % parts; base = nfull + q; u.nt = ntk / parts; u.koff = part * (ntk / parts) * 128; u.aux = part ? q * 3 + part - 1 : -1; }
        pg8::order_map(base, nM, nN, u);
        int e = 0;
#pragma unroll
        for (int k = 1; k < 8; ++k) e += (u.pm >= cs[k]) ? 1 : 0;
        u.pn += e * nN; return true; }
    __device__ __forceinline__ void a_ready(const pg8::Unit&) const {}
    __device__ __forceinline__ void done(const pg8::Unit&) const {}
};
__device__ __forceinline__ void final_rows(const Frame& F) {
    const int gw = F.vcu * NWAVES + F.wave, NGW = F.G * NWAVES;
    const bf16* H = (const bf16*)(F.ws + WS_XN); const bf16* ys = (const bf16*)(F.ws + WS_YS); const bf16* y2 = (const bf16*)(F.ws + WS_Y2);
    const int2* slot = (const int2*)(F.ws + WS_SLOT); const float2* tw = (const float2*)(F.ws + WS_TOPW);
    LAS int* stab = (LAS int*)F.lds;
    int nside;
    { MoeOrder<true> S; S.init(F.ctl + CW_MOECNT, D / 256, F.G, 0, FF / 128); nside = S.parts - 1;
      for (int i = F.tid; i < S.nM * 4; i += NTHR) stab[i] = -1;
      __syncthreads();
      for (int q = F.tid; q < S.nsplit; q += NTHR) { pg8::Unit u; pg8::order_map(S.nfull + q, S.nM, 4, u); stab[u.pm * 4 + u.pn] = q; }
      __syncthreads(); }
    f32x4 gv[4];
#pragma unroll
    for (int j = 0; j < 4; ++j) gv[j] = ((const f32x4*)F.in[I_FINAL_NORM])[F.lane + 64 * j];
    for (int m = gw; m < M; m += NGW) {
        const int2 sl = slot[m]; const float2 w = tw[m];
        const v2u* xr = (const v2u*)(H + (size_t)m * D) + F.lane;
        const v2u* y1p = (const v2u*)(ys + (size_t)sl.x * D) + F.lane; const v2u* y2p = (const v2u*)(ys + (size_t)sl.y * D) + F.lane;
        f32x4 v[4]; float s = 0.f;
#pragma unroll
        for (int j = 0; j < 4; ++j) { const v2u a = y1p[64 * j], b = y2p[64 * j];
            f32x4 ya = (f32x4){bfl(a.x), bfh(a.x), bfl(a.y), bfh(a.y)}, yb = (f32x4){bfl(b.x), bfh(b.x), bfl(b.y), bfh(b.y)};
            const int qa = stab[(sl.x >> 8) * 4 + j], qb = stab[(sl.y >> 8) * 4 + j];
            if (qa >= 0) { for (int pc = 0; pc < nside; ++pc) { const v2u t = *((const v2u*)(y2 + (size_t)(qa * 3 + pc) * 65536 + (size_t)(sl.x & 255) * 256) + F.lane); ya += (f32x4){bfl(t.x), bfh(t.x), bfl(t.y), bfh(t.y)}; } }
            if (qb >= 0) { for (int pc = 0; pc < nside; ++pc) { const v2u t = *((const v2u*)(y2 + (size_t)(qb * 3 + pc) * 65536 + (size_t)(sl.y & 255) * 256) + F.lane); yb += (f32x4){bfl(t.x), bfh(t.x), bfl(t.y), bfh(t.y)}; } }
            const v2u hx = xr[64 * j];
            v[j] = (f32x4){bfl(hx.x), bfh(hx.x), bfl(hx.y), bfh(hx.y)} + w.x * ya + w.y * yb;
            s += (v[j].x * v[j].x + v[j].y * v[j].y) + (v[j].z * v[j].z + v[j].w * v[j].w); }
        const float rstd = 1.0f / sqrtf(wave_sum(s) * (1.0f / D) + EPS);
        f32x4* o = (f32x4*)(F.out + (size_t)m * D) + F.lane;
#pragma unroll
        for (int j = 0; j < 4; ++j) o[64 * j] = v[j] * rstd * gv[j];
    }
}

constexpr int RTAB_OFF = MISC_OFF + 1024;
__device__ __forceinline__ void build_rstd_tables(const Frame& F, const pg8::StaticOrder& S, const float* ssp) {
    LAS float* rtab = (LAS float*)(F.lds + RTAB_OFF);
    const int r = F.tid & 255, ih = F.tid >> 8;
    f32x4 pa[4][4]; bool ok[4];
#pragma unroll
    for (int k = 0; k < 4; ++k) { pg8::Unit u; ok[k] = S.next(2 * k + ih, u); const int pm = ok[k] ? u.pm : 0;
        const f32x4* p = (const f32x4*)(ssp + (size_t)(pm * 256 + r) * 16);
#pragma unroll
        for (int q = 0; q < 4; ++q) pa[k][q] = p[q]; }
#pragma unroll
    for (int k = 0; k < 4; ++k) if (ok[k]) {
        const float P0 = (pa[k][0][0] + pa[k][0][1]) + (pa[k][0][2] + pa[k][0][3]), P1 = (pa[k][1][0] + pa[k][1][1]) + (pa[k][1][2] + pa[k][1][3]);
        const float P2 = (pa[k][2][0] + pa[k][2][1]) + (pa[k][2][2] + pa[k][2][3]), P3 = (pa[k][3][0] + pa[k][3][1]) + (pa[k][3][2] + pa[k][3][3]);
        rtab[(2 * k + ih) * 256 + r] = __builtin_amdgcn_rsqf(((P0 + P1) + (P2 + P3)) * (1.0f / 1024.0f) + 1e-6f); }
    __syncthreads();
}

#ifndef PHMASK
#define PHMASK 0xFFFFu
#endif
#define EN(b) ((PHMASK >> (b)) & 1u)
#ifndef PROBE_MASK
#define PROBE_MASK 0u
#endif
#define NREP(b) (1 + (int)((PROBE_MASK >> (b)) & 1u))
constexpr int PH_PRO = 0, PH_L = 1, PH_PER_LAYER = 10, PH_FINAL = 21, NPH = 22;
__global__ void __launch_bounds__(NTHR, 2) mk_fwd(Args args) {
    extern __shared__ __attribute__((aligned(16))) unsigned char lds_raw[];
    Frame F;
    F.lds = (LAS unsigned char*)lds_raw;
    F.tid = threadIdx.x; F.lane = F.tid & 63; F.wave = __builtin_amdgcn_readfirstlane(F.tid >> 6);
    F.G = gridDim.x; { const int bx = blockIdx.x; F.vcu = (F.G % 8 == 0) ? (bx % 8) * (F.G / 8) + bx / 8 : bx; }
    F.ws = args.ws; F.ctl = (unsigned*)(args.ws + WS_CTL); F.in = args.in; F.out = args.out;
    volatile LAS unsigned* MISC = (volatile LAS unsigned*)(F.lds + MISC_OFF);
    for (int u = F.tid; u < (LDS_BYTES - MISC_OFF) / 4; u += NTHR) MISC[u] = 0u;
    __syncthreads();
    const int lo = args.ph_lo, hi = args.ph_hi;
    XcdBarrier bar; bar.bar = F.ctl + CW_BAR; bar.x = 0; bar.st = nullptr;
    if (hi - lo > 1) bar = xcd_barrier_post(F.ctl + CW_BAR, MISC + 8);
#define IN(k) (lo <= (k) && (k) < hi)
#define FRESH() do { int tz_ = threadIdx.x; asm volatile("" : "+v"(tz_)); F.tid = tz_; F.lane = tz_ & 63; F.wave = __builtin_amdgcn_readfirstlane(tz_ >> 6); } while (0)
#define SEAM(k) do { if (IN(k) && IN((k) + 1)) xcd_barrier(bar); } while (0)
    unsigned char* ws = args.ws;
    bf16* XN = (bf16*)(ws + WS_XN); bf16* PROJ = (bf16*)(ws + WS_BIG);

    if (EN(0) && IN(PH_PRO)) { FRESH(); for (int rep = 0; rep < NREP(0); ++rep) { convert_jobs(F, 0, 1, F.vcu * NWAVES + F.wave, F.G * NWAVES); convert_jobs(F, 39, 40, F.vcu * NWAVES + F.wave, F.G * NWAVES); }   ssm_tables(F); for (int rep = 0; rep < NREP(6); ++rep) cast_rows(F, F.in[I_X], XN); }
    SEAM(PH_PRO);
    for (int l = 0; l < 2; ++l) {
        const int pb = PH_L + l * PH_PER_LAYER;
        unsigned char* wl = ws + (size_t)l * WS_LSTRIDE;
        F.ycat_off = l ? WS_YCAT1 : WS_YCAT0;
        bf16* YCAT = (bf16*)(ws + F.ycat_off); bf16* MERGED = (bf16*)(ws + (l ? WS_MERGED1 : WS_MERGED0));
        if (EN(1) && IN(pb + 0)) {
            pg8::Gemm g{XN, (const bf16*)(wl + WS_WIN0), M, C_G, D}; pg8::StaticOrder S; S.init(M, C_G, F.G, (int)blockIdx.x);
            FRESH(); build_rstd_tables(F, S, (const float*)(ws + WS_SSP));
            pg8::EpiProj E{PROJ, INC, 1 << 30, (const float*)(ws + WS_SSP), (const LAS float*)(F.lds + RTAB_OFF), 0, 1.f};
            for (int rep = 0; rep < NREP(1); ++rep) pg8::gemm_phase<pg8::EpiProj, pg8::StaticOrder, true, true>(F.lds, g, S, E);
            const int nfull = S.nwg % F.G;
            if (nfull != 0) { FRESH(); const int widx = ((int)blockIdx.x >= nfull) ? ((int)blockIdx.x - nfull) * NWAVES + F.wave : -1, nw = (F.G - nfull) * NWAVES;
                if (l == 0) { convert_jobs(F, 1, 15, widx, nw); convert_jobs(F, 40, 41, widx, nw); } else convert_jobs(F, 23, 27, widx, nw); }
            else { FRESH(); const int widx = F.vcu * NWAVES + F.wave, nw = F.G * NWAVES; if (l == 0) { convert_jobs(F, 1, 15, widx, nw); convert_jobs(F, 40, 41, widx, nw); } else convert_jobs(F, 23, 27, widx, nw); }
            __syncthreads();
            pg8::Gemm g8{(const bf16*)(ws + WS_HB8), (const bf16*)(wl + WS_WING8), M, INC - C_G, D / 2}; pg8::StaticOrder S8; S8.init(M, INC - C_G, F.G, (int)blockIdx.x);
            FRESH(); build_rstd_tables(F, S8, (const float*)(ws + WS_SSP));
            pg8::EpiProj E8{PROJ, INC, 0, (const float*)(ws + WS_SSP), (const LAS float*)(F.lds + RTAB_OFF), C_G, 1.0f / (SC_XS * SC_W)};
            for (int rep = 0; rep < NREP(1); ++rep) pg8::gemm_phase<pg8::EpiProj, pg8::StaticOrder, true, true, true>(F.lds, g8, S8, E8);
        }
        SEAM(pb + 0);
        if (EN(2) && IN(pb + 1)) { FRESH(); mixer_b(F, l, NREP(9), NREP(2)); }
        SEAM(pb + 1);
        if (EN(3) && IN(pb + 2)) { FRESH(); for (int rep = 0; rep < NREP(3); ++rep) for (int u = blockIdx.x; u < NCHUNK; u += F.G) ssm_pass2_unit(F, l, u); }
        SEAM(pb + 2);
        if (EN(4) && IN(pb + 3)) {
            pg8::Gemm g{YCAT, (const bf16*)(wl + WS_WCAT0), M, D, D}; pg8::StaticOrder S; S.init(M, D, F.G, (int)blockIdx.x);
            pg8::EpiBranch E{PROJ + C_G, INC, MERGED, D};
            for (int rep = 0; rep < NREP(4); ++rep) pg8::gemm_phase<pg8::EpiBranch, pg8::StaticOrder, false, true>(F.lds, g, S, E);
        }
        SEAM(pb + 3);
        if (EN(5) && IN(pb + 4)) {
            pg8::Gemm g{MERGED, (const bf16*)(wl + WS_WOUT0), M, D, D}; pg8::StaticOrder S; S.init(M, D, F.G, (int)blockIdx.x);
            if (l == 0) { pg8::EpiResid<1, false> E{F.in[I_X], (pg8::bf16_t*)XN, D, (float*)(ws + WS_SSP), nullptr, 1.f, 1.f};
                pg8::gemm_phase<pg8::EpiResid<1, false>, pg8::StaticOrder, false, true>(F.lds, g, S, E); }
            else { for (int rep = 0; rep < NREP(5); ++rep) { pg8::EpiResid<0, true> E{XN, (rep + 1 < NREP(5)) ? (pg8::bf16_t*)PROJ : (pg8::bf16_t*)XN, D, nullptr, nullptr, 1.f, 1.f};
                pg8::gemm_phase<pg8::EpiResid<0, true>, pg8::StaticOrder, false, true>(F.lds, g, S, E); } }
        }
        SEAM(pb + 4);
        if (l == 0) {
            if (EN(7) && IN(pb + 6)) {
                pg8::Gemm g{XN, (const bf16*)(ws + WS_WGU0), M, 2 * FF, D}; pg8::StaticOrder S; S.init(M, 2 * FF, F.G, (int)blockIdx.x);
                FRESH(); build_rstd_tables(F, S, (const float*)(ws + WS_SSP));
                pg8::EpiSwiglu<true, true> E{PROJ, FF, 2 * FF / 256, (const float*)(ws + WS_SSP), (const LAS float*)(F.lds + RTAB_OFF), SC_ACT};
                for (int rep = 0; rep < NREP(7); ++rep) pg8::gemm_phase<pg8::EpiSwiglu<true, true>, pg8::StaticOrder, true, true>(F.lds, g, S, E);
            }
            SEAM(pb + 6);
            if (EN(8) && IN(pb + 7)) {
                pg8::Gemm g{PROJ, (const bf16*)(ws + WS_WD0), M, D, FF / 2}; pg8::StaticOrder S; S.init(M, D, F.G, (int)blockIdx.x);
                pg8::EpiResid<3, true> E{XN, (pg8::bf16_t*)XN, D, (float*)(ws + WS_SSP), ws + WS_HB8, SC_XS, 1.0f / (SC_ACT * SC_W)};
                pg8::gemm_phase<pg8::EpiResid<3, true>, pg8::StaticOrder, false, true, true>(F.lds, g, S, E);
            }
            SEAM(pb + 7);
        } else {
            if (EN(10) && IN(pb + 5)) { FRESH(); for (int rep = 0; rep < NREP(6); ++rep) { norm_rows<true>(F, XN, F.in[I_NORM_FFN] + D, (bf16*)(ws + WS_XNN)); __syncthreads(); } for (int rep = 0; rep < NREP(0); ++rep) { convert_jobs(F, 15, 23, F.vcu * NWAVES + F.wave, F.G * NWAVES); convert_jobs(F, 27, 39, F.vcu * NWAVES + F.wave, F.G * NWAVES); } }
            SEAM(pb + 5);
            if (EN(11) && IN(pb + 6)) { FRESH(); for (int rep = 0; rep < NREP(11); ++rep) moe_gather(F); }
            SEAM(pb + 6);
            if (EN(12) && IN(pb + 7)) {
                pg8::Gemm g{(const bf16*)(ws + WS_XS), (const bf16*)(ws + WS_WMOE), MPAD, 2 * FF, D / 2}; MoeOrder<false> S; S.init(F.ctl + CW_MOECNT, 2 * FF / 256, F.G, (int)blockIdx.x, D / 128);
                pg8::EpiSwiglu8 E{ws + WS_ACTM, FF, 2 * FF / 256, -1.4426950408889634f / (SC_XS * SC_W), (SC_XS * SC_W) * (SC_XS * SC_W) / SC_ACT};
                for (int rep = 0; rep < NREP(12); ++rep) pg8::gemm_phase<pg8::EpiSwiglu8, MoeOrder<false>, true, true, true>(F.lds, g, S, E);
            }
            if (IN(pb + 7) && IN(pb + 9)) xcd_barrier(bar);
            if (EN(14) && IN(pb + 9)) {
                pg8::Gemm g{(const bf16*)(ws + WS_ACTM), (const bf16*)(ws + WS_WD8), MPAD, D, FF / 2}; MoeOrder<true> S; S.init(F.ctl + CW_MOECNT, D / 256, F.G, (int)blockIdx.x, FF / 128);
                pg8::EpiMoeDown E{(bf16*)(ws + WS_YS), D, D / 256, (bf16*)(ws + WS_Y2), 1.0f / (SC_ACT * SC_W)};
                for (int rep = 0; rep < NREP(14); ++rep) pg8::gemm_phase<pg8::EpiMoeDown, MoeOrder<true>, true, true, true>(F.lds, g, S, E);
            }
            SEAM(pb + 9);
        }
    }
    if (EN(15) && IN(PH_FINAL)) { FRESH(); for (int rep = 0; rep < NREP(15); ++rep) final_rows(F); }
#undef IN
#undef SEAM
}

extern "C" void kernel_launch(void* const* d_in, const int* in_sizes, int n_in, void* d_out, int out_size, void* d_ws, size_t ws_size, hipStream_t stream) {
    static int grid = 0;
    if (grid == 0) {
        if (n_in != 26 || in_sizes[0] != M * D || out_size != M * D || ws_size < WS_END) { fprintf(stderr, "kernel_launch: unexpected shapes (n_in %d, in0 %d, out %d, ws %zu < %zu); nothing launched\n", n_in, n_in > 0 ? in_sizes[0] : -1, out_size, ws_size, (size_t)WS_END); grid = -1; return; }
        int dev = 0, cus = 0;
        if (hipGetDevice(&dev) != hipSuccess || hipDeviceGetAttribute(&cus, hipDeviceAttributeMultiprocessorCount, dev) != hipSuccess) { fprintf(stderr, "kernel_launch: device query failed\n"); grid = -1; return; }
        if (hipFuncSetAttribute((const void*)mk_fwd, hipFuncAttributeMaxDynamicSharedMemorySize, LDS_BYTES) != hipSuccess) { fprintf(stderr, "kernel_launch: hipFuncSetAttribute failed\n"); grid = -1; return; }
        int per_cu = 0;
        if (hipOccupancyMaxActiveBlocksPerMultiprocessor(&per_cu, (const void*)mk_fwd, NTHR, LDS_BYTES) != hipSuccess || per_cu < 1) fprintf(stderr, "kernel_launch: occupancy query reports %d blocks per CU\n", per_cu);
        (void)hipGetLastError();
        grid = cus;
    }
    if (grid < 0) return;
    if (hipMemsetAsync((char*)d_ws + WS_CTL, 0, CTL_ZERO_BYTES, stream) != hipSuccess) { fprintf(stderr, "kernel_launch: memset failed\n"); return; }
    Args a{};
    for (int i = 0; i < 26; ++i) a.in[i] = (const float*)d_in[i];
    a.out = (float*)d_out; a.ws = (unsigned char*)d_ws;
#if MK_ONE_LAUNCH
    a.ph_lo = 0; a.ph_hi = NPH;
    hipLaunchKernelGGL(mk_fwd, dim3(grid), dim3(NTHR), LDS_BYTES, stream, a);
#else
    for (int ph = 0; ph < NPH; ++ph) {
        if (ph == PH_L + 9) continue;
        a.ph_lo = ph; a.ph_hi = ph + 1;
        hipLaunchKernelGGL(mk_fwd, dim3(grid), dim3(NTHR), LDS_BYTES, stream, a);
    }
#endif
    const hipError_t le = hipPeekAtLastError();
    if (le != hipSuccess) fprintf(stderr, "kernel_launch: launch failed: %s\n", hipGetErrorName(le));
}
```

```cpp
#include <hip/hip_runtime.h>
#include <cstdio>
#include <cstdint>

#ifndef MK_ONE_LAUNCH
#define MK_ONE_LAUNCH 1
#endif

namespace pg8 {
#define PG8_LAS __attribute__((address_space(3)))
typedef unsigned short bf16_t;
typedef short bf16x8 __attribute__((ext_vector_type(8)));
typedef float f32x4 __attribute__((ext_vector_type(4)));
typedef float f32x2 __attribute__((ext_vector_type(2)));
typedef unsigned u32x4 __attribute__((ext_vector_type(4)));
constexpr int BM = 256, BK = 64, HALF = 128, HTB = HALF * BK * 2  , STAGE_BYTES = 8 * HTB, NXCD = 8, WGM = 8;

__host__ __device__ __forceinline__ int lds_byte(int r, int c) { const int st = (r >> 4) * 2 + (c >> 5), rr = r & 15, cc = c & 31, ob = rr * 64 + cc * 2; return st * 1024 + (ob ^ (((ob >> 9) & 1) << 5)); }
__host__ __device__ __forceinline__ void stage_rc(int b, int& R, int& C) { const int st = b / 1024, sb = b % 1024, swz = sb ^ (((sb >> 9) & 1) << 5); R = (st >> 1) * 16 + swz / 64; C = (st & 1) * 32 + (swz % 64) / 2; }
__host__ __device__ __forceinline__ int perm32(int rho) { const int n = rho >> 4, i = rho & 15; return 8 * (i >> 2) + 4 * n + (i & 3); }

struct Unit { int pm, pn; int nt, koff, aux; };
struct Gemm { const bf16_t* A; const bf16_t* Bt; int M, N, K; };

__host__ __device__ __forceinline__ void order_map(int L, int nM, int nN, Unit& u) {
    const int nwg = nM * nN;
    int wgid = L; { const int q = nwg / NXCD, r = nwg % NXCD, xcd = wgid % NXCD, off = wgid / NXCD; wgid = (xcd < r ? xcd * (q + 1) : r * (q + 1) + (xcd - r) * q) + off; }
    const int nig = WGM * nN, gid = wgid / nig, fm = gid * WGM, gsz = (nM - fm) < WGM ? (nM - fm) : WGM;
    u.pm = fm + ((wgid % nig) % gsz); u.pn = (wgid % nig) / gsz;
}
struct StaticOrder {
    static constexpr bool VARK = false;
    int nM, nN, nwg, G, c;
    __host__ __device__ void init(int M, int N, int G_, int c_) { nM = M / BM; nN = N / BM; nwg = nM * nN; G = G_; c = c_; }
    __host__ __device__ bool next(int i, Unit& u) const {
        const long L = (long)i * G + c; if (L >= nwg) return false;
        order_map((int)L, nM, nN, u); u.aux = i; return true;
    }
    __device__ __forceinline__ void a_ready(const Unit&) const {}
    __device__ __forceinline__ void done(const Unit&) const {}
};
typedef __bf16 bf16x2n __attribute__((ext_vector_type(2)));
__device__ __forceinline__ unsigned cvt_pk_bf16(float lo, float hi) { const f32x2 v = {lo, hi}; return __builtin_bit_cast(unsigned, __builtin_convertvector(v, bf16x2n)); }

template <class Epi, class Sched, bool ALIGN_EPI = false, bool SP2 = false, bool FP8 = false>
__device__ __forceinline__ void gemm_phase(PG8_LAS unsigned char* lds, const Gemm g, const Sched& S, const Epi& E) {
    int tid_ = threadIdx.x; asm volatile("" : "+v"(tid_));
    const int tid = tid_, wid = __builtin_amdgcn_readfirstlane(tid >> 6), lane = tid & 63, wr = wid >> 2, wc = wid & 3, fr = lane & 15, fq = lane >> 4;
    const int K = g.K, nt = K / BK;
    unsigned voffA[2], voffB[2];
#pragma unroll
    for (int i = 0; i < 2; ++i) { int R, C; stage_rc(tid * 16 + i * 8192, R, C); const int Rb = Epi::PERM ? ((R & ~31) + perm32(R & 31)) : R;
        voffA[i] = (unsigned)(R * K + C) * 2u; voffB[i] = (unsigned)(Rb * K + C) * 2u; }
    const size_t kstep = (size_t)(BK * 2);
    const size_t hstep = (size_t)HALF * K * 2;
    const size_t tstep = 2 * hstep;
    const unsigned ldsw = (unsigned)wid * 1024u;
    const int aoff = lds_byte(wr * 64 + fr, fq * 8), boff = lds_byte(wc * 32 + fr, fq * 8);
#define PG8_SA(b, h) (((b) * 2 + (h)) * HTB)
#define PG8_SB(b, h) ((4 + (b) * 2 + (h)) * HTB)
#define PG8_STAGE(bufoff, gbase, voff) do { _Pragma("unroll") for (int _i = 0; _i < 2; ++_i) \
        __builtin_amdgcn_global_load_lds((const unsigned*)((const char*)(gbase) + (voff)[_i]), (PG8_LAS unsigned*)(lds + (bufoff) + ldsw + _i * 8192), 16, 0, 0); } while (0)
#define PG8_LDA(dst, b, h) do { _Pragma("unroll") for (int m = 0; m < 4; ++m) { if constexpr (FP8) { dst##w[m] = __builtin_shufflevector(*(const PG8_LAS bf16x8*)(lds + PG8_SA(b, h) + aoff + m * 2048), *(const PG8_LAS bf16x8*)(lds + PG8_SA(b, h) + aoff + m * 2048 + 1024), 0, 1, 2, 3, 4, 5, 6, 7, 8, 9, 10, 11, 12, 13, 14, 15); } \
        else { _Pragma("unroll") for (int k = 0; k < 2; ++k) dst[m][k] = *(const PG8_LAS bf16x8*)(lds + PG8_SA(b, h) + aoff + m * 2048 + k * 1024); } } } while (0)
#define PG8_LDB(dst, b, h) do { _Pragma("unroll") for (int n = 0; n < 2; ++n) { if constexpr (FP8) { dst##w[n] = __builtin_shufflevector(*(const PG8_LAS bf16x8*)(lds + PG8_SB(b, h) + boff + n * 2048), *(const PG8_LAS bf16x8*)(lds + PG8_SB(b, h) + boff + n * 2048 + 1024), 0, 1, 2, 3, 4, 5, 6, 7, 8, 9, 10, 11, 12, 13, 14, 15); } \
        else { _Pragma("unroll") for (int k = 0; k < 2; ++k) dst[n][k] = *(const PG8_LAS bf16x8*)(lds + PG8_SB(b, h) + boff + n * 2048 + k * 1024); } } } while (0)
#define PG8_MMA(ai, bj, At, Bt) do { __builtin_amdgcn_s_setprio(1); _Pragma("unroll") for (int m = 0; m < 4; ++m) _Pragma("unroll") for (int n = 0; n < 2; ++n) { \
        if constexpr (FP8) { typedef int v8i_ __attribute__((ext_vector_type(8))); \
            asm volatile("v_mfma_scale_f32_16x16x128_f8f6f4 %0, %1, %2, %0, %3, %3 op_sel_hi:[0,0,0]" : "+v"(acc[ai][bj][m][n]) : "v"(__builtin_bit_cast(v8i_, Bt##w[n])), "v"(__builtin_bit_cast(v8i_, At##w[m])), "v"(sc8)); } \
        else { _Pragma("unroll") for (int k = 0; k < 2; ++k) acc[ai][bj][m][n] = __builtin_amdgcn_mfma_f32_16x16x32_bf16(Bt[n][k], At[m][k], acc[ai][bj][m][n], 0, 0, 0); } } \
        __builtin_amdgcn_s_setprio(0); } while (0)
#define PG8_WAIT_V(n) asm volatile("s_waitcnt vmcnt(" #n ")" ::: "memory")
#define PG8_WAIT_L(n) asm volatile("s_waitcnt lgkmcnt(" #n ")" ::: "memory")
#define PG8_BAR __builtin_amdgcn_s_barrier()
#define PG8_SCHED __builtin_amdgcn_sched_barrier(0)
    Unit cur, nxt; int ui = 0;
    if (!S.next(0, cur)) return;
    f32x4 acc[2][2][4][2];
#pragma unroll
    for (int a = 0; a < 2; ++a)
#pragma unroll
        for (int b = 0; b < 2; ++b)
#pragma unroll
            for (int m = 0; m < 4; ++m)
#pragma unroll
                for (int n = 0; n < 2; ++n) acc[a][b][m][n] = (f32x4){0.f, 0.f, 0.f, 0.f};
    bf16x8 At[4][2], B0[2][2], B1[2][2];
    typedef short bf16x16_ __attribute__((ext_vector_type(16))); bf16x16_ Atw[4], B0w[2], B1w[2];
    unsigned sc8 = 0x7F7F7F7Fu; asm volatile("" : "+v"(sc8));
    const char* cA = (const char*)g.A + (size_t)cur.pm * tstep; const char* cB = (const char*)g.Bt + (size_t)cur.pn * tstep;
    int cnt = nt;
    if constexpr (Sched::VARK) { cnt = cur.nt; cA += cur.koff; cB += cur.koff; }
    S.a_ready(cur);
    if constexpr (SP2) {
        PG8_STAGE(PG8_SB(0, 0), cB, voffB); PG8_STAGE(PG8_SB(0, 1), cB + hstep, voffB); PG8_STAGE(PG8_SA(0, 0), cA, voffA); PG8_STAGE(PG8_SA(0, 1), cA + hstep, voffA);
        if (wr == 1) PG8_BAR;
        PG8_WAIT_V(2); PG8_BAR;
        PG8_STAGE(PG8_SB(1, 0), cB + kstep, voffB); PG8_STAGE(PG8_SA(1, 0), cA + kstep, voffA); PG8_STAGE(PG8_SB(1, 1), cB + hstep + kstep, voffB);
        PG8_WAIT_V(6); PG8_BAR;
    } else {
        PG8_STAGE(PG8_SB(0, 0), cB, voffB); PG8_STAGE(PG8_SA(0, 0), cA, voffA); PG8_STAGE(PG8_SB(0, 1), cB + hstep, voffB); PG8_STAGE(PG8_SA(0, 1), cA + hstep, voffA);
        if (wr == 1) PG8_BAR;
        PG8_WAIT_V(4); PG8_BAR;
        PG8_STAGE(PG8_SB(1, 0), cB + kstep, voffB); PG8_STAGE(PG8_SA(1, 0), cA + kstep, voffA); PG8_STAGE(PG8_SB(1, 1), cB + hstep + kstep, voffB);
        PG8_WAIT_V(6); PG8_BAR;
    }
    for (;;) {
        const bool has_next = S.next(ui + 1, nxt);
        const char* nA = has_next ? (const char*)g.A + (size_t)nxt.pm * tstep : cA; const char* nB = has_next ? (const char*)g.Bt + (size_t)nxt.pn * tstep : cB;
        if constexpr (Sched::VARK) { if (has_next) { nA += nxt.koff; nB += nxt.koff; } }
        for (int t = 0; t < cnt; t += 2) {
            const bool last = (t == cnt - 2);
            const char* a1 = cA + (size_t)(t + 1) * kstep;
            const char* a2 = last ? nA : cA + (size_t)(t + 2) * kstep; const char* b2 = last ? nB : cB + (size_t)(t + 2) * kstep;
            const char* a3 = a2 + kstep; const char* b3 = b2 + kstep;
            if (last && has_next) S.a_ready(nxt);
            if constexpr (Epi::MIDK) { if (t == Epi::MID0 || t == Epi::MID1) { int tz_ = tid; asm volatile("" : "+v"(tz_)); const int ln_ = tz_ & 63; E.mid(acc, cur, t, wr, wc, ln_ & 15, ln_ >> 4); } }
            if constexpr (SP2) {
            PG8_LDB(B0, 0, 0); PG8_LDB(B1, 0, 1); PG8_SCHED; PG8_LDA(At, 0, 0); PG8_STAGE(PG8_SA(1, 1), a1 + hstep, voffA);
            PG8_WAIT_V(8); PG8_WAIT_L(0); PG8_BAR; PG8_MMA(0, 0, At, B0); PG8_MMA(0, 1, At, B1); PG8_BAR; PG8_SCHED;
            PG8_LDA(At, 0, 1); PG8_STAGE(PG8_SB(0, 0), b2, voffB); PG8_STAGE(PG8_SB(0, 1), b2 + hstep, voffB); PG8_STAGE(PG8_SA(0, 0), a2, voffA);
            PG8_WAIT_V(8); PG8_WAIT_L(0); PG8_BAR; PG8_MMA(1, 0, At, B0); PG8_MMA(1, 1, At, B1); PG8_BAR; PG8_SCHED;
            PG8_LDB(B0, 1, 0); PG8_LDB(B1, 1, 1); PG8_SCHED; PG8_LDA(At, 1, 0); PG8_STAGE(PG8_SA(0, 1), a2 + hstep, voffA);
            PG8_WAIT_V(8); PG8_WAIT_L(0); PG8_BAR; PG8_MMA(0, 0, At, B0); PG8_MMA(0, 1, At, B1); PG8_BAR; PG8_SCHED;
            PG8_LDA(At, 1, 1); PG8_STAGE(PG8_SB(1, 0), b3, voffB); PG8_STAGE(PG8_SB(1, 1), b3 + hstep, voffB); PG8_STAGE(PG8_SA(1, 0), a3, voffA);
            PG8_WAIT_V(8); PG8_WAIT_L(0); PG8_BAR; PG8_MMA(1, 0, At, B0); PG8_MMA(1, 1, At, B1); PG8_BAR; PG8_SCHED;
            } else {
            PG8_LDB(B0, 0, 0); PG8_SCHED; PG8_LDA(At, 0, 0); PG8_STAGE(PG8_SA(1, 1), a1 + hstep, voffA);
            PG8_WAIT_L(8); PG8_BAR; PG8_WAIT_L(0); PG8_MMA(0, 0, At, B0); PG8_BAR; PG8_SCHED;
            PG8_LDB(B1, 0, 1); PG8_STAGE(PG8_SB(0, 0), b2, voffB);
            PG8_BAR; PG8_WAIT_L(0); PG8_MMA(0, 1, At, B1); PG8_BAR;
            PG8_LDA(At, 0, 1); PG8_STAGE(PG8_SA(0, 0), a2, voffA);
            PG8_BAR; PG8_WAIT_L(0); PG8_MMA(1, 0, At, B0); PG8_BAR; PG8_SCHED;
            PG8_STAGE(PG8_SB(0, 1), b2 + hstep, voffB);
            PG8_WAIT_V(6); PG8_BAR; PG8_MMA(1, 1, At, B1); PG8_BAR;
            PG8_LDB(B0, 1, 0); PG8_SCHED; PG8_LDA(At, 1, 0); PG8_STAGE(PG8_SA(0, 1), a2 + hstep, voffA);
            PG8_WAIT_L(8); PG8_BAR; PG8_WAIT_L(0); PG8_MMA(0, 0, At, B0); PG8_BAR; PG8_SCHED;
            PG8_LDB(B1, 1, 1); PG8_STAGE(PG8_SB(1, 0), b3, voffB);
            PG8_BAR; PG8_WAIT_L(0); PG8_MMA(0, 1, At, B1); PG8_BAR;
            PG8_LDA(At, 1, 1); PG8_STAGE(PG8_SA(1, 0), a3, voffA);
            PG8_BAR; PG8_WAIT_L(0); PG8_MMA(1, 0, At, B0); PG8_BAR; PG8_SCHED;
            PG8_STAGE(PG8_SB(1, 1), b3 + hstep, voffB);
            PG8_WAIT_V(6); PG8_BAR; PG8_MMA(1, 1, At, B1); PG8_BAR;
            }
        }
        if constexpr (ALIGN_EPI) { if (wr == 0) PG8_BAR; }
        if constexpr (FP8) asm volatile("s_nop 15\n\ts_nop 15" ::: "memory");
        if constexpr (!Epi::AFTER_DRAIN) { int tz_ = tid; asm volatile("" : "+v"(tz_)); const int ln_ = tz_ & 63;
            E(acc, cur, wr, wc, ln_ & 15, ln_ >> 4); S.done(cur); }
        if (!has_next) break;
#pragma unroll
        for (int a = 0; a < 2; ++a)
#pragma unroll
            for (int b = 0; b < 2; ++b)
#pragma unroll
                for (int m = 0; m < 4; ++m)
#pragma unroll
                    for (int n = 0; n < 2; ++n) acc[a][b][m][n] = (f32x4){0.f, 0.f, 0.f, 0.f};
        cur = nxt; cA = nA; cB = nB; ++ui; if constexpr (Sched::VARK) cnt = cur.nt;
        if constexpr (ALIGN_EPI) { if (wr == 1) PG8_BAR; }
    }
    PG8_WAIT_V(0);
    if constexpr (!ALIGN_EPI) { if (wr == 0) PG8_BAR; }
    PG8_BAR;
    if constexpr (Epi::AFTER_DRAIN) { E.fused(acc, cur, wr, wc, fr, fq, lds, wid, lane); S.done(cur); }
#undef PG8_SA
#undef PG8_SB
#undef PG8_STAGE
#undef PG8_LDA
#undef PG8_LDB
#undef PG8_MMA
#undef PG8_WAIT_V
#undef PG8_WAIT_L
#undef PG8_BAR
#undef PG8_SCHED
}

__device__ __forceinline__ float bfl(unsigned w) { return __uint_as_float(w << 16); }
__device__ __forceinline__ float bfh(unsigned w) { return __uint_as_float(w & 0xffff0000u); }
__device__ __forceinline__ float sigmoid_clamped(float l) { l = fminf(fmaxf(l, -30.f), 30.f); return __builtin_amdgcn_rcpf(1.f + __expf(-l)); }
__device__ __forceinline__ float onepexp_clamped(float l) { l = fminf(fmaxf(l, -30.f), 30.f); return 1.f + __expf(-l); }

__device__ __forceinline__ float sum_fq(float x) {
    { const auto r = __builtin_amdgcn_permlane16_swap(__float_as_uint(x), __float_as_uint(x), false, false); x = __uint_as_float(r[0]) + __uint_as_float(r[1]); }
    { const auto r = __builtin_amdgcn_permlane32_swap(__float_as_uint(x), __float_as_uint(x), false, false); x = __uint_as_float(r[0]) + __uint_as_float(r[1]); }
    return x;
}
__device__ __forceinline__ float row_rstd(const float* ssp, int r, int fq) {
    const f32x4 p4 = *(const f32x4*)(ssp + (size_t)r * 16 + 4 * fq);
    float s = (p4[0] + p4[1]) + (p4[2] + p4[3]);
    s = sum_fq(s);
    return __builtin_amdgcn_rsqf(s * (1.0f / 1024.0f) + 1e-6f);
}
__device__ __forceinline__ void row_rstd8(const float* ssp, int row0, int fq, float (&rs)[2][4]) {
    f32x4 p4[2][4];
#pragma unroll
    for (int ai = 0; ai < 2; ++ai)
#pragma unroll
        for (int m = 0; m < 4; ++m) p4[ai][m] = *(const f32x4*)(ssp + (size_t)(row0 + ai * HALF + m * 16) * 16 + 4 * fq);
#pragma unroll
    for (int ai = 0; ai < 2; ++ai)
#pragma unroll
        for (int m = 0; m < 4; ++m) { float s = (p4[ai][m][0] + p4[ai][m][1]) + (p4[ai][m][2] + p4[ai][m][3]); s = sum_fq(s); rs[ai][m] = __builtin_amdgcn_rsqf(s * (1.0f / 1024.0f) + 1e-6f); }
}
__device__ __forceinline__ void rstd8(const PG8_LAS float* rtab, const float* ssp, const Unit& u, int row0, int rloc, int fq, float (&rs)[2][4]) {
    if (u.aux < 8) {
#pragma unroll
        for (int ai = 0; ai < 2; ++ai)
#pragma unroll
            for (int m = 0; m < 4; ++m) rs[ai][m] = rtab[u.aux * 256 + rloc + ai * HALF + m * 16];
    } else row_rstd8(ssp, row0, fq, rs);
}
struct EpiStoreBf16 {
    static constexpr bool PERM = true, AFTER_DRAIN = false, MIDK = false; static constexpr int MID0 = -1, MID1 = -1;
    bf16_t* O; int ldc; int nct;
    __device__ __forceinline__ void operator()(const f32x4 (&acc)[2][2][4][2], const Unit& u, int wr, int wc, int fr, int fq) const {
        const int row0 = u.pm * BM + wr * 64 + fr, col0 = (u.pn % nct) * BM + wc * 32 + 8 * fq;
#pragma unroll
        for (int ai = 0; ai < 2; ++ai)
#pragma unroll
            for (int m = 0; m < 4; ++m) { bf16_t* rowp = O + (size_t)(row0 + ai * HALF + m * 16) * ldc + col0;
#pragma unroll
                for (int bj = 0; bj < 2; ++bj) { const f32x4 v0 = acc[ai][bj][m][0], v1 = acc[ai][bj][m][1];
                    u32x4 w; w.x = cvt_pk_bf16(v0[0], v0[1]); w.y = cvt_pk_bf16(v0[2], v0[3]); w.z = cvt_pk_bf16(v1[0], v1[1]); w.w = cvt_pk_bf16(v1[2], v1[3]);
                    *(u32x4*)(rowp + bj * HALF) = w; } }
    }
};
struct EpiProj {
    static constexpr bool PERM = true, AFTER_DRAIN = false, MIDK = false; static constexpr int MID0 = -1, MID1 = -1;
    bf16_t* O; int ldc; int gate_tile0; const float* ssp; const PG8_LAS float* rtab; int col_off; float scale;
    __device__ __forceinline__ void operator()(const f32x4 (&acc)[2][2][4][2], const Unit& u, int wr, int wc, int fr, int fq) const {
        const int row0 = u.pm * BM + wr * 64 + fr, col0 = col_off + u.pn * BM + wc * 32 + 8 * fq;
        const bool gate = u.pn >= gate_tile0;
        float rsv[2][4]; rstd8(rtab, ssp, u, row0, wr * 64 + fr, fq, rsv);
#pragma unroll
        for (int ai = 0; ai < 2; ++ai)
#pragma unroll
            for (int m = 0; m < 4; ++m) { bf16_t* rowp = O + (size_t)(row0 + ai * HALF + m * 16) * ldc + col0;
                const float rs = rsv[ai][m] * scale;
                if (gate) { const float k1 = rs * -1.4426950408889634f;
#pragma unroll
                    for (int bj = 0; bj < 2; ++bj) { u32x4 w;
#pragma unroll
                        for (int q = 0; q < 4; ++q) { const f32x2 a2 = {acc[ai][bj][m][q >> 1][2 * (q & 1)], acc[ai][bj][m][q >> 1][2 * (q & 1) + 1]}; const f32x2 t = a2 * k1;
                            const f32x2 ex = {__builtin_amdgcn_exp2f(__builtin_amdgcn_fmed3f(t.x, -43.280851f, 43.280851f)), __builtin_amdgcn_exp2f(__builtin_amdgcn_fmed3f(t.y, -43.280851f, 43.280851f))};
                            const f32x2 o = ex + 1.0f; w[q] = cvt_pk_bf16(o.x, o.y); }
                        *(u32x4*)(rowp + bj * HALF) = w; } }
                else {
#pragma unroll
                    for (int bj = 0; bj < 2; ++bj) { const f32x4 v0 = acc[ai][bj][m][0] * rs, v1 = acc[ai][bj][m][1] * rs;
                        u32x4 w; w.x = cvt_pk_bf16(v0[0], v0[1]); w.y = cvt_pk_bf16(v0[2], v0[3]); w.z = cvt_pk_bf16(v1[0], v1[1]); w.w = cvt_pk_bf16(v1[2], v1[3]);
                        *(u32x4*)(rowp + bj * HALF) = w; } } }
    }
};
__device__ __forceinline__ unsigned pk4_fp8(float a, float b, float c, float d) {
    a = fminf(fmaxf(a, -448.f), 448.f); b = fminf(fmaxf(b, -448.f), 448.f); c = fminf(fmaxf(c, -448.f), 448.f); d = fminf(fmaxf(d, -448.f), 448.f);
    int p = __builtin_amdgcn_cvt_pk_fp8_f32(a, b, 0, false); p = __builtin_amdgcn_cvt_pk_fp8_f32(c, d, p, true); return (unsigned)p;
}
struct EpiSwiglu8 {
    static constexpr bool PERM = true, AFTER_DRAIN = false, MIDK = false; static constexpr int MID0 = -1, MID1 = -1;
    unsigned char* O; int ldc; int nct; float k1, cden;
    __device__ __forceinline__ void operator()(const f32x4 (&acc)[2][2][4][2], const Unit& u, int wr, int wc, int fr, int fq) const {
        const int row0 = u.pm * BM + wr * 64 + fr, col0 = (u.pn % nct) * HALF + wc * 32 + 8 * fq;
#pragma unroll
        for (int ai = 0; ai < 2; ++ai)
#pragma unroll
            for (int m = 0; m < 4; ++m) { unsigned char* rowp = O + (size_t)(row0 + ai * HALF + m * 16) * ldc + col0;
                float r[8];
#pragma unroll
                for (int n = 0; n < 2; ++n)
#pragma unroll
                    for (int h = 0; h < 2; ++h) { const f32x2 g2 = {acc[ai][0][m][n][2 * h], acc[ai][0][m][n][2 * h + 1]}, u2 = {acc[ai][1][m][n][2 * h], acc[ai][1][m][n][2 * h + 1]};
                        const f32x2 t = g2 * k1; const f32x2 ex = {__builtin_amdgcn_exp2f(t.x), __builtin_amdgcn_exp2f(t.y)}; const f32x2 d = ex * cden + cden;
                        const f32x2 rr = {__builtin_amdgcn_rcpf(d.x), __builtin_amdgcn_rcpf(d.y)}; const f32x2 o = (g2 * u2) * rr; r[n * 4 + 2 * h] = o.x; r[n * 4 + 2 * h + 1] = o.y; }
                typedef unsigned u32x2v __attribute__((ext_vector_type(2))); u32x2v w; w.x = pk4_fp8(r[0], r[1], r[2], r[3]); w.y = pk4_fp8(r[4], r[5], r[6], r[7]);
                *(u32x2v*)rowp = w; }
    }
};
struct EpiMoeDown {
    static constexpr bool PERM = true, AFTER_DRAIN = false, MIDK = false; static constexpr int MID0 = -1, MID1 = -1;
    bf16_t* O; int ldc; int nct; bf16_t* O2; float scale;
    __device__ __forceinline__ void operator()(const f32x4 (&acc)[2][2][4][2], const Unit& u, int wr, int wc, int fr, int fq) const {
        const bool second = u.aux >= 0;
        bf16_t* base = second ? O2 + (size_t)u.aux * 65536 + (size_t)(wr * 64 + fr) * 256 + wc * 32 + 8 * fq
                              : O + (size_t)(u.pm * BM + wr * 64 + fr) * ldc + (u.pn % nct) * BM + wc * 32 + 8 * fq;
        const int ld = second ? 256 : ldc;
#pragma unroll
        for (int ai = 0; ai < 2; ++ai)
#pragma unroll
            for (int m = 0; m < 4; ++m) { bf16_t* rowp = base + (size_t)(ai * HALF + m * 16) * ld;
#pragma unroll
                for (int bj = 0; bj < 2; ++bj) { const f32x4 v0 = acc[ai][bj][m][0] * scale, v1 = acc[ai][bj][m][1] * scale;
                    u32x4 w; w.x = cvt_pk_bf16(v0[0], v0[1]); w.y = cvt_pk_bf16(v0[2], v0[3]); w.z = cvt_pk_bf16(v1[0], v1[1]); w.w = cvt_pk_bf16(v1[2], v1[3]);
                    *(u32x4*)(rowp + bj * HALF) = w; } }
    }
};
template <int NORMOUT, bool BASE16> struct EpiResid {
    static constexpr bool PERM = true, AFTER_DRAIN = false, MIDK = false; static constexpr int MID0 = -1, MID1 = -1;
    const void* base; bf16_t* hb; int ldc; float* ssp; unsigned char* hb8; float hb8_scale; float ascale;
    __device__ __forceinline__ void row_out(const f32x4 (&o)[2][2], size_t off, int r, int pn, int wc, int fq) const {
        float q = 0.f;
#pragma unroll
        for (int bj = 0; bj < 2; ++bj) { const f32x4 o0 = o[bj][0], o1 = o[bj][1];
            if (NORMOUT & 1) q += ((o0[0] * o0[0] + o0[1] * o0[1]) + (o0[2] * o0[2] + o0[3] * o0[3])) + ((o1[0] * o1[0] + o1[1] * o1[1]) + (o1[2] * o1[2] + o1[3] * o1[3]));
            u32x4 w; w.x = cvt_pk_bf16(o0[0], o0[1]); w.y = cvt_pk_bf16(o0[2], o0[3]); w.z = cvt_pk_bf16(o1[0], o1[1]); w.w = cvt_pk_bf16(o1[2], o1[3]); *(u32x4*)(hb + off + bj * HALF) = w;
            if (NORMOUT & 2) { typedef unsigned u32x2v __attribute__((ext_vector_type(2))); u32x2v w8; w8.x = pk4_fp8(o0[0] * hb8_scale, o0[1] * hb8_scale, o0[2] * hb8_scale, o0[3] * hb8_scale); w8.y = pk4_fp8(o1[0] * hb8_scale, o1[1] * hb8_scale, o1[2] * hb8_scale, o1[3] * hb8_scale); *(u32x2v*)(hb8 + off + bj * HALF) = w8; } }
        if (NORMOUT & 1) { q = sum_fq(q); if (fq == 0) ssp[(size_t)r * 16 + 4 * pn + wc] = q; }
    }
    __device__ __forceinline__ void operator()(const f32x4 (&acc)[2][2][4][2], const Unit& u, int wr, int wc, int fr, int fq) const {
        const int row0 = u.pm * BM + wr * 64 + fr, col0 = u.pn * BM + wc * 32 + 8 * fq;
        if constexpr (BASE16) { const bf16_t* b16 = (const bf16_t*)base;
#pragma unroll
            for (int ai = 0; ai < 2; ++ai) { u32x4 bs[4][2];
#pragma unroll
                for (int m = 0; m < 4; ++m)
#pragma unroll
                    for (int bj = 0; bj < 2; ++bj) bs[m][bj] = *(const u32x4*)(b16 + (size_t)(row0 + ai * HALF + m * 16) * ldc + col0 + bj * HALF);
#pragma unroll
                for (int m = 0; m < 4; ++m) { const int r = row0 + ai * HALF + m * 16; f32x4 o[2][2];
#pragma unroll
                    for (int bj = 0; bj < 2; ++bj) { const u32x4 b = bs[m][bj];
                        o[bj][0] = (f32x4){bfl(b.x), bfh(b.x), bfl(b.y), bfh(b.y)} + acc[ai][bj][m][0] * ascale; o[bj][1] = (f32x4){bfl(b.z), bfh(b.z), bfl(b.w), bfh(b.w)} + acc[ai][bj][m][1] * ascale; }
                    row_out(o, (size_t)r * ldc + col0, r, u.pn, wc, fq); }
                asm volatile("" ::: "memory"); }
        } else { const float* b32 = (const float*)base;
#pragma unroll
            for (int ai = 0; ai < 2; ++ai)
#pragma unroll
                for (int mp = 0; mp < 2; ++mp) { f32x4 bs[2][2][2];
#pragma unroll
                    for (int mm = 0; mm < 2; ++mm) { const size_t off = (size_t)(row0 + ai * HALF + (2 * mp + mm) * 16) * ldc + col0;
#pragma unroll
                        for (int bj = 0; bj < 2; ++bj)
#pragma unroll
                            for (int n = 0; n < 2; ++n) bs[mm][bj][n] = *(const f32x4*)(b32 + off + bj * HALF + n * 4); }
#pragma unroll
                    for (int mm = 0; mm < 2; ++mm) { const int r = row0 + ai * HALF + (2 * mp + mm) * 16; f32x4 o[2][2];
#pragma unroll
                        for (int bj = 0; bj < 2; ++bj) { o[bj][0] = bs[mm][bj][0] + acc[ai][bj][2 * mp + mm][0] * ascale; o[bj][1] = bs[mm][bj][1] + acc[ai][bj][2 * mp + mm][1] * ascale; }
                        row_out(o, (size_t)r * ldc + col0, r, u.pn, wc, fq); }
                    asm volatile("" ::: "memory"); }
        }
    }
};
template <bool RS, bool OUT8 = false> struct EpiSwiglu {
    static constexpr bool PERM = true, AFTER_DRAIN = false, MIDK = false; static constexpr int MID0 = -1, MID1 = -1;
    bf16_t* O; int ldc; int nct; const float* ssp; const PG8_LAS float* rtab; float out_scale;
    __device__ __forceinline__ void operator()(const f32x4 (&acc)[2][2][4][2], const Unit& u, int wr, int wc, int fr, int fq) const {
        const int row0 = u.pm * BM + wr * 64 + fr, col0 = (u.pn % nct) * HALF + wc * 32 + 8 * fq;
        float rsv[2][4]; if (RS) rstd8(rtab, ssp, u, row0, wr * 64 + fr, fq, rsv);
#pragma unroll
        for (int ai = 0; ai < 2; ++ai)
#pragma unroll
            for (int m = 0; m < 4; ++m) { bf16_t* rowp = O + (size_t)(row0 + ai * HALF + m * 16) * ldc + col0;
                float r[8]; float rs = 1.f; if (RS) rs = rsv[ai][m];
                const float k1 = rs * -1.4426950408889634f, cden = (RS || OUT8) ? __builtin_amdgcn_rcpf(rs * rs * (OUT8 ? out_scale : 1.f)) : 1.f;
#pragma unroll
                for (int n = 0; n < 2; ++n)
#pragma unroll
                    for (int h = 0; h < 2; ++h) { const f32x2 g2 = {acc[ai][0][m][n][2 * h], acc[ai][0][m][n][2 * h + 1]}, u2 = {acc[ai][1][m][n][2 * h], acc[ai][1][m][n][2 * h + 1]};
                        const f32x2 t = g2 * k1; const f32x2 ex = {__builtin_amdgcn_exp2f(t.x), __builtin_amdgcn_exp2f(t.y)}; const f32x2 d = ex * cden + cden;
                        const f32x2 rr = {__builtin_amdgcn_rcpf(d.x), __builtin_amdgcn_rcpf(d.y)}; const f32x2 o = (g2 * u2) * rr; r[n * 4 + 2 * h] = o.x; r[n * 4 + 2 * h + 1] = o.y; }
                if constexpr (OUT8) { typedef unsigned u32x2v __attribute__((ext_vector_type(2))); u32x2v w; w.x = pk4_fp8(r[0], r[1], r[2], r[3]); w.y = pk4_fp8(r[4], r[5], r[6], r[7]);
                    *(u32x2v*)((unsigned char*)O + (size_t)(row0 + ai * HALF + m * 16) * ldc + col0) = w; }
                else { u32x4 w; w.x = cvt_pk_bf16(r[0], r[1]); w.y = cvt_pk_bf16(r[2], r[3]); w.z = cvt_pk_bf16(r[4], r[5]); w.w = cvt_pk_bf16(r[6], r[7]);
                    *(u32x4*)rowp = w; } }
    }
};
struct EpiBranch {
    static constexpr bool PERM = true, AFTER_DRAIN = false, MIDK = true; static constexpr int MID0 = 8, MID1 = 12;
    const bf16_t* G; int ldg; bf16_t* O; int ldc;
    __device__ __forceinline__ void mid(f32x4 (&acc)[2][2][4][2], const Unit& u, int t, int wr, int wc, int fr, int fq) const {
        int row0 = u.pm * BM + wr * 64 + fr, col0 = u.pn * BM + wc * 32 + 8 * fq;
        asm volatile("" : "+v"(row0), "+v"(col0));
        const bf16_t* gp = G + (t == MID0 ? 0 : 1024);
        u32x4 ld_[2][2][2], ln_[2][2][2];
#define BR_LOAD(bf, ai, mp) do { _Pragma("unroll") for (int mm = 0; mm < 2; ++mm) { const bf16_t* rp = gp + (size_t)(row0 + (ai) * HALF + (2 * (mp) + mm) * 16) * ldg + col0; \
            _Pragma("unroll") for (int bj = 0; bj < 2; ++bj) { ld_[bf][mm][bj] = *(const u32x4*)(rp + bj * HALF); ln_[bf][mm][bj] = *(const u32x4*)(rp + bj * HALF + 1024); } } } while (0)
#define BR_APPLY(bf, ai, mp) do { _Pragma("unroll") for (int mm = 0; mm < 2; ++mm) _Pragma("unroll") for (int bj = 0; bj < 2; ++bj) _Pragma("unroll") for (int q = 0; q < 4; ++q) { \
            const unsigned dw = ld_[bf][mm][bj][q], nw = ln_[bf][mm][bj][q];        \
            const f32x2 rd = {__builtin_amdgcn_rcpf(bfl(dw)), __builtin_amdgcn_rcpf(bfh(dw))}, nm = {bfl(nw), bfh(nw)}; const f32x2 ra = nm * rd; \
            acc[ai][bj][2 * (mp) + mm][q >> 1][2 * (q & 1)] *= ra.x; acc[ai][bj][2 * (mp) + mm][q >> 1][2 * (q & 1) + 1] *= ra.y; } } while (0)
        BR_LOAD(0, 0, 0); BR_LOAD(1, 0, 1); asm volatile("" ::: "memory");
        BR_APPLY(0, 0, 0); asm volatile("" ::: "memory"); BR_LOAD(0, 1, 0); asm volatile("" ::: "memory");
        BR_APPLY(1, 0, 1); asm volatile("" ::: "memory"); BR_LOAD(1, 1, 1); asm volatile("" ::: "memory");
        BR_APPLY(0, 1, 0); asm volatile("" ::: "memory"); BR_APPLY(1, 1, 1); asm volatile("" ::: "memory");
#undef BR_LOAD
#undef BR_APPLY
    }
    __device__ __forceinline__ void operator()(const f32x4 (&acc)[2][2][4][2], const Unit& u, int wr, int wc, int fr, int fq) const {
        const int row0 = u.pm * BM + wr * 64 + fr, col0 = u.pn * BM + wc * 32 + 8 * fq;
        u32x4 l2[2][2][2];
#define BR_LOAD(bf, ai, mp) do { _Pragma("unroll") for (int mm = 0; mm < 2; ++mm) _Pragma("unroll") for (int bj = 0; bj < 2; ++bj) \
            l2[bf][mm][bj] = *(const u32x4*)(G + 2048 + (size_t)(row0 + (ai) * HALF + (2 * (mp) + mm) * 16) * ldg + col0 + bj * HALF); } while (0)
#define BR_APPLY(bf, ai, mp) do { _Pragma("unroll") for (int mm = 0; mm < 2; ++mm) _Pragma("unroll") for (int bj = 0; bj < 2; ++bj) { u32x4 w; \
            _Pragma("unroll") for (int q = 0; q < 4; ++q) { const unsigned dw = l2[bf][mm][bj][q]; const f32x2 rd = {__builtin_amdgcn_rcpf(bfl(dw)), __builtin_amdgcn_rcpf(bfh(dw))}; \
                const f32x2 a2 = {acc[ai][bj][2 * (mp) + mm][q >> 1][2 * (q & 1)], acc[ai][bj][2 * (mp) + mm][q >> 1][2 * (q & 1) + 1]}; const f32x2 o = a2 * rd; w[q] = cvt_pk_bf16(o.x, o.y); } \
            *(u32x4*)(O + (size_t)(row0 + (ai) * HALF + (2 * (mp) + mm) * 16) * ldc + col0 + bj * HALF) = w; } } while (0)
        BR_LOAD(0, 0, 0); BR_LOAD(1, 0, 1); asm volatile("" ::: "memory");
        BR_APPLY(0, 0, 0); asm volatile("" ::: "memory"); BR_LOAD(0, 1, 0); asm volatile("" ::: "memory");
        BR_APPLY(1, 0, 1); asm volatile("" ::: "memory"); BR_LOAD(1, 1, 1); asm volatile("" ::: "memory");
        BR_APPLY(0, 1, 0); asm volatile("" ::: "memory"); BR_APPLY(1, 1, 1);
#undef BR_LOAD
#undef BR_APPLY
    }
};

}

constexpr int NWAVES = 8, NTHR = 512;
constexpr int BATCH = 4, SEQ = 4096, D = 1024, M = BATCH * SEQ, INC = 5632, FF = 3584, NE = 8, NHEAD = 8, HD = 64;
constexpr int C_Q = 0, C_K = 512, C_V = 1024, C_U = 1536, C_CH = 1792, C_CB = 2048, C_CC = 2304, C_G = 2560;
constexpr int MPAD = 2 * M + 2048;
constexpr int NCHUNK = M / 64;
constexpr float EPS = 1e-6f;
constexpr float SB_EXIT = -150.1f;

constexpr size_t MiB = 1u << 20;
constexpr size_t WS_CTL = 0, CTL_ZERO_BYTES = 65536;
constexpr int CW_BAR = 4096, CW_MOECNT = 8192;
constexpr size_t WS_TOPI = 1 * MiB, WS_TOPW = WS_TOPI + 256 * 1024, WS_SLOT = WS_TOPI + 512 * 1024;
constexpr size_t WS_TAB = 2 * MiB, TAB_STRIDE = 512 * 1024, TAB_ABAR = 0, TAB_BBAR = 64 * 1024, TAB_CMATB = 256 * 1024, TAB_BBF = 320 * 1024;
constexpr size_t WS_HB8 = 236 * MiB;
constexpr size_t WS_WING8 = 77 * MiB;
constexpr size_t WS_Y2 = 224 * MiB;
constexpr size_t WS_E = 4 * MiB, WS_SSP = 6 * MiB;
constexpr size_t WS_XNN = 8 * MiB;
constexpr size_t WS_WIN0 = 72 * MiB, WS_WCAT0 = 83 * MiB, WS_WOUT0 = 85 * MiB, WS_WGLU0 = 87 * MiB, WS_WGU0 = 88 * MiB, WS_WD0 = 102 * MiB;
constexpr size_t WS_WIN1 = 109 * MiB, WS_WCAT1 = 120 * MiB, WS_WOUT1 = 122 * MiB, WS_WGLU1 = 124 * MiB;
constexpr size_t WS_LSTRIDE = WS_WIN1 - WS_WIN0;
static_assert(WS_WCAT1 - WS_WCAT0 == WS_LSTRIDE && WS_WOUT1 - WS_WOUT0 == WS_LSTRIDE && WS_WGLU1 - WS_WGLU0 == WS_LSTRIDE, "layer stride");
constexpr size_t WS_YCAT0 = 125 * MiB, WS_MERGED0 = 157 * MiB, WS_XN = 252 * MiB, WS_BIG = 284 * MiB;
constexpr size_t WS_YCAT1 = 72 * MiB, WS_MERGED1 = 460 * MiB;
constexpr size_t WS_XS = 72 * MiB, WS_WMOE = 140 * MiB, WS_WD8 = 196 * MiB, WS_ACTM = 284 * MiB, WS_YS = 404 * MiB, WS_END = 492 * MiB;
constexpr float SC_XS = 4.f, SC_W = 64.f, SC_ACT = 8.f;
static_assert(WS_XS + (size_t)MPAD * D <= WS_WIN1 && WS_WMOE + (size_t)NE * 2 * FF * D <= WS_WD8 && WS_WD8 + (size_t)NE * FF * D <= 224 * MiB && WS_ACTM + (size_t)MPAD * FF <= WS_YS && WS_YS + (size_t)MPAD * D * 2 <= WS_END, "MoE map");
static_assert(WS_BIG + (size_t)M * INC * 2 <= WS_END && WS_XN + (size_t)M * D * 2 <= WS_BIG && WS_MERGED0 + (size_t)M * D * 2 <= WS_XN && WS_MERGED1 + (size_t)M * D * 2 <= WS_END && WS_YCAT1 + (size_t)M * D * 2 <= WS_WIN1, "mixer map");

constexpr int RING_BYTES = 131072, MISC_OFF = RING_BYTES, LDS_BYTES = 147456;

#define LAS __attribute__((address_space(3)))
#ifndef TP_A
#define TP_A -2
#define TP_B -2
#endif
#define TP_MUL 8
__device__ __forceinline__ void tp_stamp(LAS unsigned char* lds, int k) {
    if (TP_A == -2) return;
    if (threadIdx.x == 0 && blockIdx.x == 0) { if (k == TP_A) *(volatile LAS long long*)(lds + 140288) = wall_clock64(); if (k == TP_B) *(volatile LAS long long*)(lds + 140296) = wall_clock64(); }
}
typedef unsigned short bf16;
typedef unsigned v4u __attribute__((ext_vector_type(4)));
typedef unsigned v2u __attribute__((ext_vector_type(2)));
typedef float f32x4 __attribute__((ext_vector_type(4)));
typedef float f32x16 __attribute__((ext_vector_type(16)));
typedef float f32x2v __attribute__((ext_vector_type(2)));
typedef short bf16x8 __attribute__((ext_vector_type(8)));
#define RLX_AGENT __ATOMIC_RELAXED, __HIP_MEMORY_SCOPE_AGENT
#define LDS_WAIT() asm volatile("s_waitcnt lgkmcnt(0)" ::: "memory")
__device__ __forceinline__ float bfl(unsigned w) { return __uint_as_float(w << 16); }
__device__ __forceinline__ float bfh(unsigned w) { return __uint_as_float(w & 0xffff0000u); }
__device__ __forceinline__ float bf2f(bf16 x) { return __uint_as_float(((unsigned)x) << 16); }
typedef float f32x2c __attribute__((ext_vector_type(2))); typedef __bf16 bf16x2c __attribute__((ext_vector_type(2)));
__device__ __forceinline__ unsigned pk2(float lo, float hi) { const f32x2c v = {lo, hi}; return __builtin_bit_cast(unsigned, __builtin_convertvector(v, bf16x2c)); }
__device__ __forceinline__ unsigned f2bf(float f) { return pk2(f, f) & 0xffffu; }
__device__ __forceinline__ float wave_sum(float v) {
#pragma unroll
    for (int o = 1; o < 64; o <<= 1) v += __shfl_xor(v, o);
    return v;
}

#define XB_TMO      128
#define XB_XCNT(j)  (256  + 64 * (j))
#define XB_XSUB(j)  (1280 + 64 * (j))
#define XB_XGEN(j)  (2304 + 64 * (j))
#define XB_TOP      3328
#define XB_TOPGEN   3392
#define XCD_BAR_WORDS 3456
#define XB_SPIN_CAP (1u << 18)
__device__ __forceinline__ unsigned xb_ld(unsigned* p)              { return __hip_atomic_load(p, __ATOMIC_RELAXED, __HIP_MEMORY_SCOPE_AGENT); }
__device__ __forceinline__ unsigned xb_add(unsigned* p, unsigned v) { return __hip_atomic_fetch_add(p, v, __ATOMIC_RELAXED, __HIP_MEMORY_SCOPE_AGENT); }
__device__ __forceinline__ unsigned xb_xcc_id() { return (unsigned)__builtin_amdgcn_s_getreg((3 << 11) | 20) & 0xFu; }
#define XB_SPIN(cond, bar) do { unsigned _sp = 0; while (cond) { __builtin_amdgcn_s_sleep(1); \
    if ((++_sp & 255u) == 0u) { if (xb_ld(&(bar)[XB_TMO])) break; if (_sp > XB_SPIN_CAP) { atomicAdd(&(bar)[XB_TMO], 1u); break; } } } } while (0)
struct XcdBarrier { unsigned* bar; unsigned x; volatile LAS unsigned* st; };
__device__ __forceinline__ XcdBarrier xcd_barrier_post(unsigned* bar, volatile LAS unsigned* st) {
    XcdBarrier b; b.bar = bar; b.x = xb_xcc_id(); b.st = st;
    if (threadIdx.x == 0) (void)xb_add(&bar[XB_XCNT(b.x)], 1u);
    return b;
}
__device__ __forceinline__ void xcd_barrier_complete(unsigned* bar, unsigned x, unsigned& nloc, unsigned& nx) {
    const unsigned G = gridDim.x * gridDim.y * gridDim.z;
    unsigned sum, cnt, mine, sp = 0u;
    for (;;) {
        sum = 0u; cnt = 0u; mine = 0u;
#pragma unroll
        for (unsigned j = 0; j < 16; ++j) { const unsigned c = xb_ld(&bar[XB_XCNT(j)]); sum += c; cnt += (c > 0u) ? 1u : 0u; mine = (j == x) ? c : mine; }
        if (sum == G) break;
        __builtin_amdgcn_s_sleep(1);
        if ((++sp & 255u) == 0u) { if (xb_ld(&bar[XB_TMO])) break; if (sp > XB_SPIN_CAP) { atomicAdd(&bar[XB_TMO], 1u); break; } }
    }
    nloc = mine > 0u ? mine : 1u; nx = cnt > 0u ? cnt : 1u;
}
__device__ __forceinline__ void xcd_barrier(const XcdBarrier& b) {
    asm volatile("s_waitcnt vmcnt(0)" ::: "memory");
    __syncthreads();
    if (threadIdx.x == 0) {
        unsigned* bar = b.bar;
        __builtin_amdgcn_s_waitcnt(0);
        unsigned nloc = b.st[0], nx = b.st[1];
        if (nloc == 0u) { xcd_barrier_complete(bar, b.x, nloc, nx); b.st[0] = nloc; b.st[1] = nx; }
        const unsigned old = xb_add(&bar[XB_XSUB(b.x)], 1u);
        const unsigned gen = old / nloc;
        if (old + 1u == (gen + 1u) * nloc) {
            __builtin_amdgcn_fence(__ATOMIC_RELEASE, "agent");
            asm volatile("s_waitcnt vmcnt(0)" ::: "memory");
            const unsigned og = xb_add(&bar[XB_TOP], 1u);
            const unsigned tg = og / nx;
            if (og + 1u == (tg + 1u) * nx) xb_add(&bar[XB_TOPGEN], 1u);
            else XB_SPIN(xb_ld(&bar[XB_TOPGEN]) == tg, bar);
            __builtin_amdgcn_fence(__ATOMIC_ACQUIRE, "agent");
            xb_add(&bar[XB_XGEN(b.x)], 1u);
            asm volatile("s_waitcnt vmcnt(0)" ::: "memory");
        } else {
            XB_SPIN(xb_ld(&bar[XB_XGEN(b.x)]) == gen, bar);
            __builtin_amdgcn_fence(__ATOMIC_ACQUIRE, "agent");
            asm volatile("s_waitcnt vmcnt(0)" ::: "memory");
        }
    }
    __syncthreads();
}

struct Args { const float* in[26]; float* out; unsigned char* ws; int ph_lo, ph_hi; };
enum InIdx { I_X = 0, I_NORM_MIX, I_W_IN, I_LAM_RE, I_LAM_IM, I_LOG_DT, I_B_RE, I_B_IM, I_C_RE, I_C_IM, I_SSM_D, I_W_GLU, I_CONV_W, I_W_BR_A, I_W_BR_B, I_W_BR_C, I_W_OUT,
             I_NORM_FFN, I_DW_GATE, I_DW_UP, I_DW_DOWN, I_ROUTER, I_MW_GATE, I_MW_UP, I_MW_DOWN, I_FINAL_NORM };
struct Frame {
    LAS unsigned char* lds;
    unsigned* ctl;
    unsigned char* ws;
    const float* const* in;
    float* out;
    int tid, lane, wave, vcu, G;
    size_t ycat_off;
};

struct CvtJob { const float* src; bf16* dst; int K, N, ld, koff, mode; const float* gain; int fp8; int src_ld, c0; };
__device__ __forceinline__ CvtJob get_job(const Frame& F, int j) {
    CvtJob J; J.koff = 0; J.mode = 0; J.gain = nullptr; J.fp8 = 0; J.src_ld = 0; J.c0 = 0;
    if (j >= 39) { const int l = j - 39;
        J.src = F.in[I_W_IN] + (size_t)l * D * INC; J.K = D; J.N = INC - C_G; J.src_ld = INC; J.c0 = C_G; J.dst = (bf16*)(F.ws + WS_WING8 + (size_t)l * WS_LSTRIDE); J.ld = D; J.gain = F.in[I_NORM_MIX] + l * D; J.fp8 = 1; return J; }
    if (j < 12) { const int l = j / 6, r = j % 6; unsigned char* wl = F.ws + (size_t)l * WS_LSTRIDE;
        if (r == 0)      { J.src = F.in[I_W_IN] + (size_t)l * D * INC;   J.K = D;   J.N = C_G; J.src_ld = INC; J.dst = (bf16*)(wl + WS_WIN0);  J.ld = D; J.gain = F.in[I_NORM_MIX] + l * D; }
        else if (r == 1) { J.src = F.in[I_W_BR_A] + (size_t)l * 512 * D; J.K = 512; J.N = D;   J.dst = (bf16*)(wl + WS_WCAT0); J.ld = D; }
        else if (r == 2) { J.src = F.in[I_W_BR_B] + (size_t)l * 256 * D; J.K = 256; J.N = D;   J.dst = (bf16*)(wl + WS_WCAT0); J.ld = D; J.koff = 512; }
        else if (r == 3) { J.src = F.in[I_W_BR_C] + (size_t)l * 256 * D; J.K = 256; J.N = D;   J.dst = (bf16*)(wl + WS_WCAT0); J.ld = D; J.koff = 768; }
        else if (r == 4) { J.src = F.in[I_W_OUT] + (size_t)l * D * D;    J.K = D;   J.N = D;   J.dst = (bf16*)(wl + WS_WOUT0); J.ld = D; }
        else             { J.src = F.in[I_W_GLU] + (size_t)l * 256 * 256; J.K = 256; J.N = 256; J.dst = (bf16*)(wl + WS_WGLU0); J.ld = 256; }
    } else if (j == 12) { J.src = F.in[I_DW_GATE]; J.K = D; J.N = FF; J.dst = (bf16*)(F.ws + WS_WGU0); J.ld = D; J.mode = 1; J.gain = F.in[I_NORM_FFN]; }
    else if (j == 13)   { J.src = F.in[I_DW_UP];   J.K = D; J.N = FF; J.dst = (bf16*)(F.ws + WS_WGU0); J.ld = D; J.mode = 2; J.gain = F.in[I_NORM_FFN]; }
    else if (j == 14)   { J.src = F.in[I_DW_DOWN]; J.K = FF; J.N = D; J.dst = (bf16*)(F.ws + WS_WD0);  J.ld = FF; J.fp8 = 1; }
    else if (j < 31)    { const int e = (j - 15) >> 1, up = (j - 15) & 1; const float* sg = F.in[I_MW_GATE]; const float* su = F.in[I_MW_UP]; J.src = (up ? su : sg) + (size_t)e * D * FF; J.K = D; J.N = FF;
                          J.dst = (bf16*)(F.ws + WS_WMOE + (size_t)e * 2 * FF * D); J.ld = D; J.mode = 1 + up; J.fp8 = 1; }
    else                { const int e = j - 31; J.src = F.in[I_MW_DOWN] + (size_t)e * FF * D; J.K = FF; J.N = D; J.dst = (bf16*)(F.ws + WS_WD8 + (size_t)e * D * FF); J.ld = FF; J.fp8 = 1; }
    if (!J.src_ld) J.src_ld = J.N;
    return J;
}
__device__ __forceinline__ void cvt_load(const CvtJob& J, int item, int lane, f32x4 (&ld)[16]) {
    const int nblk = J.N / 64, kb = item / nblk, nb = item % nblk;
    const float* p = J.src + (size_t)(64 * kb + (lane >> 4)) * J.src_ld + J.c0 + 64 * nb + (lane & 15) * 4;
#pragma unroll
    for (int i = 0; i < 16; ++i) ld[i] = *(const f32x4*)(p + (size_t)(4 * i) * J.src_ld);
}
__device__ __forceinline__ void cvt_to_lds(const CvtJob& J, int item, int lane, f32x4 (&ld)[16], LAS float* scr) {
    const int nblk = J.N / 64, kb = item / nblk, k0 = 64 * kb;
    if (J.gain) {
#pragma unroll
        for (int i = 0; i < 16; ++i) ld[i] = ld[i] * J.gain[k0 + (lane >> 4) + 4 * i]; }
#pragma unroll
    for (int i = 0; i < 16; ++i) { const int k = (lane >> 4) + 4 * i; *(LAS f32x4*)(scr + k * 64 + 4 * ((lane & 15) ^ (((k >> 3) ^ k) & 7))) = ld[i]; }
    LDS_WAIT(); asm volatile("" ::: "memory");
}
__device__ __forceinline__ void cvt_store(const CvtJob& J, int item, int lane, const LAS float* scr) {
    const int nblk = J.N / 64, kb = item / nblk, nb = item % nblk, k0 = 64 * kb, n0 = 64 * nb;
    const int drow0 = (J.mode == 0) ? n0 : ((n0 >> 7) * 256 + (n0 & 127) + (J.mode == 2 ? 128 : 0));
    const int c = lane & 7;
#pragma unroll
    for (int j = 0; j < 8; ++j) { const int n = (lane >> 3) + 8 * j; float v[8];
#pragma unroll
        for (int q = 0; q < 8; ++q) v[q] = scr[(8 * c + q) * 64 + 4 * ((n >> 2) ^ ((c ^ q) & 7)) + (n & 3)];
        if (J.fp8) { v2u o8; o8.x = pg8::pk4_fp8(v[0] * SC_W, v[1] * SC_W, v[2] * SC_W, v[3] * SC_W); o8.y = pg8::pk4_fp8(v[4] * SC_W, v[5] * SC_W, v[6] * SC_W, v[7] * SC_W);
            *(v2u*)((unsigned char*)J.dst + (size_t)(drow0 + n) * J.ld + J.koff + k0 + 8 * c) = o8; }
        else { v4u o; o.x = pk2(v[0], v[1]); o.y = pk2(v[2], v[3]); o.z = pk2(v[4], v[5]); o.w = pk2(v[6], v[7]);
            *(v4u*)(J.dst + (size_t)(drow0 + n) * J.ld + J.koff + k0 + 8 * c) = o; } }
    LDS_WAIT(); asm volatile("" ::: "memory");
}
struct CvtCursor { int j, base, n; CvtJob J; };
__device__ __forceinline__ bool cvt_advance(const Frame& F, CvtCursor& C, int jb, int jc, int jd, int flat, int& item) {
    while (flat - C.base >= C.n) { C.base += C.n; ++C.j; if (C.j == jb) C.j = jc; if (C.j >= jd) { C.n = 0x3fffffff; return false; } C.J = get_job(F, C.j); C.n = (C.J.K / 64) * (C.J.N / 64); }
    item = flat - C.base; return true;
}
__device__ __forceinline__ void convert_jobs(const Frame& F, int ja, int jb, int jc, int jd, int widx, int nw) {
    if (widx < 0) return;
    LAS float* scr = (LAS float*)(F.lds + F.wave * 16384);
    CvtCursor C; C.j = (ja < jb) ? ja : jc; if (C.j >= jd) return; C.base = 0; C.J = get_job(F, C.j); C.n = (C.J.K / 64) * (C.J.N / 64);
    int flat = widx, itc = 0; bool ok = cvt_advance(F, C, jb, jc, jd, flat, itc);
    CvtJob Jc = C.J; f32x4 ld[16];
    if (ok) cvt_load(Jc, itc, F.lane, ld);
    while (ok) {
        cvt_to_lds(Jc, itc, F.lane, ld, scr);
        flat += nw; int itn = 0; const bool okn = cvt_advance(F, C, jb, jc, jd, flat, itn); const CvtJob Jn = C.J;
        if (okn) cvt_load(Jn, itn, F.lane, ld);
        asm volatile("" ::: "memory");
        cvt_store(Jc, itc, F.lane, scr);
        Jc = Jn; itc = itn; ok = okn;
    }
}
__device__ __forceinline__ void convert_jobs(const Frame& F, int jlo, int jhi, int widx, int nw) { convert_jobs(F, jlo, jhi, jhi, jhi, widx, nw); }

__device__ __forceinline__ void ssm_tables(const Frame& F) {
    const int gt = blockIdx.x * NTHR + F.tid, NT = F.G * NTHR;
    for (int i = gt; i < 2 * 16 * 64; i += NT) {
        const int l = i >> 10, g = (i >> 6) & 15, p = i & 63;
        unsigned char* tab = F.ws + WS_TAB + (size_t)l * TAB_STRIDE;
        const float lr = fminf(F.in[I_LAM_RE][i], -1e-4f), li = F.in[I_LAM_IM][i], dt = expf(F.in[I_LOG_DT][l * 16 + g]);
        const float mag = expf(lr * dt), ar = mag * cosf(li * dt), ai = mag * sinf(li * dt);
        const float den = lr * lr + li * li, nr = ar - 1.0f, ni = ai;
        const float fr = (nr * lr + ni * li) / den, fi = (ni * lr - nr * li) / den;
        const double ang = (double)li * (double)dt * 64.0; const double rev = ang * 0.15915494309189535; const float rf = (float)((rev - rint(rev)) * 6.283185307179586);
        const float magT = expf(64.0f * lr * dt);
        ((f32x4*)(tab + TAB_ABAR))[g * 64 + p] = (f32x4){ar, ai, magT * cosf(rf), magT * sinf(rf)};
        float* bb = (float*)(tab + TAB_BBAR) + (size_t)(g * 64 + p) * 32;
        const float* bre = F.in[I_B_RE] + (size_t)i * 16; const float* bim = F.in[I_B_IM] + (size_t)i * 16;
#pragma unroll
        for (int h = 0; h < 16; ++h) { const float br = bre[h], bi = bim[h]; bb[2 * h] = fr * br - fi * bi; bb[2 * h + 1] = fr * bi + fi * br; }
    }
    for (int i = gt; i < 2 * 16 * 8 * 64; i += NT) {
        const int l = i >> 13, g = (i >> 9) & 15, cbk = (i >> 6) & 7, ln = i & 63;
        const int c = cbk * 16 + (ln & 15), p = c >> 1, ri = c & 1, kh = ln >> 4;
        unsigned w[4] = {0u, 0u, 0u, 0u};
        if (kh < 2) {
            const int idx = (l * 16 + g) * 64 + p;
            const float lr = fminf(F.in[I_LAM_RE][idx], -1e-4f), li = F.in[I_LAM_IM][idx], dt = expf(F.in[I_LOG_DT][l * 16 + g]);
            const float mag = expf(lr * dt), ar = mag * cosf(li * dt), ai = mag * sinf(li * dt);
            const float den = lr * lr + li * li, nr = ar - 1.0f, ni = ai;
            const float fr = (nr * lr + ni * li) / den, fi = (ni * lr - nr * li) / den;
            const float* bre = F.in[I_B_RE] + (size_t)idx * 16 + 8 * kh; const float* bim = F.in[I_B_IM] + (size_t)idx * 16 + 8 * kh;
            float v[8];
#pragma unroll
            for (int j = 0; j < 8; ++j) { const float br = bre[j], bi = bim[j]; v[j] = ri ? (fr * bi + fi * br) : (fr * br - fi * bi); }
            w[0] = pk2(v[0], v[1]); w[1] = pk2(v[2], v[3]); w[2] = pk2(v[4], v[5]); w[3] = pk2(v[6], v[7]);
        }
        ((v4u*)(F.ws + WS_TAB + (size_t)l * TAB_STRIDE + TAB_BBF))[i & 8191] = (v4u){w[0], w[1], w[2], w[3]};
    }
    for (int i = gt; i < 2 * 16 * 4 * 64; i += NT) {
        const int l = i >> 12, g = (i >> 8) & 15, ks = (i >> 6) & 3, ln = i & 63;
        const int hp = ln & 15;
        const float* cre = F.in[I_C_RE] + ((size_t)(l * 16 + g) * 16 + hp) * 64; const float* cim = F.in[I_C_IM] + ((size_t)(l * 16 + g) * 16 + hp) * 64;
        unsigned w[4];
#pragma unroll
        for (int jj = 0; jj < 4; ++jj) { const int k = ks * 32 + 8 * (ln >> 4) + 2 * jj, p = k >> 1; w[jj] = pk2(cre[p], -cim[p]); }
        ((v4u*)(F.ws + WS_TAB + (size_t)l * TAB_STRIDE + TAB_CMATB))[i & 4095] = (v4u){w[0], w[1], w[2], w[3]};
    }
}

template <bool ROUTER>
__device__ __forceinline__ void norm_rows(const Frame& F, const bf16* src, const float* gain, bf16* dst) {
    const int gw = F.vcu * NWAVES + F.wave, NGW = F.G * NWAVES;
    LAS float* wrt = (LAS float*)F.lds;
    if (ROUTER) {
        const float* wr = F.in[I_ROUTER];
        for (int i = F.tid; i < D * NE; i += NTHR) wrt[(i & 7) * D + (i >> 3)] = wr[i];
        __syncthreads();
    }
    f32x4 gv[4];
#pragma unroll
    for (int j = 0; j < 4; ++j) gv[j] = ((const f32x4*)gain)[F.lane + 64 * j];
    v2u nv[4];
    if (gw < M) {
#pragma unroll
        for (int j = 0; j < 4; ++j) nv[j] = ((const v2u*)(src + (size_t)gw * D) + F.lane)[64 * j]; }
    for (int m = gw; m < M; m += NGW) {
        f32x4 v[4]; float s = 0.f;
#pragma unroll
        for (int j = 0; j < 4; ++j) v[j] = (f32x4){bfl(nv[j].x), bfh(nv[j].x), bfl(nv[j].y), bfh(nv[j].y)};
        if (m + NGW < M) {
#pragma unroll
            for (int j = 0; j < 4; ++j) nv[j] = ((const v2u*)(src + (size_t)(m + NGW) * D) + F.lane)[64 * j]; }
#pragma unroll
        for (int j = 0; j < 4; ++j) s += (v[j].x * v[j].x + v[j].y * v[j].y) + (v[j].z * v[j].z + v[j].w * v[j].w);
        const float rstd = 1.0f / sqrtf(wave_sum(s) * (1.0f / D) + EPS);
        if (ROUTER) { unsigned* o4 = (unsigned*)((unsigned char*)dst + (size_t)m * D) + F.lane;
#pragma unroll
            for (int j = 0; j < 4; ++j) { v[j] = v[j] * rstd * gv[j]; o4[64 * j] = pg8::pk4_fp8(v[j].x * SC_XS, v[j].y * SC_XS, v[j].z * SC_XS, v[j].w * SC_XS); } }
        else { unsigned long long* o8 = (unsigned long long*)(dst + (size_t)m * D) + F.lane;
#pragma unroll
            for (int j = 0; j < 4; ++j) { v[j] = v[j] * rstd * gv[j]; o8[64 * j] = (unsigned long long)pk2(v[j].x, v[j].y) | ((unsigned long long)pk2(v[j].z, v[j].w) << 32); } }
        if (ROUTER) {
            float lg[8];
#pragma unroll
            for (int e = 0; e < 8; ++e) { float a = 0.f;
#pragma unroll
                for (int j = 0; j < 4; ++j) { const f32x4 w = *(const LAS f32x4*)(wrt + e * D + 4 * F.lane + 256 * j); a += (v[j].x * w.x + v[j].y * w.y) + (v[j].z * w.z + v[j].w * w.w); }
                lg[e] = wave_sum(a); }
            if (F.lane == 0) {
                int i1 = 0; float v1 = lg[0];
#pragma unroll
                for (int e = 1; e < 8; ++e) if (lg[e] > v1) { v1 = lg[e]; i1 = e; }
                int i2 = -1; float v2 = -INFINITY;
#pragma unroll
                for (int e = 0; e < 8; ++e) if (e != i1 && lg[e] > v2) { v2 = lg[e]; i2 = e; }
                const float e2 = expf(v2 - v1), w1 = 1.0f / (1.0f + e2);
                ((int2*)(F.ws + WS_TOPI))[m] = make_int2(i1, i2);
                ((float2*)(F.ws + WS_TOPW))[m] = make_float2(w1, e2 * w1);
            }
        }
    }
}

__device__ __forceinline__ void cast_rows(const Frame& F, const float* src, bf16* dst) {
    const int gw = F.vcu * NWAVES + F.wave, NGW = F.G * NWAVES;
    float* ssp = (float*)(F.ws + WS_SSP);
    f32x4 nv[4];
    if (gw < M) {
#pragma unroll
        for (int j = 0; j < 4; ++j) nv[j] = ((const f32x4*)(src + (size_t)gw * D) + F.lane)[64 * j]; }
    for (int m = gw; m < M; m += NGW) {
        f32x4 v[4]; float s = 0.f;
#pragma unroll
        for (int j = 0; j < 4; ++j) v[j] = nv[j];
        if (m + NGW < M) {
#pragma unroll
            for (int j = 0; j < 4; ++j) nv[j] = ((const f32x4*)(src + (size_t)(m + NGW) * D) + F.lane)[64 * j]; }
#pragma unroll
        for (int j = 0; j < 4; ++j) s += (v[j].x * v[j].x + v[j].y * v[j].y) + (v[j].z * v[j].z + v[j].w * v[j].w);
        s = wave_sum(s);
        unsigned long long* o8 = (unsigned long long*)(dst + (size_t)m * D) + F.lane;
#pragma unroll
        for (int j = 0; j < 4; ++j) o8[64 * j] = (unsigned long long)pk2(v[j].x, v[j].y) | ((unsigned long long)pk2(v[j].z, v[j].w) << 32);
        unsigned* o4 = (unsigned*)(F.ws + WS_HB8 + (size_t)m * D) + F.lane;
#pragma unroll
        for (int j = 0; j < 4; ++j) o4[64 * j] = pg8::pk4_fp8(v[j].x * SC_XS, v[j].y * SC_XS, v[j].z * SC_XS, v[j].w * SC_XS);
        if (F.lane < 16) ssp[(size_t)m * 16 + F.lane] = (F.lane == 0) ? s : 0.f;
    }
}
__device__ __forceinline__ void cfma(float& sr, float& si, float ar, float ai, float br, float bi) {
    float t1, t2, nr, ni; const float nai = -ai;
    asm volatile("v_fma_f32 %0, %1, %2, %3" : "=v"(t1) : "v"(ar), "v"(sr), "v"(br));
    asm volatile("v_fma_f32 %0, %1, %2, %3" : "=v"(nr) : "v"(nai), "v"(si), "v"(t1));
    asm volatile("v_fma_f32 %0, %1, %2, %3" : "=v"(t2) : "v"(ar), "v"(si), "v"(bi));
    asm volatile("v_fma_f32 %0, %1, %2, %3" : "=v"(ni) : "v"(ai), "v"(sr), "v"(t2));
    sr = nr; si = ni;
}
constexpr int BUP = 132;
__device__ __forceinline__ bf16x8 ssm_u_frag(const bf16* proj, int tokb, int g, int lane) {
    bf16x8 a = {0, 0, 0, 0, 0, 0, 0, 0};
    if ((lane >> 4) < 2) a = *(const bf16x8*)(proj + (size_t)(tokb + (lane & 15)) * INC + C_U + g * 16 + 8 * (lane >> 4));
    return a;
}
__device__ __forceinline__ void ssm_bu_block(LAS float* bu, const bf16x8 (&bbf)[8], bf16x8 a, int lane) {
    const int kh = lane >> 4;
#pragma unroll
    for (int cb = 0; cb < 8; ++cb) {
        const pg8::f32x4 d = __builtin_amdgcn_mfma_f32_16x16x32_bf16(a, bbf[cb], (pg8::f32x4){0.f, 0.f, 0.f, 0.f}, 0, 0, 0);
#pragma unroll
        for (int r = 0; r < 4; ++r) bu[(4 * kh + r) * BUP + cb * 16 + (lane & 15)] = d[r];
    }
    LDS_WAIT(); asm volatile("" ::: "memory");
}
#define SSM_STEP(tt_) do { const f32x2v b_ = *(const LAS f32x2v*)(bu + (tt_) * BUP + 2 * p); \
    cfma(sr, si, ab.x, ab.y, b_.x, b_.y); } while (0)

__device__ __forceinline__ void ssm_pass1_unit(const Frame& F, int l, int unit) {
    const bf16* proj = (const bf16*)(F.ws + WS_BIG);
    const unsigned char* tab = F.ws + WS_TAB + (size_t)l * TAB_STRIDE;
    LAS float* bu = (LAS float*)(F.lds + F.wave * (16 * BUP * 4));
    const int p = F.lane, tok0 = unit * 64;
    for (int gi = 0; gi < 2; ++gi) {
        const int g = F.wave * 2 + gi;
        bf16x8 bbf[8];
#pragma unroll
        for (int cb = 0; cb < 8; ++cb) bbf[cb] = ((const bf16x8*)(tab + TAB_BBF))[(g * 8 + cb) * 64 + F.lane];
        const f32x4 ab = ((const f32x4*)(tab + TAB_ABAR))[g * 64 + p];
        bf16x8 af[4];
#pragma unroll
        for (int tb = 0; tb < 4; ++tb) af[tb] = ssm_u_frag(proj, tok0 + tb * 16, g, F.lane);
        float sr = 0.f, si = 0.f;
#pragma unroll
        for (int tb = 0; tb < 4; ++tb) {
            ssm_bu_block(bu, bbf, af[tb], F.lane);
#pragma unroll
            for (int tt = 0; tt < 16; ++tt) SSM_STEP(tt);
        }
        ((float2*)(F.ws + WS_E))[((size_t)unit * 16 + g) * 64 + p] = make_float2(sr, si);
        LDS_WAIT(); asm volatile("" ::: "memory");
    }
}
__device__ __forceinline__ void conv_unit(const Frame& F, int l, int unit) {
    const bf16* proj = (const bf16*)(F.ws + WS_BIG); bf16* ycat = (bf16*)(F.ws + F.ycat_off);
    const float* cw = F.in[I_CONV_W] + (size_t)l * 3 * 256;
    for (int it = F.tid; it < 64 * 32; it += NTHR) {
        const int tt = it >> 5, cg = (it & 31) * 8, tok = unit * 64 + tt, tl = tok & (SEQ - 1);
        const bf16* row = proj + (size_t)tok * INC;
        float u[3][8];
        v4u hv[3], cv[3];
#pragma unroll
        for (int d = 0; d < 3; ++d) { const size_t back = (tl >= d) ? (size_t)d * INC : 0; hv[d] = *(const v4u*)(row - back + C_CH + cg); cv[d] = *(const v4u*)(row - back + C_CC + cg); }
#pragma unroll
        for (int d = 0; d < 3; ++d) {
            const float keep = (tl >= d) ? 1.f : 0.f;
            const unsigned hw[4] = {hv[d].x, hv[d].y, hv[d].z, hv[d].w}, cww[4] = {cv[d].x, cv[d].y, cv[d].z, cv[d].w};
#pragma unroll
            for (int q = 0; q < 4; ++q) { u[d][2 * q] = keep * (bfl(hw[q]) * bfl(cww[q])); u[d][2 * q + 1] = keep * (bfh(hw[q]) * bfh(cww[q])); }
        }
        const v4u bv = *(const v4u*)(row + C_CB + cg); const unsigned bw[4] = {bv.x, bv.y, bv.z, bv.w};
        float o[8];
#pragma unroll
        for (int q = 0; q < 8; ++q) { const float y = cw[cg + q] * u[2][q] + cw[256 + cg + q] * u[1][q] + cw[512 + cg + q] * u[0][q]; const float bg = (q & 1) ? bfh(bw[q >> 1]) : bfl(bw[q >> 1]); o[q] = bg * y; }
        *(v4u*)(ycat + (size_t)tok * D + 768 + cg) = (v4u){pk2(o[0], o[1]), pk2(o[2], o[3]), pk2(o[4], o[5]), pk2(o[6], o[7])};
    }
}
__device__ __forceinline__ int crow(int r, int hi) { return (r & 3) + 8 * (r >> 2) + 4 * hi; }
constexpr int VPITCH = 144;
typedef short v4i16_t __attribute__((ext_vector_type(4)));
__device__ __forceinline__ bf16x8 pack8(float a, float b, float c, float d, float e, float f, float g, float h) {
    v4u w = {pk2(a, b), pk2(c, d), pk2(e, f), pk2(g, h)}; return __builtin_bit_cast(bf16x8, w); }
__device__ __forceinline__ void attn_unit(const Frame& F, int uidx, LAS unsigned char* vl) {
    const int lane = F.lane, r32 = lane & 31, hh = lane >> 5;
    const int bh = uidx >> 7, qb = uidx & 127, b = bh >> 3, h = bh & 7, t0 = qb * 32, tq = t0 + r32;
    const bf16* P = (const bf16*)(F.ws + WS_BIG) + (size_t)b * SEQ * INC;
    bf16* ycat = (bf16*)(F.ws + F.ycat_off);
    bf16x8 qf[4];
#pragma unroll
    for (int ks = 0; ks < 4; ++ks) qf[ks] = *(const bf16x8*)(P + (size_t)tq * INC + C_Q + h * 64 + 16 * ks + 8 * hh);
    f32x16 o0 = {}, o1 = {};
    float carry = 0.f;
    const int trb = ((lane & 15) >> 2) * VPITCH + (16 * ((lane >> 4) & 1) + 4 * (lane & 3)) * 2 + 4 * hh * VPITCH;
    bf16x8 kf0[4], kf1[4];
    v4u vv[8];
    const unsigned vlo = (unsigned)(((lane >> 3) * INC + (lane & 7) * 8) * 2), klo = (unsigned)((r32 * INC + 8 * hh) * 2);
    const char* Pv = (const char*)(P + C_V + h * 64); const char* Pk = (const char*)(P + C_K + h * 64);
#define AT_LOADV(KSB) do { const char* vb_ = Pv + (size_t)(KSB) * (INC * 2); _Pragma("unroll") for (int i = 0; i < 8; ++i) vv[i] = *(const v4u*)(vb_ + (size_t)(8 * i) * (INC * 2) + vlo); } while (0)
#define AT_LOADK(KSB) do { const char* kb_ = Pk + (size_t)(KSB) * (INC * 2); \
            _Pragma("unroll") for (int ks = 0; ks < 4; ++ks) { kf0[ks] = *(const bf16x8*)(kb_ + klo + 32 * ks); kf1[ks] = *(const bf16x8*)(kb_ + (size_t)32 * (INC * 2) + klo + 32 * ks); } } while (0)
    { const int kb0 = t0 - 32 < 0 ? 0 : t0 - 32; AT_LOADV(kb0); AT_LOADK(kb0); }
    for (int kend = t0 + 32; kend > 0; kend -= 64) {
        const int ks0 = kend - 64;
        asm volatile("" : "+v"(vv[0]), "+v"(vv[1]), "+v"(vv[2]), "+v"(vv[3]), "+v"(vv[4]), "+v"(vv[5]), "+v"(vv[6]), "+v"(vv[7]));
#pragma unroll
        for (int i = 0; i < 8; ++i) { const int row = (lane >> 3) + 8 * i; *(LAS v4u*)(vl + row * VPITCH + (lane & 7) * 16) = vv[i]; }
        const int ksb = ks0 < 0 ? 0 : ks0, ksn = ks0 - 64 < 0 ? 0 : ks0 - 64;
        AT_LOADV(ksn); asm volatile("" ::: "memory");
        f32x16 s0 = {}, s1 = {};
#pragma unroll
        for (int ks = 0; ks < 4; ++ks) { s0 = __builtin_amdgcn_mfma_f32_32x32x16_bf16(kf0[ks], qf[ks], s0, 0, 0, 0); s1 = __builtin_amdgcn_mfma_f32_32x32x16_bf16(kf1[ks], qf[ks], s1, 0, 0, 0); }
        asm volatile("" : "+v"(s0), "+v"(s1));
        AT_LOADK(ksn); asm volatile("" ::: "memory");
        f32x16 c0, c1; float tot = 0.f; const int kmax = kend < tq ? kend : tq;
#define SP_ELEM(S, C, I, KEY, MASKED) do { const float z2 = 0.18033688011112042f * S[I]; const float sp = fmaxf(z2, 0.f) + __builtin_amdgcn_logf(1.f + __builtin_amdgcn_exp2f(-fabsf(z2))); \
            if (MASKED) { const bool valid = (KEY) < kmax; C[I] = valid ? (z2 - sp) + carry : -INFINITY; S[I] = valid ? -sp : 0.f; } else { C[I] = (z2 - sp) + carry; S[I] = -sp; } tot += S[I]; } while (0)
        if (ks0 >= 0 && kend <= t0) {
#pragma unroll
            for (int i = 0; i < 16; ++i) SP_ELEM(s1, c1, i, 0, false);
            tot += __shfl_xor(tot, 32); carry += tot; tot = 0.f;
#pragma unroll
            for (int i = 0; i < 16; ++i) SP_ELEM(s0, c0, i, 0, false);
        } else {
#pragma unroll
            for (int i = 0; i < 16; ++i) { const int key1 = ksb + 32 + crow(i, hh); SP_ELEM(s1, c1, i, key1, true); }
            tot += __shfl_xor(tot, 32); carry += tot; tot = 0.f;
#pragma unroll
            for (int i = 0; i < 16; ++i) { const int key0 = ksb + crow(i, hh); SP_ELEM(s0, c0, i, key0, true); }
        }
#undef SP_ELEM
        tot += __shfl_xor(tot, 32); carry += tot;
        {
#define HIW(S, q8) ((v4u){pk2(S[(q8)], S[(q8) + 1]), pk2(S[(q8) + 2], S[(q8) + 3]), pk2(S[(q8) + 4], S[(q8) + 5]), pk2(S[(q8) + 6], S[(q8) + 7])})
#define LOW(S, q8, H) ((v4u){pk2(S[(q8)] - bfl((H).x), S[(q8) + 1] - bfh((H).x)), pk2(S[(q8) + 2] - bfl((H).y), S[(q8) + 3] - bfh((H).y)), pk2(S[(q8) + 4] - bfl((H).z), S[(q8) + 5] - bfh((H).z)), pk2(S[(q8) + 6] - bfl((H).w), S[(q8) + 7] - bfh((H).w))})
#define CUM6(X00, X01, X10, X11) do { c0 = __builtin_amdgcn_mfma_f32_32x32x16_bf16(T0, X00, c0, 0, 0, 0); c0 = __builtin_amdgcn_mfma_f32_32x32x16_bf16(T1, X01, c0, 0, 0, 0); \
            c1 = __builtin_amdgcn_mfma_f32_32x32x16_bf16(T0, X10, c1, 0, 0, 0); c1 = __builtin_amdgcn_mfma_f32_32x32x16_bf16(T1, X11, c1, 0, 0, 0); } while (0)
            bf16x8 T0, T1;
            { int lt = lane; asm volatile("" : "+v"(lt)); const int rt = lt & 31, ht = lt >> 5;
#pragma unroll
              for (int j = 0; j < 8; ++j) { const int ko = 8 * (j >> 2) + 4 * ht + (j & 3); T0[j] = (ko > rt) ? (short)0x3F80 : (short)0; T1[j] = (16 + ko > rt) ? (short)0x3F80 : (short)0; } }
            const v4u h00 = HIW(s0, 0), h01 = HIW(s0, 8), h10 = HIW(s1, 0), h11 = HIW(s1, 8);
            CUM6(__builtin_bit_cast(bf16x8, h00), __builtin_bit_cast(bf16x8, h01), __builtin_bit_cast(bf16x8, h10), __builtin_bit_cast(bf16x8, h11));
            const v4u l00 = LOW(s0, 0, h00), l01 = LOW(s0, 8, h01), l10 = LOW(s1, 0, h10), l11 = LOW(s1, 8, h11);
            CUM6(__builtin_bit_cast(bf16x8, l00), __builtin_bit_cast(bf16x8, l01), __builtin_bit_cast(bf16x8, l10), __builtin_bit_cast(bf16x8, l11));
#undef HIW
#undef LOW
#undef CUM6
        }
#pragma unroll
        for (int i = 0; i < 16; ++i) { c0[i] = __builtin_amdgcn_exp2f(c0[i]); c1[i] = __builtin_amdgcn_exp2f(c1[i]); }
#pragma unroll
        for (int kq = 0; kq < 4; ++kq) {
            const bf16x8 wa = (kq & 2) ? pack8(c1[8 * (kq & 1)], c1[8 * (kq & 1) + 1], c1[8 * (kq & 1) + 2], c1[8 * (kq & 1) + 3], c1[8 * (kq & 1) + 4], c1[8 * (kq & 1) + 5], c1[8 * (kq & 1) + 6], c1[8 * (kq & 1) + 7])
                                       : pack8(c0[8 * (kq & 1)], c0[8 * (kq & 1) + 1], c0[8 * (kq & 1) + 2], c0[8 * (kq & 1) + 3], c0[8 * (kq & 1) + 4], c0[8 * (kq & 1) + 5], c0[8 * (kq & 1) + 6], c0[8 * (kq & 1) + 7]);
#pragma unroll
            for (int db = 0; db < 2; ++db) {
                LAS unsigned char* vp = vl + trb + 16 * kq * VPITCH + 64 * db;
                const v4i16_t lo = __builtin_amdgcn_ds_read_tr16_b64_v4i16((LAS v4i16_t*)vp), hi = __builtin_amdgcn_ds_read_tr16_b64_v4i16((LAS v4i16_t*)(vp + 8 * VPITCH));
                const bf16x8 vf = {lo[0], lo[1], lo[2], lo[3], hi[0], hi[1], hi[2], hi[3]};
                if (db == 0) o0 = __builtin_amdgcn_mfma_f32_32x32x16_bf16(wa, vf, o0, 0, 0, 0); else o1 = __builtin_amdgcn_mfma_f32_32x32x16_bf16(wa, vf, o1, 0, 0, 0);
            }
        }
        if (__all(carry < SB_EXIT)) break;
    }
#undef AT_LOADV
#undef AT_LOADK
    int lz = lane; asm volatile("" : "+v"(lz));
    bf16* op = ycat + (size_t)(b * SEQ + t0 + 4 * (lz >> 5)) * D + h * 64 + (lz & 31);
#pragma unroll
    for (int i = 0; i < 16; ++i) { const int q = crow(i, 0); op[(size_t)q * D] = (bf16)f2bf(o0[i]); op[(size_t)q * D + 32] = (bf16)f2bf(o1[i]); }
    LDS_WAIT(); asm volatile("" ::: "memory");
}
__device__ __forceinline__ void mixer_b(const Frame& F, int l, int nrep_s, int nrep_a) {
    for (int rep = 0; rep < nrep_s; ++rep)
    for (int u = blockIdx.x; u < NCHUNK; u += F.G) { ssm_pass1_unit(F, l, u); conv_unit(F, l, u); }
    tp_stamp(F.lds, 200 + 10 * l);
    __syncthreads();
    LAS unsigned char* vl = F.lds + 32768 + F.wave * (64 * VPITCH);
    const int gw = blockIdx.x * NWAVES + F.wave, NGW = F.G * NWAVES;
    for (int rep = 0; rep < nrep_a; ++rep)
    for (int uidx = gw; uidx < BATCH * NHEAD * (SEQ / 32); uidx += NGW) attn_unit(F, uidx, vl);
    tp_stamp(F.lds, 201 + 10 * l);
}

__device__ __forceinline__ void ssm_pass2_unit(const Frame& F, int l, int unit) {
    const bf16* proj = (const bf16*)(F.ws + WS_BIG); bf16* ycat = (bf16*)(F.ws + F.ycat_off);
    const unsigned char* tab = F.ws + WS_TAB + (size_t)l * TAB_STRIDE;
    const float* dsk = F.in[I_SSM_D] + l * 256;
    const bf16* wglu = (const bf16*)(F.ws + WS_WGLU0 + (size_t)l * WS_LSTRIDE);
    LAS float* bu = (LAS float*)(F.lds + F.wave * (16 * BUP * 4));
    LAS unsigned char* sst = (LAS unsigned char*)bu;
    LAS unsigned char* yg = F.lds + 8 * (16 * BUP * 4);
    const int lane = F.lane, p = lane, tok0 = unit * 64, cfirst = unit & ~63;
    float s0r = 0.f, s0i = 0.f, s1r = 0.f, s1i = 0.f;
    { const f32x4 ab0 = ((const f32x4*)(tab + TAB_ABAR))[(F.wave * 2) * 64 + p], ab1 = ((const f32x4*)(tab + TAB_ABAR))[(F.wave * 2 + 1) * 64 + p];
      const float2* ep = (const float2*)(F.ws + WS_E) + (size_t)(F.wave * 2) * 64 + p;
      float2 e0[8], e1[8], f0[8], f1[8];
#define HORNER_LOAD(A0, A1, CC) do { _Pragma("unroll") for (int q = 0; q < 8; ++q) { const int ci = ((CC) + q < unit) ? (CC) + q : cfirst; A0[q] = ep[(size_t)ci * 1024]; A1[q] = ep[(size_t)ci * 1024 + 64]; } } while (0)
#define HORNER_APPLY(A0, A1, CC) do { _Pragma("unroll") for (int q = 0; q < 8; ++q) if ((CC) + q < unit) { cfma(s0r, s0i, ab0.z, ab0.w, A0[q].x, A0[q].y); cfma(s1r, s1i, ab1.z, ab1.w, A1[q].x, A1[q].y); } } while (0)
      if (cfirst < unit) HORNER_LOAD(e0, e1, cfirst);
      for (int cc = cfirst; cc < unit; cc += 16) {
          if (cc + 8 < unit) HORNER_LOAD(f0, f1, cc + 8);
          asm volatile("" ::: "memory");
          HORNER_APPLY(e0, e1, cc);
          if (cc + 16 < unit) HORNER_LOAD(e0, e1, cc + 16);
          asm volatile("" ::: "memory");
          if (cc + 8 < unit) HORNER_APPLY(f0, f1, cc + 8);
      }
#undef HORNER_LOAD
#undef HORNER_APPLY
    }
    for (int gi = 0; gi < 2; ++gi) {
        const int g = F.wave * 2 + gi;
        bf16x8 bbf[8];
#pragma unroll
        for (int cb = 0; cb < 8; ++cb) bbf[cb] = ((const bf16x8*)(tab + TAB_BBF))[(g * 8 + cb) * 64 + lane];
        const f32x4 ab = ((const f32x4*)(tab + TAB_ABAR))[g * 64 + p];
        bf16x8 cb4[4];
#pragma unroll
        for (int ks = 0; ks < 4; ++ks) cb4[ks] = ((const bf16x8*)(tab + TAB_CMATB))[(g * 4 + ks) * 64 + lane];
        bf16x8 af[4]; bf16 uvs[4][4];
#pragma unroll
        for (int tb = 0; tb < 4; ++tb) { af[tb] = ssm_u_frag(proj, tok0 + tb * 16, g, lane);
#pragma unroll
            for (int r = 0; r < 4; ++r) uvs[tb][r] = proj[(size_t)(tok0 + tb * 16 + 4 * (lane >> 4) + r) * INC + C_U + g * 16 + (lane & 15)]; }
        float sr = gi ? s1r : s0r, si = gi ? s1i : s0i;
        const float dk = dsk[g * 16 + (lane & 15)];
#pragma unroll
        for (int tb = 0; tb < 4; ++tb) {
            ssm_bu_block(bu, bbf, af[tb], lane);
#pragma unroll
            for (int tt = 0; tt < 16; ++tt) { SSM_STEP(tt); *(LAS unsigned*)(sst + tt * (BUP * 4) + p * 4) = pk2(sr, si); }
            pg8::f32x4 acc = {0.f, 0.f, 0.f, 0.f};
#pragma unroll
            for (int ks = 0; ks < 4; ++ks) { const bf16x8 a = *(const LAS bf16x8*)(sst + (lane & 15) * (BUP * 4) + (ks * 32 + 8 * (lane >> 4)) * 2); acc = __builtin_amdgcn_mfma_f32_16x16x32_bf16(a, cb4[ks], acc, 0, 0, 0); }
#pragma unroll
            for (int r = 0; r < 4; ++r) { const int t = tb * 16 + 4 * (lane >> 4) + r; const float y = acc[r] + dk * bf2f(uvs[tb][r]);
                const float gl = y * __builtin_amdgcn_rcpf(1.f + __builtin_amdgcn_exp2f(-2.3022081986f * (y + 0.044715f * y * y * y)));
                *(LAS bf16*)(yg + t * 528 + (g * 16 + (lane & 15)) * 2) = (bf16)f2bf(gl); }
        }
        LDS_WAIT(); asm volatile("" ::: "memory");
    }
    const int n0 = 32 * F.wave, r32 = lane & 31, hh = lane >> 5;
    bf16x8 wfr[16];
    { const bf16* wrow = wglu + (size_t)(n0 + r32) * 256 + 8 * hh;
#pragma unroll
      for (int ks = 0; ks < 16; ++ks) wfr[ks] = *(const bf16x8*)(wrow + 16 * ks); }
    __syncthreads();
    {
        f32x16 a0 = {}, a1 = {};
#pragma unroll
        for (int ks = 0; ks < 16; ++ks) {
            const bf16x8 bfr = wfr[ks];
            const bf16x8 x0 = *(const LAS bf16x8*)(yg + r32 * 528 + (16 * ks + 8 * hh) * 2), x1 = *(const LAS bf16x8*)(yg + (32 + r32) * 528 + (16 * ks + 8 * hh) * 2);
            a0 = __builtin_amdgcn_mfma_f32_32x32x16_bf16(x0, bfr, a0, 0, 0, 0); a1 = __builtin_amdgcn_mfma_f32_32x32x16_bf16(x1, bfr, a1, 0, 0, 0);
        }
#pragma unroll
        for (int r = 0; r < 16; ++r) { const int t = crow(r, hh);
            { const float yv = bf2f(*(const LAS bf16*)(yg + t * 528 + (n0 + r32) * 2)); ycat[(size_t)(tok0 + t) * D + 512 + n0 + r32] = (bf16)f2bf(yv * __builtin_amdgcn_rcpf(1.f + __builtin_amdgcn_exp2f(-1.4426950409f * a0[r]))); }
            { const float yv = bf2f(*(const LAS bf16*)(yg + (32 + t) * 528 + (n0 + r32) * 2)); ycat[(size_t)(tok0 + 32 + t) * D + 512 + n0 + r32] = (bf16)f2bf(yv * __builtin_amdgcn_rcpf(1.f + __builtin_amdgcn_exp2f(-1.4426950409f * a1[r]))); } }
    }
    __syncthreads();
}

__device__ __forceinline__ void moe_gather(const Frame& F) {
    LAS int* cnt = (LAS int*)F.lds;
    LAS int* tot = (LAS int*)(F.lds + 16384);
    LAS int* slot_l = (LAS int*)(F.lds + 16384 + 256);
    const int2* topi = (const int2*)(F.ws + WS_TOPI);
    const unsigned char* xn = F.ws + WS_XNN; unsigned char* xs = F.ws + WS_XS;
    {   int c0 = 0, c1 = 0, c2 = 0, c3 = 0, c4 = 0, c5 = 0, c6 = 0, c7 = 0;
        for (int k = 0; k < 32; ++k) { const int2 ti = topi[F.tid * 32 + k];
            c0 += (ti.x == 0) + (ti.y == 0); c1 += (ti.x == 1) + (ti.y == 1); c2 += (ti.x == 2) + (ti.y == 2); c3 += (ti.x == 3) + (ti.y == 3);
            c4 += (ti.x == 4) + (ti.y == 4); c5 += (ti.x == 5) + (ti.y == 5); c6 += (ti.x == 6) + (ti.y == 6); c7 += (ti.x == 7) + (ti.y == 7); }
        cnt[0 * 512 + F.tid] = c0; cnt[1 * 512 + F.tid] = c1; cnt[2 * 512 + F.tid] = c2; cnt[3 * 512 + F.tid] = c3;
        cnt[4 * 512 + F.tid] = c4; cnt[5 * 512 + F.tid] = c5; cnt[6 * 512 + F.tid] = c6; cnt[7 * 512 + F.tid] = c7; }
    __syncthreads();
    {   LAS int* ce = cnt + F.wave * 512 + F.lane * 8;
        int v[8], s = 0;
#pragma unroll
        for (int q = 0; q < 8; ++q) { v[q] = ce[q]; s += v[q]; }
        int inc = s;
#pragma unroll
        for (int d = 1; d < 64; d <<= 1) { const int y = __shfl_up(inc, d); if (F.lane >= d) inc += y; }
        int run = inc - s;
#pragma unroll
        for (int q = 0; q < 8; ++q) { ce[q] = run; run += v[q]; }
        if (F.lane == 63) tot[F.wave] = inc; }
    __syncthreads();
    int seg[8]; { int a = 0;
#pragma unroll
        for (int e = 0; e < 8; ++e) { seg[e] = a; a += (tot[e] + 255) & ~255; } }
    if (blockIdx.x == 0 && F.tid < 8) __hip_atomic_store(F.ctl + CW_MOECNT + F.tid, (unsigned)tot[F.tid], RLX_AGENT);
    for (int u = blockIdx.x; u < NCHUNK; u += F.G) {
        if (F.wave == 0) {
            const int tk = 64 * u + F.lane, tp = tk >> 5; const int2 ti = topi[tk];
            const unsigned long long low = ((1ull << F.lane) - 1ull) & (F.lane >= 32 ? 0xFFFFFFFF00000000ull : 0x00000000FFFFFFFFull);
            int s1 = 0, s2 = 0;
#pragma unroll
            for (int e = 0; e < 8; ++e) { const unsigned long long mk = __ballot(ti.x == e || ti.y == e); const int within = __popcll(mk & low); const int pos = seg[e] + cnt[e * 512 + tp] + within;
                if (ti.x == e) s1 = pos; if (ti.y == e) s2 = pos; }
            ((int2*)(F.ws + WS_SLOT))[tk] = make_int2(s1, s2);
            slot_l[F.lane * 2] = s1; slot_l[F.lane * 2 + 1] = s2;
        }
        __syncthreads();
        {   v4u ra[8];
#pragma unroll
            for (int j = 0; j < 8; ++j) ra[j] = ((const v4u*)(xn + (size_t)(64 * u + F.wave * 8 + j) * D))[F.lane];
#pragma unroll
            for (int j = 0; j < 8; ++j) { const int s1 = slot_l[(F.wave * 8 + j) * 2], s2 = slot_l[(F.wave * 8 + j) * 2 + 1];
                ((v4u*)(xs + (size_t)s1 * D))[F.lane] = ra[j]; ((v4u*)(xs + (size_t)s2 * D))[F.lane] = ra[j]; }
        }
        __syncthreads();
    }
}
template <bool TS> struct MoeOrder {
    static constexpr bool VARK = TS;
    int nM, nN, G, c; int cs[9]; int nfull, nsplit, ntk, parts;
    __device__ __forceinline__ void init(unsigned* cntw, int nN_, int G_, int c_, int ntk_) { nN = nN_; G = G_; c = c_; ntk = ntk_; cs[0] = 0;
#pragma unroll
        for (int e = 0; e < 8; ++e) cs[e + 1] = cs[e] + (int)((__hip_atomic_load(cntw + e, RLX_AGENT) + 255u) >> 8);
        nM = cs[8]; const int total = nM * nN; nfull = TS ? (total / G) * G : total; nsplit = total - nfull;
        if (nsplit > 32) { nfull = total; nsplit = 0; }
        parts = 2; }
    __device__ __forceinline__ bool next(int i, pg8::Unit& u) const {
        const long L = (long)i * G + c; if (L >= (long)nfull + parts * nsplit) return false;
        int base = (int)L; u.nt = ntk; u.koff = 0; u.aux = -1;
        if (TS && L >= nfull) { const int q = ((int)L - nfull) / parts, part = ((int)L - nfull) % parts; base = nfull + q; u.nt = ntk / parts; u.koff = part * (ntk / parts) * 128; u.aux = part ? q * 3 + part - 1 : -1; }
        pg8::order_map(base, nM, nN, u);
        int e = 0;
#pragma unroll
        for (int k = 1; k < 8; ++k) e += (u.pm >= cs[k]) ? 1 : 0;
        u.pn += e * nN; return true; }
    __device__ __forceinline__ void a_ready(const pg8::Unit&) const {}
    __device__ __forceinline__ void done(const pg8::Unit&) const {}
};
__device__ __forceinline__ void final_rows(const Frame& F) {
    const int gw = F.vcu * NWAVES + F.wave, NGW = F.G * NWAVES;
    const bf16* H = (const bf16*)(F.ws + WS_XN); const bf16* ys = (const bf16*)(F.ws + WS_YS); const bf16* y2 = (const bf16*)(F.ws + WS_Y2);
    const int2* slot = (const int2*)(F.ws + WS_SLOT); const float2* tw = (const float2*)(F.ws + WS_TOPW);
    LAS int* stab = (LAS int*)F.lds;
    int nside;
    { MoeOrder<true> S; S.init(F.ctl + CW_MOECNT, D / 256, F.G, 0, FF / 128); nside = S.parts - 1;
      for (int i = F.tid; i < S.nM * 4; i += NTHR) stab[i] = -1;
      __syncthreads();
      for (int q = F.tid; q < S.nsplit; q += NTHR) { pg8::Unit u; pg8::order_map(S.nfull + q, S.nM, 4, u); stab[u.pm * 4 + u.pn] = q; }
      __syncthreads(); }
    f32x4 gv[4];
#pragma unroll
    for (int j = 0; j < 4; ++j) gv[j] = ((const f32x4*)F.in[I_FINAL_NORM])[F.lane + 64 * j];
    for (int m = gw; m < M; m += NGW) {
        const int2 sl = slot[m]; const float2 w = tw[m];
        const v2u* xr = (const v2u*)(H + (size_t)m * D) + F.lane;
        const v2u* y1p = (const v2u*)(ys + (size_t)sl.x * D) + F.lane; const v2u* y2p = (const v2u*)(ys + (size_t)sl.y * D) + F.lane;
        f32x4 v[4]; float s = 0.f;
#pragma unroll
        for (int j = 0; j < 4; ++j) { const v2u a = y1p[64 * j], b = y2p[64 * j];
            f32x4 ya = (f32x4){bfl(a.x), bfh(a.x), bfl(a.y), bfh(a.y)}, yb = (f32x4){bfl(b.x), bfh(b.x), bfl(b.y), bfh(b.y)};
            const int qa = stab[(sl.x >> 8) * 4 + j], qb = stab[(sl.y >> 8) * 4 + j];
            if (qa >= 0) { for (int pc = 0; pc < nside; ++pc) { const v2u t = *((const v2u*)(y2 + (size_t)(qa * 3 + pc) * 65536 + (size_t)(sl.x & 255) * 256) + F.lane); ya += (f32x4){bfl(t.x), bfh(t.x), bfl(t.y), bfh(t.y)}; } }
            if (qb >= 0) { for (int pc = 0; pc < nside; ++pc) { const v2u t = *((const v2u*)(y2 + (size_t)(qb * 3 + pc) * 65536 + (size_t)(sl.y & 255) * 256) + F.lane); yb += (f32x4){bfl(t.x), bfh(t.x), bfl(t.y), bfh(t.y)}; } }
            const v2u hx = xr[64 * j];
            v[j] = (f32x4){bfl(hx.x), bfh(hx.x), bfl(hx.y), bfh(hx.y)} + w.x * ya + w.y * yb;
            s += (v[j].x * v[j].x + v[j].y * v[j].y) + (v[j].z * v[j].z + v[j].w * v[j].w); }
        const float rstd = 1.0f / sqrtf(wave_sum(s) * (1.0f / D) + EPS);
        f32x4* o = (f32x4*)(F.out + (size_t)m * D) + F.lane;
#pragma unroll
        for (int j = 0; j < 4; ++j) o[64 * j] = v[j] * rstd * gv[j];
    }
}

constexpr int RTAB_OFF = MISC_OFF + 1024;
__device__ __forceinline__ void build_rstd_tables(const Frame& F, const pg8::StaticOrder& S, const float* ssp) {
    LAS float* rtab = (LAS float*)(F.lds + RTAB_OFF);
    const int r = F.tid & 255, ih = F.tid >> 8;
    f32x4 pa[4][4]; bool ok[4];
#pragma unroll
    for (int k = 0; k < 4; ++k) { pg8::Unit u; ok[k] = S.next(2 * k + ih, u); const int pm = ok[k] ? u.pm : 0;
        const f32x4* p = (const f32x4*)(ssp + (size_t)(pm * 256 + r) * 16);
#pragma unroll
        for (int q = 0; q < 4; ++q) pa[k][q] = p[q]; }
#pragma unroll
    for (int k = 0; k < 4; ++k) if (ok[k]) {
        const float P0 = (pa[k][0][0] + pa[k][0][1]) + (pa[k][0][2] + pa[k][0][3]), P1 = (pa[k][1][0] + pa[k][1][1]) + (pa[k][1][2] + pa[k][1][3]);
        const float P2 = (pa[k][2][0] + pa[k][2][1]) + (pa[k][2][2] + pa[k][2][3]), P3 = (pa[k][3][0] + pa[k][3][1]) + (pa[k][3][2] + pa[k][3][3]);
        rtab[(2 * k + ih) * 256 + r] = __builtin_amdgcn_rsqf(((P0 + P1) + (P2 + P3)) * (1.0f / 1024.0f) + 1e-6f); }
    __syncthreads();
}

#ifndef PHMASK
#define PHMASK 0xFFFFu
#endif
#define EN(b) ((PHMASK >> (b)) & 1u)
#ifndef PROBE_MASK
#define PROBE_MASK 0u
#endif
#define NREP(b) (1 + (int)((PROBE_MASK >> (b)) & 1u))
constexpr int PH_PRO = 0, PH_L = 1, PH_PER_LAYER = 10, PH_FINAL = 21, NPH = 22;
__global__ void __launch_bounds__(NTHR, 2) mk_fwd(Args args) {
    extern __shared__ __attribute__((aligned(16))) unsigned char lds_raw[];
    Frame F;
    F.lds = (LAS unsigned char*)lds_raw;
    F.tid = threadIdx.x; F.lane = F.tid & 63; F.wave = __builtin_amdgcn_readfirstlane(F.tid >> 6);
    F.G = gridDim.x; { const int bx = blockIdx.x; F.vcu = (F.G % 8 == 0) ? (bx % 8) * (F.G / 8) + bx / 8 : bx; }
    F.ws = args.ws; F.ctl = (unsigned*)(args.ws + WS_CTL); F.in = args.in; F.out = args.out;
    volatile LAS unsigned* MISC = (volatile LAS unsigned*)(F.lds + MISC_OFF);
    for (int u = F.tid; u < (LDS_BYTES - MISC_OFF) / 4; u += NTHR) MISC[u] = 0u;
    __syncthreads();
    const int lo = args.ph_lo, hi = args.ph_hi;
    XcdBarrier bar; bar.bar = F.ctl + CW_BAR; bar.x = 0; bar.st = nullptr;
    if (hi - lo > 1) bar = xcd_barrier_post(F.ctl + CW_BAR, MISC + 8);
#define IN(k) (lo <= (k) && (k) < hi)
#define FRESH() do { int tz_ = threadIdx.x; asm volatile("" : "+v"(tz_)); F.tid = tz_; F.lane = tz_ & 63; F.wave = __builtin_amdgcn_readfirstlane(tz_ >> 6); } while (0)
#define SEAM(k) do { if (IN(k) && IN((k) + 1)) xcd_barrier(bar); STAMP(k); } while (0)
#define STAMP(k) tp_stamp(F.lds, (k))
    STAMP(-1);
    unsigned char* ws = args.ws;
    bf16* XN = (bf16*)(ws + WS_XN); bf16* PROJ = (bf16*)(ws + WS_BIG);

    if (EN(0) && IN(PH_PRO)) { FRESH(); for (int rep = 0; rep < NREP(0); ++rep) convert_jobs(F, 0, 1, 39, 40, F.vcu * NWAVES + F.wave, F.G * NWAVES);   ssm_tables(F); for (int rep = 0; rep < NREP(6); ++rep) cast_rows(F, F.in[I_X], XN); }
    SEAM(PH_PRO);
    for (int l = 0; l < 2; ++l) {
        const int pb = PH_L + l * PH_PER_LAYER;
        unsigned char* wl = ws + (size_t)l * WS_LSTRIDE;
        F.ycat_off = l ? WS_YCAT1 : WS_YCAT0;
        bf16* YCAT = (bf16*)(ws + F.ycat_off); bf16* MERGED = (bf16*)(ws + (l ? WS_MERGED1 : WS_MERGED0));
        if (EN(1) && IN(pb + 0)) {
            pg8::Gemm g{XN, (const bf16*)(wl + WS_WIN0), M, C_G, D}; pg8::StaticOrder S; S.init(M, C_G, F.G, (int)blockIdx.x);
            FRESH(); build_rstd_tables(F, S, (const float*)(ws + WS_SSP));
            pg8::EpiProj E{PROJ, INC, 1 << 30, (const float*)(ws + WS_SSP), (const LAS float*)(F.lds + RTAB_OFF), 0, 1.f};
            for (int rep = 0; rep < NREP(1); ++rep) pg8::gemm_phase<pg8::EpiProj, pg8::StaticOrder, true, true>(F.lds, g, S, E);
            STAMP(100 + 10 * l);
            const int nfull = S.nwg % F.G;
            if (nfull != 0) { FRESH(); const int widx = ((int)blockIdx.x >= nfull) ? ((int)blockIdx.x - nfull) * NWAVES + F.wave : -1, nw = (F.G - nfull) * NWAVES;
                if (l == 0) convert_jobs(F, 1, 15, 40, 41, widx, nw); else convert_jobs(F, 23, 27, widx, nw); }
            else { FRESH(); const int widx = F.vcu * NWAVES + F.wave, nw = F.G * NWAVES; if (l == 0) convert_jobs(F, 1, 15, 40, 41, widx, nw); else convert_jobs(F, 23, 27, widx, nw); }
            __syncthreads();
            STAMP(101 + 10 * l);
            pg8::Gemm g8{(const bf16*)(ws + WS_HB8), (const bf16*)(wl + WS_WING8), M, INC - C_G, D / 2}; pg8::StaticOrder S8; S8.init(M, INC - C_G, F.G, (int)blockIdx.x);
            FRESH(); build_rstd_tables(F, S8, (const float*)(ws + WS_SSP));
            pg8::EpiProj E8{PROJ, INC, 0, (const float*)(ws + WS_SSP), (const LAS float*)(F.lds + RTAB_OFF), C_G, 1.0f / (SC_XS * SC_W)};
            for (int rep = 0; rep < NREP(1); ++rep) pg8::gemm_phase<pg8::EpiProj, pg8::StaticOrder, true, true, true>(F.lds, g8, S8, E8);
            STAMP(103 + 10 * l);
        }
        SEAM(pb + 0);
        if (EN(2) && IN(pb + 1)) { FRESH(); mixer_b(F, l, NREP(9), NREP(2)); }
        SEAM(pb + 1);
        if (EN(3) && IN(pb + 2)) { FRESH(); for (int rep = 0; rep < NREP(3); ++rep) for (int u = blockIdx.x; u < NCHUNK; u += F.G) ssm_pass2_unit(F, l, u); STAMP(202 + 10 * l); }
        SEAM(pb + 2);
        if (EN(4) && IN(pb + 3)) {
            pg8::Gemm g{YCAT, (const bf16*)(wl + WS_WCAT0), M, D, D}; pg8::StaticOrder S; S.init(M, D, F.G, (int)blockIdx.x);
            pg8::EpiBranch E{PROJ + C_G, INC, MERGED, D};
            for (int rep = 0; rep < NREP(4); ++rep) pg8::gemm_phase<pg8::EpiBranch, pg8::StaticOrder, false, true>(F.lds, g, S, E);
            STAMP(300 + 10 * l);
        }
        SEAM(pb + 3);
        if (EN(5) && IN(pb + 4)) {
            pg8::Gemm g{MERGED, (const bf16*)(wl + WS_WOUT0), M, D, D}; pg8::StaticOrder S; S.init(M, D, F.G, (int)blockIdx.x);
            if (l == 0) { pg8::EpiResid<1, false> E{F.in[I_X], (pg8::bf16_t*)XN, D, (float*)(ws + WS_SSP), nullptr, 1.f, 1.f};
                pg8::gemm_phase<pg8::EpiResid<1, false>, pg8::StaticOrder, false, true>(F.lds, g, S, E); }
            else { for (int rep = 0; rep < NREP(5); ++rep) { pg8::EpiResid<0, true> E{XN, (rep + 1 < NREP(5)) ? (pg8::bf16_t*)PROJ : (pg8::bf16_t*)XN, D, nullptr, nullptr, 1.f, 1.f};
                pg8::gemm_phase<pg8::EpiResid<0, true>, pg8::StaticOrder, false, true>(F.lds, g, S, E); } }
        }
        SEAM(pb + 4);
        if (l == 0) {
            if (EN(7) && IN(pb + 6)) {
                pg8::Gemm g{XN, (const bf16*)(ws + WS_WGU0), M, 2 * FF, D}; pg8::StaticOrder S; S.init(M, 2 * FF, F.G, (int)blockIdx.x);
                FRESH(); build_rstd_tables(F, S, (const float*)(ws + WS_SSP));
                pg8::EpiSwiglu<true, true> E{PROJ, FF, 2 * FF / 256, (const float*)(ws + WS_SSP), (const LAS float*)(F.lds + RTAB_OFF), SC_ACT};
                for (int rep = 0; rep < NREP(7); ++rep) pg8::gemm_phase<pg8::EpiSwiglu<true, true>, pg8::StaticOrder, true, true>(F.lds, g, S, E);
            }
            SEAM(pb + 6);
            if (EN(8) && IN(pb + 7)) {
                pg8::Gemm g{PROJ, (const bf16*)(ws + WS_WD0), M, D, FF / 2}; pg8::StaticOrder S; S.init(M, D, F.G, (int)blockIdx.x);
                pg8::EpiResid<3, true> E{XN, (pg8::bf16_t*)XN, D, (float*)(ws + WS_SSP), ws + WS_HB8, SC_XS, 1.0f / (SC_ACT * SC_W)};
                pg8::gemm_phase<pg8::EpiResid<3, true>, pg8::StaticOrder, false, true, true>(F.lds, g, S, E);
            }
            SEAM(pb + 7);
        } else {
            if (EN(10) && IN(pb + 5)) { FRESH(); for (int rep = 0; rep < NREP(6); ++rep) { norm_rows<true>(F, XN, F.in[I_NORM_FFN] + D, (bf16*)(ws + WS_XNN)); __syncthreads(); } for (int rep = 0; rep < NREP(0); ++rep) convert_jobs(F, 15, 23, 27, 39, F.vcu * NWAVES + F.wave, F.G * NWAVES); }
            SEAM(pb + 5);
            if (EN(11) && IN(pb + 6)) { FRESH(); for (int rep = 0; rep < NREP(11); ++rep) moe_gather(F); }
            SEAM(pb + 6);
            if (EN(12) && IN(pb + 7)) {
                pg8::Gemm g{(const bf16*)(ws + WS_XS), (const bf16*)(ws + WS_WMOE), MPAD, 2 * FF, D / 2}; MoeOrder<false> S; S.init(F.ctl + CW_MOECNT, 2 * FF / 256, F.G, (int)blockIdx.x, D / 128);
                pg8::EpiSwiglu8 E{ws + WS_ACTM, FF, 2 * FF / 256, -1.4426950408889634f / (SC_XS * SC_W), (SC_XS * SC_W) * (SC_XS * SC_W) / SC_ACT};
                for (int rep = 0; rep < NREP(12); ++rep) pg8::gemm_phase<pg8::EpiSwiglu8, MoeOrder<false>, true, true, true>(F.lds, g, S, E);
            }
            if (IN(pb + 7) && IN(pb + 9)) xcd_barrier(bar);
            STAMP(pb + 7);
            if (EN(14) && IN(pb + 9)) {
                pg8::Gemm g{(const bf16*)(ws + WS_ACTM), (const bf16*)(ws + WS_WD8), MPAD, D, FF / 2}; MoeOrder<true> S; S.init(F.ctl + CW_MOECNT, D / 256, F.G, (int)blockIdx.x, FF / 128);
                pg8::EpiMoeDown E{(bf16*)(ws + WS_YS), D, D / 256, (bf16*)(ws + WS_Y2), 1.0f / (SC_ACT * SC_W)};
                for (int rep = 0; rep < NREP(14); ++rep) pg8::gemm_phase<pg8::EpiMoeDown, MoeOrder<true>, true, true, true>(F.lds, g, S, E);
            }
            SEAM(pb + 9);
        }
    }
    if (EN(15) && IN(PH_FINAL)) { FRESH(); for (int rep = 0; rep < NREP(15); ++rep) final_rows(F); }
    STAMP(PH_FINAL);
    if (TP_A != -2 && blockIdx.x == 0 && threadIdx.x == 0) { const long long tend = wall_clock64(), hold = (*(volatile LAS long long*)(F.lds + 140296) - *(volatile LAS long long*)(F.lds + 140288)) * TP_MUL; while (wall_clock64() - tend < hold) __builtin_amdgcn_s_sleep(32); }
#undef IN
#undef SEAM
}

extern "C" void kernel_launch(void* const* d_in, const int* in_sizes, int n_in, void* d_out, int out_size, void* d_ws, size_t ws_size, hipStream_t stream) {
    static int grid = 0;
    if (grid == 0) {
        if (n_in != 26 || in_sizes[0] != M * D || out_size != M * D || ws_size < WS_END) { fprintf(stderr, "kernel_launch: unexpected shapes (n_in %d, in0 %d, out %d, ws %zu < %zu); nothing launched\n", n_in, n_in > 0 ? in_sizes[0] : -1, out_size, ws_size, (size_t)WS_END); grid = -1; return; }
        int dev = 0, cus = 0;
        if (hipGetDevice(&dev) != hipSuccess || hipDeviceGetAttribute(&cus, hipDeviceAttributeMultiprocessorCount, dev) != hipSuccess) { fprintf(stderr, "kernel_launch: device query failed\n"); grid = -1; return; }
        if (hipFuncSetAttribute((const void*)mk_fwd, hipFuncAttributeMaxDynamicSharedMemorySize, LDS_BYTES) != hipSuccess) { fprintf(stderr, "kernel_launch: hipFuncSetAttribute failed\n"); grid = -1; return; }
        int per_cu = 0;
        if (hipOccupancyMaxActiveBlocksPerMultiprocessor(&per_cu, (const void*)mk_fwd, NTHR, LDS_BYTES) != hipSuccess || per_cu < 1) fprintf(stderr, "kernel_launch: occupancy query reports %d blocks per CU\n", per_cu);
        (void)hipGetLastError();
        grid = cus;
    }
    if (grid < 0) return;
    if (hipMemsetAsync((char*)d_ws + WS_CTL, 0, CTL_ZERO_BYTES, stream) != hipSuccess) { fprintf(stderr, "kernel_launch: memset failed\n"); return; }
    Args a{};
    for (int i = 0; i < 26; ++i) a.in[i] = (const float*)d_in[i];
    a.out = (float*)d_out; a.ws = (unsigned char*)d_ws;
#if MK_ONE_LAUNCH
    a.ph_lo = 0; a.ph_hi = NPH;
    hipLaunchKernelGGL(mk_fwd, dim3(grid), dim3(NTHR), LDS_BYTES, stream, a);
#else
    for (int ph = 0; ph < NPH; ++ph) {
        if (ph == PH_L + 9) continue;
        a.ph_lo = ph; a.ph_hi = ph + 1;
        hipLaunchKernelGGL(mk_fwd, dim3(grid), dim3(NTHR), LDS_BYTES, stream, a);
    }
#endif
    const hipError_t le = hipPeekAtLastError();
    if (le != hipSuccess) fprintf(stderr, "kernel_launch: launch failed: %s\n", hipGetErrorName(le));
}
```

```cpp
#include <hip/hip_runtime.h>
#include <cstdio>
#include <cstdint>

#ifndef MK_ONE_LAUNCH
#define MK_ONE_LAUNCH 1
#endif

namespace pg8 {
#define PG8_LAS __attribute__((address_space(3)))
typedef unsigned short bf16_t;
typedef short bf16x8 __attribute__((ext_vector_type(8)));
typedef float f32x4 __attribute__((ext_vector_type(4)));
typedef float f32x2 __attribute__((ext_vector_type(2)));
typedef unsigned u32x4 __attribute__((ext_vector_type(4)));
constexpr int BM = 256, BK = 64, HALF = 128, HTB = HALF * BK * 2  , STAGE_BYTES = 8 * HTB, NXCD = 8, WGM = 8;

__host__ __device__ __forceinline__ int lds_byte(int r, int c) { const int st = (r >> 4) * 2 + (c >> 5), rr = r & 15, cc = c & 31, ob = rr * 64 + cc * 2; return st * 1024 + (ob ^ (((ob >> 9) & 1) << 5)); }
__host__ __device__ __forceinline__ void stage_rc(int b, int& R, int& C) { const int st = b / 1024, sb = b % 1024, swz = sb ^ (((sb >> 9) & 1) << 5); R = (st >> 1) * 16 + swz / 64; C = (st & 1) * 32 + (swz % 64) / 2; }
__host__ __device__ __forceinline__ int perm32(int rho) { const int n = rho >> 4, i = rho & 15; return 8 * (i >> 2) + 4 * n + (i & 3); }

struct Unit { int pm, pn; int nt, koff, aux; };
struct Gemm { const bf16_t* A; const bf16_t* Bt; int M, N, K; };

__host__ __device__ __forceinline__ void order_map(int L, int nM, int nN, Unit& u) {
    const int nwg = nM * nN;
    int wgid = L; { const int q = nwg / NXCD, r = nwg % NXCD, xcd = wgid % NXCD, off = wgid / NXCD; wgid = (xcd < r ? xcd * (q + 1) : r * (q + 1) + (xcd - r) * q) + off; }
    const int nig = WGM * nN, gid = wgid / nig, fm = gid * WGM, gsz = (nM - fm) < WGM ? (nM - fm) : WGM;
    u.pm = fm + ((wgid % nig) % gsz); u.pn = (wgid % nig) / gsz;
}
struct StaticOrder {
    static constexpr bool VARK = false;
    int nM, nN, nwg, G, c;
    __host__ __device__ void init(int M, int N, int G_, int c_) { nM = M / BM; nN = N / BM; nwg = nM * nN; G = G_; c = c_; }
    __host__ __device__ bool next(int i, Unit& u) const {
        const long L = (long)i * G + c; if (L >= nwg) return false;
        order_map((int)L, nM, nN, u); u.aux = i; return true;
    }
    __device__ __forceinline__ void a_ready(const Unit&) const {}
    __device__ __forceinline__ void done(const Unit&) const {}
};
typedef __bf16 bf16x2n __attribute__((ext_vector_type(2)));
__device__ __forceinline__ unsigned cvt_pk_bf16(float lo, float hi) { const f32x2 v = {lo, hi}; return __builtin_bit_cast(unsigned, __builtin_convertvector(v, bf16x2n)); }

template <class Epi, class Sched, bool ALIGN_EPI = false, bool SP2 = false, bool FP8 = false>
__device__ __forceinline__ void gemm_phase(PG8_LAS unsigned char* lds, const Gemm g, const Sched& S, const Epi& E) {
    int tid_ = threadIdx.x; asm volatile("" : "+v"(tid_));
    const int tid = tid_, wid = __builtin_amdgcn_readfirstlane(tid >> 6), lane = tid & 63, wr = wid >> 2, wc = wid & 3, fr = lane & 15, fq = lane >> 4;
    const int K = g.K, nt = K / BK;
    unsigned voffA[2], voffB[2];
#pragma unroll
    for (int i = 0; i < 2; ++i) { int R, C; stage_rc(tid * 16 + i * 8192, R, C); const int Rb = Epi::PERM ? ((R & ~31) + perm32(R & 31)) : R;
        voffA[i] = (unsigned)(R * K + C) * 2u; voffB[i] = (unsigned)(Rb * K + C) * 2u; }
    const size_t kstep = (size_t)(BK * 2);
    const size_t hstep = (size_t)HALF * K * 2;
    const size_t tstep = 2 * hstep;
    const unsigned ldsw = (unsigned)wid * 1024u;
    const int aoff = lds_byte(wr * 64 + fr, fq * 8), boff = lds_byte(wc * 32 + fr, fq * 8);
#define PG8_SA(b, h) (((b) * 2 + (h)) * HTB)
#define PG8_SB(b, h) ((4 + (b) * 2 + (h)) * HTB)
#define PG8_STAGE(bufoff, gbase, voff) do { _Pragma("unroll") for (int _i = 0; _i < 2; ++_i) \
        __builtin_amdgcn_global_load_lds((const unsigned*)((const char*)(gbase) + (voff)[_i]), (PG8_LAS unsigned*)(lds + (bufoff) + ldsw + _i * 8192), 16, 0, 0); } while (0)
#define PG8_LDA(dst, b, h) do { _Pragma("unroll") for (int m = 0; m < 4; ++m) { if constexpr (FP8) { dst##w[m] = __builtin_shufflevector(*(const PG8_LAS bf16x8*)(lds + PG8_SA(b, h) + aoff + m * 2048), *(const PG8_LAS bf16x8*)(lds + PG8_SA(b, h) + aoff + m * 2048 + 1024), 0, 1, 2, 3, 4, 5, 6, 7, 8, 9, 10, 11, 12, 13, 14, 15); } \
        else { _Pragma("unroll") for (int k = 0; k < 2; ++k) dst[m][k] = *(const PG8_LAS bf16x8*)(lds + PG8_SA(b, h) + aoff + m * 2048 + k * 1024); } } } while (0)
#define PG8_LDB(dst, b, h) do { _Pragma("unroll") for (int n = 0; n < 2; ++n) { if constexpr (FP8) { dst##w[n] = __builtin_shufflevector(*(const PG8_LAS bf16x8*)(lds + PG8_SB(b, h) + boff + n * 2048), *(const PG8_LAS bf16x8*)(lds + PG8_SB(b, h) + boff + n * 2048 + 1024), 0, 1, 2, 3, 4, 5, 6, 7, 8, 9, 10, 11, 12, 13, 14, 15); } \
        else { _Pragma("unroll") for (int k = 0; k < 2; ++k) dst[n][k] = *(const PG8_LAS bf16x8*)(lds + PG8_SB(b, h) + boff + n * 2048 + k * 1024); } } } while (0)
#define PG8_MMA(ai, bj, At, Bt) do { __builtin_amdgcn_s_setprio(1); _Pragma("unroll") for (int m = 0; m < 4; ++m) _Pragma("unroll") for (int n = 0; n < 2; ++n) { \
        if constexpr (FP8) { typedef int v8i_ __attribute__((ext_vector_type(8))); \
            asm volatile("v_mfma_scale_f32_16x16x128_f8f6f4 %0, %1, %2, %0, %3, %3 op_sel_hi:[0,0,0]" : "+v"(acc[ai][bj][m][n]) : "v"(__builtin_bit_cast(v8i_, Bt##w[n])), "v"(__builtin_bit_cast(v8i_, At##w[m])), "v"(sc8)); } \
        else { _Pragma("unroll") for (int k = 0; k < 2; ++k) acc[ai][bj][m][n] = __builtin_amdgcn_mfma_f32_16x16x32_bf16(Bt[n][k], At[m][k], acc[ai][bj][m][n], 0, 0, 0); } } \
        __builtin_amdgcn_s_setprio(0); } while (0)
#define PG8_WAIT_V(n) asm volatile("s_waitcnt vmcnt(" #n ")" ::: "memory")
#define PG8_WAIT_L(n) asm volatile("s_waitcnt lgkmcnt(" #n ")" ::: "memory")
#define PG8_BAR __builtin_amdgcn_s_barrier()
#define PG8_SCHED __builtin_amdgcn_sched_barrier(0)
    Unit cur, nxt; int ui = 0;
    if (!S.next(0, cur)) return;
    f32x4 acc[2][2][4][2];
#pragma unroll
    for (int a = 0; a < 2; ++a)
#pragma unroll
        for (int b = 0; b < 2; ++b)
#pragma unroll
            for (int m = 0; m < 4; ++m)
#pragma unroll
                for (int n = 0; n < 2; ++n) acc[a][b][m][n] = (f32x4){0.f, 0.f, 0.f, 0.f};
    bf16x8 At[4][2], B0[2][2], B1[2][2];
    typedef short bf16x16_ __attribute__((ext_vector_type(16))); bf16x16_ Atw[4], B0w[2], B1w[2];
    unsigned sc8 = 0x7F7F7F7Fu; asm volatile("" : "+v"(sc8));
    const char* cA = (const char*)g.A + (size_t)cur.pm * tstep; const char* cB = (const char*)g.Bt + (size_t)cur.pn * tstep;
    int cnt = nt;
    if constexpr (Sched::VARK) { cnt = cur.nt; cA += cur.koff; cB += cur.koff; }
    S.a_ready(cur);
    if constexpr (SP2) {
        PG8_STAGE(PG8_SB(0, 0), cB, voffB); PG8_STAGE(PG8_SB(0, 1), cB + hstep, voffB); PG8_STAGE(PG8_SA(0, 0), cA, voffA); PG8_STAGE(PG8_SA(0, 1), cA + hstep, voffA);
        if (wr == 1) PG8_BAR;
        PG8_WAIT_V(2); PG8_BAR;
        PG8_STAGE(PG8_SB(1, 0), cB + kstep, voffB); PG8_STAGE(PG8_SA(1, 0), cA + kstep, voffA); PG8_STAGE(PG8_SB(1, 1), cB + hstep + kstep, voffB);
        PG8_WAIT_V(6); PG8_BAR;
    } else {
        PG8_STAGE(PG8_SB(0, 0), cB, voffB); PG8_STAGE(PG8_SA(0, 0), cA, voffA); PG8_STAGE(PG8_SB(0, 1), cB + hstep, voffB); PG8_STAGE(PG8_SA(0, 1), cA + hstep, voffA);
        if (wr == 1) PG8_BAR;
        PG8_WAIT_V(4); PG8_BAR;
        PG8_STAGE(PG8_SB(1, 0), cB + kstep, voffB); PG8_STAGE(PG8_SA(1, 0), cA + kstep, voffA); PG8_STAGE(PG8_SB(1, 1), cB + hstep + kstep, voffB);
        PG8_WAIT_V(6); PG8_BAR;
    }
    for (;;) {
        const bool has_next = S.next(ui + 1, nxt);
        const char* nA = has_next ? (const char*)g.A + (size_t)nxt.pm * tstep : cA; const char* nB = has_next ? (const char*)g.Bt + (size_t)nxt.pn * tstep : cB;
        if constexpr (Sched::VARK) { if (has_next) { nA += nxt.koff; nB += nxt.koff; } }
        for (int t = 0; t < cnt; t += 2) {
            const bool last = (t == cnt - 2);
            const char* a1 = cA + (size_t)(t + 1) * kstep;
            const char* a2 = last ? nA : cA + (size_t)(t + 2) * kstep; const char* b2 = last ? nB : cB + (size_t)(t + 2) * kstep;
            const char* a3 = a2 + kstep; const char* b3 = b2 + kstep;
            if (last && has_next) S.a_ready(nxt);
            if constexpr (Epi::MIDK) { if (t == Epi::MID0 || t == Epi::MID1) { int tz_ = tid; asm volatile("" : "+v"(tz_)); const int ln_ = tz_ & 63; E.mid(acc, cur, t, wr, wc, ln_ & 15, ln_ >> 4); } }
            if constexpr (SP2) {
            PG8_LDB(B0, 0, 0); PG8_LDB(B1, 0, 1); PG8_SCHED; PG8_LDA(At, 0, 0); PG8_STAGE(PG8_SA(1, 1), a1 + hstep, voffA);
            PG8_WAIT_V(8); PG8_WAIT_L(0); PG8_BAR; PG8_MMA(0, 0, At, B0); PG8_MMA(0, 1, At, B1); PG8_BAR; PG8_SCHED;
            PG8_LDA(At, 0, 1); PG8_STAGE(PG8_SB(0, 0), b2, voffB); PG8_STAGE(PG8_SB(0, 1), b2 + hstep, voffB); PG8_STAGE(PG8_SA(0, 0), a2, voffA);
            PG8_WAIT_V(8); PG8_WAIT_L(0); PG8_BAR; PG8_MMA(1, 0, At, B0); PG8_MMA(1, 1, At, B1); PG8_BAR; PG8_SCHED;
            PG8_LDB(B0, 1, 0); PG8_LDB(B1, 1, 1); PG8_SCHED; PG8_LDA(At, 1, 0); PG8_STAGE(PG8_SA(0, 1), a2 + hstep, voffA);
            PG8_WAIT_V(8); PG8_WAIT_L(0); PG8_BAR; PG8_MMA(0, 0, At, B0); PG8_MMA(0, 1, At, B1); PG8_BAR; PG8_SCHED;
            PG8_LDA(At, 1, 1); PG8_STAGE(PG8_SB(1, 0), b3, voffB); PG8_STAGE(PG8_SB(1, 1), b3 + hstep, voffB); PG8_STAGE(PG8_SA(1, 0), a3, voffA);
            PG8_WAIT_V(8); PG8_WAIT_L(0); PG8_BAR; PG8_MMA(1, 0, At, B0); PG8_MMA(1, 1, At, B1); PG8_BAR; PG8_SCHED;
            } else {
            PG8_LDB(B0, 0, 0); PG8_SCHED; PG8_LDA(At, 0, 0); PG8_STAGE(PG8_SA(1, 1), a1 + hstep, voffA);
            PG8_WAIT_L(8); PG8_BAR; PG8_WAIT_L(0); PG8_MMA(0, 0, At, B0); PG8_BAR; PG8_SCHED;
            PG8_LDB(B1, 0, 1); PG8_STAGE(PG8_SB(0, 0), b2, voffB);
            PG8_BAR; PG8_WAIT_L(0); PG8_MMA(0, 1, At, B1); PG8_BAR;
            PG8_LDA(At, 0, 1); PG8_STAGE(PG8_SA(0, 0), a2, voffA);
            PG8_BAR; PG8_WAIT_L(0); PG8_MMA(1, 0, At, B0); PG8_BAR; PG8_SCHED;
            PG8_STAGE(PG8_SB(0, 1), b2 + hstep, voffB);
            PG8_WAIT_V(6); PG8_BAR; PG8_MMA(1, 1, At, B1); PG8_BAR;
            PG8_LDB(B0, 1, 0); PG8_SCHED; PG8_LDA(At, 1, 0); PG8_STAGE(PG8_SA(0, 1), a2 + hstep, voffA);
            PG8_WAIT_L(8); PG8_BAR; PG8_WAIT_L(0); PG8_MMA(0, 0, At, B0); PG8_BAR; PG8_SCHED;
            PG8_LDB(B1, 1, 1); PG8_STAGE(PG8_SB(1, 0), b3, voffB);
            PG8_BAR; PG8_WAIT_L(0); PG8_MMA(0, 1, At, B1); PG8_BAR;
            PG8_LDA(At, 1, 1); PG8_STAGE(PG8_SA(1, 0), a3, voffA);
            PG8_BAR; PG8_WAIT_L(0); PG8_MMA(1, 0, At, B0); PG8_BAR; PG8_SCHED;
            PG8_STAGE(PG8_SB(1, 1), b3 + hstep, voffB);
            PG8_WAIT_V(6); PG8_BAR; PG8_MMA(1, 1, At, B1); PG8_BAR;
            }
        }
        if constexpr (ALIGN_EPI) { if (wr == 0) PG8_BAR; }
        if constexpr (FP8) asm volatile("s_nop 15\n\ts_nop 15" ::: "memory");
        if constexpr (!Epi::AFTER_DRAIN) { int tz_ = tid; asm volatile("" : "+v"(tz_)); const int ln_ = tz_ & 63;
            E(acc, cur, wr, wc, ln_ & 15, ln_ >> 4); S.done(cur); }
        if (!has_next) break;
#pragma unroll
        for (int a = 0; a < 2; ++a)
#pragma unroll
            for (int b = 0; b < 2; ++b)
#pragma unroll
                for (int m = 0; m < 4; ++m)
#pragma unroll
                    for (int n = 0; n < 2; ++n) acc[a][b][m][n] = (f32x4){0.f, 0.f, 0.f, 0.f};
        cur = nxt; cA = nA; cB = nB; ++ui; if constexpr (Sched::VARK) cnt = cur.nt;
        if constexpr (ALIGN_EPI) { if (wr == 1) PG8_BAR; }
    }
    PG8_WAIT_V(0);
    if constexpr (!ALIGN_EPI) { if (wr == 0) PG8_BAR; }
    PG8_BAR;
    if constexpr (Epi::AFTER_DRAIN) { E.fused(acc, cur, wr, wc, fr, fq, lds, wid, lane); S.done(cur); }
#undef PG8_SA
#undef PG8_SB
#undef PG8_STAGE
#undef PG8_LDA
#undef PG8_LDB
#undef PG8_MMA
#undef PG8_WAIT_V
#undef PG8_WAIT_L
#undef PG8_BAR
#undef PG8_SCHED
}

__device__ __forceinline__ float bfl(unsigned w) { return __uint_as_float(w << 16); }
__device__ __forceinline__ float bfh(unsigned w) { return __uint_as_float(w & 0xffff0000u); }
__device__ __forceinline__ float sigmoid_clamped(float l) { l = fminf(fmaxf(l, -30.f), 30.f); return __builtin_amdgcn_rcpf(1.f + __expf(-l)); }
__device__ __forceinline__ float onepexp_clamped(float l) { l = fminf(fmaxf(l, -30.f), 30.f); return 1.f + __expf(-l); }

__device__ __forceinline__ float sum_fq(float x) {
    { const auto r = __builtin_amdgcn_permlane16_swap(__float_as_uint(x), __float_as_uint(x), false, false); x = __uint_as_float(r[0]) + __uint_as_float(r[1]); }
    { const auto r = __builtin_amdgcn_permlane32_swap(__float_as_uint(x), __float_as_uint(x), false, false); x = __uint_as_float(r[0]) + __uint_as_float(r[1]); }
    return x;
}
__device__ __forceinline__ float row_rstd(const float* ssp, int r, int fq) {
    const f32x4 p4 = *(const f32x4*)(ssp + (size_t)r * 16 + 4 * fq);
    float s = (p4[0] + p4[1]) + (p4[2] + p4[3]);
    s = sum_fq(s);
    return __builtin_amdgcn_rsqf(s * (1.0f / 1024.0f) + 1e-6f);
}
__device__ __forceinline__ void row_rstd8(const float* ssp, int row0, int fq, float (&rs)[2][4]) {
    f32x4 p4[2][4];
#pragma unroll
    for (int ai = 0; ai < 2; ++ai)
#pragma unroll
        for (int m = 0; m < 4; ++m) p4[ai][m] = *(const f32x4*)(ssp + (size_t)(row0 + ai * HALF + m * 16) * 16 + 4 * fq);
#pragma unroll
    for (int ai = 0; ai < 2; ++ai)
#pragma unroll
        for (int m = 0; m < 4; ++m) { float s = (p4[ai][m][0] + p4[ai][m][1]) + (p4[ai][m][2] + p4[ai][m][3]); s = sum_fq(s); rs[ai][m] = __builtin_amdgcn_rsqf(s * (1.0f / 1024.0f) + 1e-6f); }
}
__device__ __forceinline__ void rstd8(const PG8_LAS float* rtab, const float* ssp, const Unit& u, int row0, int rloc, int fq, float (&rs)[2][4]) {
    if (u.aux < 8) {
#pragma unroll
        for (int ai = 0; ai < 2; ++ai)
#pragma unroll
            for (int m = 0; m < 4; ++m) rs[ai][m] = rtab[u.aux * 256 + rloc + ai * HALF + m * 16];
    } else row_rstd8(ssp, row0, fq, rs);
}
struct EpiStoreBf16 {
    static constexpr bool PERM = true, AFTER_DRAIN = false, MIDK = false; static constexpr int MID0 = -1, MID1 = -1;
    bf16_t* O; int ldc; int nct;
    __device__ __forceinline__ void operator()(const f32x4 (&acc)[2][2][4][2], const Unit& u, int wr, int wc, int fr, int fq) const {
        const int row0 = u.pm * BM + wr * 64 + fr, col0 = (u.pn % nct) * BM + wc * 32 + 8 * fq;
#pragma unroll
        for (int ai = 0; ai < 2; ++ai)
#pragma unroll
            for (int m = 0; m < 4; ++m) { bf16_t* rowp = O + (size_t)(row0 + ai * HALF + m * 16) * ldc + col0;
#pragma unroll
                for (int bj = 0; bj < 2; ++bj) { const f32x4 v0 = acc[ai][bj][m][0], v1 = acc[ai][bj][m][1];
                    u32x4 w; w.x = cvt_pk_bf16(v0[0], v0[1]); w.y = cvt_pk_bf16(v0[2], v0[3]); w.z = cvt_pk_bf16(v1[0], v1[1]); w.w = cvt_pk_bf16(v1[2], v1[3]);
                    *(u32x4*)(rowp + bj * HALF) = w; } }
    }
};
struct EpiProj {
    static constexpr bool PERM = true, AFTER_DRAIN = false, MIDK = false; static constexpr int MID0 = -1, MID1 = -1;
    bf16_t* O; int ldc; int gate_tile0; const float* ssp; const PG8_LAS float* rtab; int col_off; float scale;
    __device__ __forceinline__ void operator()(const f32x4 (&acc)[2][2][4][2], const Unit& u, int wr, int wc, int fr, int fq) const {
        const int row0 = u.pm * BM + wr * 64 + fr, col0 = col_off + u.pn * BM + wc * 32 + 8 * fq;
        const bool gate = u.pn >= gate_tile0;
        float rsv[2][4]; rstd8(rtab, ssp, u, row0, wr * 64 + fr, fq, rsv);
#pragma unroll
        for (int ai = 0; ai < 2; ++ai)
#pragma unroll
            for (int m = 0; m < 4; ++m) { bf16_t* rowp = O + (size_t)(row0 + ai * HALF + m * 16) * ldc + col0;
                const float rs = rsv[ai][m] * scale;
                if (gate) { const float k1 = rs * -1.4426950408889634f;
#pragma unroll
                    for (int bj = 0; bj < 2; ++bj) { u32x4 w;
#pragma unroll
                        for (int q = 0; q < 4; ++q) { const f32x2 a2 = {acc[ai][bj][m][q >> 1][2 * (q & 1)], acc[ai][bj][m][q >> 1][2 * (q & 1) + 1]}; const f32x2 t = a2 * k1;
                            const f32x2 ex = {__builtin_amdgcn_exp2f(__builtin_amdgcn_fmed3f(t.x, -43.280851f, 43.280851f)), __builtin_amdgcn_exp2f(__builtin_amdgcn_fmed3f(t.y, -43.280851f, 43.280851f))};
                            const f32x2 o = ex + 1.0f; w[q] = cvt_pk_bf16(o.x, o.y); }
                        *(u32x4*)(rowp + bj * HALF) = w; } }
                else {
#pragma unroll
                    for (int bj = 0; bj < 2; ++bj) { const f32x4 v0 = acc[ai][bj][m][0] * rs, v1 = acc[ai][bj][m][1] * rs;
                        u32x4 w; w.x = cvt_pk_bf16(v0[0], v0[1]); w.y = cvt_pk_bf16(v0[2], v0[3]); w.z = cvt_pk_bf16(v1[0], v1[1]); w.w = cvt_pk_bf16(v1[2], v1[3]);
                        *(u32x4*)(rowp + bj * HALF) = w; } } }
    }
};
__device__ __forceinline__ unsigned pk4_fp8(float a, float b, float c, float d) {
    a = fminf(fmaxf(a, -448.f), 448.f); b = fminf(fmaxf(b, -448.f), 448.f); c = fminf(fmaxf(c, -448.f), 448.f); d = fminf(fmaxf(d, -448.f), 448.f);
    int p = __builtin_amdgcn_cvt_pk_fp8_f32(a, b, 0, false); p = __builtin_amdgcn_cvt_pk_fp8_f32(c, d, p, true); return (unsigned)p;
}
struct EpiSwiglu8 {
    static constexpr bool PERM = true, AFTER_DRAIN = false, MIDK = false; static constexpr int MID0 = -1, MID1 = -1;
    unsigned char* O; int ldc; int nct; float k1, cden;
    __device__ __forceinline__ void operator()(const f32x4 (&acc)[2][2][4][2], const Unit& u, int wr, int wc, int fr, int fq) const {
        const int row0 = u.pm * BM + wr * 64 + fr, col0 = (u.pn % nct) * HALF + wc * 32 + 8 * fq;
#pragma unroll
        for (int ai = 0; ai < 2; ++ai)
#pragma unroll
            for (int m = 0; m < 4; ++m) { unsigned char* rowp = O + (size_t)(row0 + ai * HALF + m * 16) * ldc + col0;
                float r[8];
#pragma unroll
                for (int n = 0; n < 2; ++n)
#pragma unroll
                    for (int h = 0; h < 2; ++h) { const f32x2 g2 = {acc[ai][0][m][n][2 * h], acc[ai][0][m][n][2 * h + 1]}, u2 = {acc[ai][1][m][n][2 * h], acc[ai][1][m][n][2 * h + 1]};
                        const f32x2 t = g2 * k1; const f32x2 ex = {__builtin_amdgcn_exp2f(t.x), __builtin_amdgcn_exp2f(t.y)}; const f32x2 d = ex * cden + cden;
                        const f32x2 rr = {__builtin_amdgcn_rcpf(d.x), __builtin_amdgcn_rcpf(d.y)}; const f32x2 o = (g2 * u2) * rr; r[n * 4 + 2 * h] = o.x; r[n * 4 + 2 * h + 1] = o.y; }
                typedef unsigned u32x2v __attribute__((ext_vector_type(2))); u32x2v w; w.x = pk4_fp8(r[0], r[1], r[2], r[3]); w.y = pk4_fp8(r[4], r[5], r[6], r[7]);
                *(u32x2v*)rowp = w; }
    }
};
struct EpiMoeDown {
    static constexpr bool PERM = true, AFTER_DRAIN = false, MIDK = false; static constexpr int MID0 = -1, MID1 = -1;
    bf16_t* O; int ldc; int nct; bf16_t* O2; float scale;
    __device__ __forceinline__ void operator()(const f32x4 (&acc)[2][2][4][2], const Unit& u, int wr, int wc, int fr, int fq) const {
        const bool second = u.aux >= 0;
        bf16_t* base = second ? O2 + (size_t)u.aux * 65536 + (size_t)(wr * 64 + fr) * 256 + wc * 32 + 8 * fq
                              : O + (size_t)(u.pm * BM + wr * 64 + fr) * ldc + (u.pn % nct) * BM + wc * 32 + 8 * fq;
        const int ld = second ? 256 : ldc;
#pragma unroll
        for (int ai = 0; ai < 2; ++ai)
#pragma unroll
            for (int m = 0; m < 4; ++m) { bf16_t* rowp = base + (size_t)(ai * HALF + m * 16) * ld;
#pragma unroll
                for (int bj = 0; bj < 2; ++bj) { const f32x4 v0 = acc[ai][bj][m][0] * scale, v1 = acc[ai][bj][m][1] * scale;
                    u32x4 w; w.x = cvt_pk_bf16(v0[0], v0[1]); w.y = cvt_pk_bf16(v0[2], v0[3]); w.z = cvt_pk_bf16(v1[0], v1[1]); w.w = cvt_pk_bf16(v1[2], v1[3]);
                    *(u32x4*)(rowp + bj * HALF) = w; } }
    }
};
template <int NORMOUT, bool BASE16> struct EpiResid {
    static constexpr bool PERM = true, AFTER_DRAIN = false, MIDK = false; static constexpr int MID0 = -1, MID1 = -1;
    const void* base; bf16_t* hb; int ldc; float* ssp; unsigned char* hb8; float hb8_scale; float ascale;
    __device__ __forceinline__ void row_out(const f32x4 (&o)[2][2], size_t off, int r, int pn, int wc, int fq) const {
        float q = 0.f;
#pragma unroll
        for (int bj = 0; bj < 2; ++bj) { const f32x4 o0 = o[bj][0], o1 = o[bj][1];
            if (NORMOUT & 1) q += ((o0[0] * o0[0] + o0[1] * o0[1]) + (o0[2] * o0[2] + o0[3] * o0[3])) + ((o1[0] * o1[0] + o1[1] * o1[1]) + (o1[2] * o1[2] + o1[3] * o1[3]));
            u32x4 w; w.x = cvt_pk_bf16(o0[0], o0[1]); w.y = cvt_pk_bf16(o0[2], o0[3]); w.z = cvt_pk_bf16(o1[0], o1[1]); w.w = cvt_pk_bf16(o1[2], o1[3]); *(u32x4*)(hb + off + bj * HALF) = w;
            if (NORMOUT & 2) { typedef unsigned u32x2v __attribute__((ext_vector_type(2))); u32x2v w8; w8.x = pk4_fp8(o0[0] * hb8_scale, o0[1] * hb8_scale, o0[2] * hb8_scale, o0[3] * hb8_scale); w8.y = pk4_fp8(o1[0] * hb8_scale, o1[1] * hb8_scale, o1[2] * hb8_scale, o1[3] * hb8_scale); *(u32x2v*)(hb8 + off + bj * HALF) = w8; } }
        if (NORMOUT & 1) { q = sum_fq(q); if (fq == 0) ssp[(size_t)r * 16 + 4 * pn + wc] = q; }
    }
    __device__ __forceinline__ void operator()(const f32x4 (&acc)[2][2][4][2], const Unit& u, int wr, int wc, int fr, int fq) const {
        const int row0 = u.pm * BM + wr * 64 + fr, col0 = u.pn * BM + wc * 32 + 8 * fq;
        if constexpr (BASE16) { const bf16_t* b16 = (const bf16_t*)base;
#pragma unroll
            for (int ai = 0; ai < 2; ++ai) { u32x4 bs[4][2];
#pragma unroll
                for (int m = 0; m < 4; ++m)
#pragma unroll
                    for (int bj = 0; bj < 2; ++bj) bs[m][bj] = *(const u32x4*)(b16 + (size_t)(row0 + ai * HALF + m * 16) * ldc + col0 + bj * HALF);
#pragma unroll
                for (int m = 0; m < 4; ++m) { const int r = row0 + ai * HALF + m * 16; f32x4 o[2][2];
#pragma unroll
                    for (int bj = 0; bj < 2; ++bj) { const u32x4 b = bs[m][bj];
                        o[bj][0] = (f32x4){bfl(b.x), bfh(b.x), bfl(b.y), bfh(b.y)} + acc[ai][bj][m][0] * ascale; o[bj][1] = (f32x4){bfl(b.z), bfh(b.z), bfl(b.w), bfh(b.w)} + acc[ai][bj][m][1] * ascale; }
                    row_out(o, (size_t)r * ldc + col0, r, u.pn, wc, fq); }
                asm volatile("" ::: "memory"); }
        } else { const float* b32 = (const float*)base;
#pragma unroll
            for (int ai = 0; ai < 2; ++ai)
#pragma unroll
                for (int mp = 0; mp < 2; ++mp) { f32x4 bs[2][2][2];
#pragma unroll
                    for (int mm = 0; mm < 2; ++mm) { const size_t off = (size_t)(row0 + ai * HALF + (2 * mp + mm) * 16) * ldc + col0;
#pragma unroll
                        for (int bj = 0; bj < 2; ++bj)
#pragma unroll
                            for (int n = 0; n < 2; ++n) bs[mm][bj][n] = *(const f32x4*)(b32 + off + bj * HALF + n * 4); }
#pragma unroll
                    for (int mm = 0; mm < 2; ++mm) { const int r = row0 + ai * HALF + (2 * mp + mm) * 16; f32x4 o[2][2];
#pragma unroll
                        for (int bj = 0; bj < 2; ++bj) { o[bj][0] = bs[mm][bj][0] + acc[ai][bj][2 * mp + mm][0] * ascale; o[bj][1] = bs[mm][bj][1] + acc[ai][bj][2 * mp + mm][1] * ascale; }
                        row_out(o, (size_t)r * ldc + col0, r, u.pn, wc, fq); }
                    asm volatile("" ::: "memory"); }
        }
    }
};
template <bool RS, bool OUT8 = false> struct EpiSwiglu {
    static constexpr bool PERM = true, AFTER_DRAIN = false, MIDK = false; static constexpr int MID0 = -1, MID1 = -1;
    bf16_t* O; int ldc; int nct; const float* ssp; const PG8_LAS float* rtab; float out_scale;
    __device__ __forceinline__ void operator()(const f32x4 (&acc)[2][2][4][2], const Unit& u, int wr, int wc, int fr, int fq) const {
        const int row0 = u.pm * BM + wr * 64 + fr, col0 = (u.pn % nct) * HALF + wc * 32 + 8 * fq;
        float rsv[2][4]; if (RS) rstd8(rtab, ssp, u, row0, wr * 64 + fr, fq, rsv);
#pragma unroll
        for (int ai = 0; ai < 2; ++ai)
#pragma unroll
            for (int m = 0; m < 4; ++m) { bf16_t* rowp = O + (size_t)(row0 + ai * HALF + m * 16) * ldc + col0;
                float r[8]; float rs = 1.f; if (RS) rs = rsv[ai][m];
                const float k1 = rs * -1.4426950408889634f, cden = (RS || OUT8) ? __builtin_amdgcn_rcpf(rs * rs * (OUT8 ? out_scale : 1.f)) : 1.f;
#pragma unroll
                for (int n = 0; n < 2; ++n)
#pragma unroll
                    for (int h = 0; h < 2; ++h) { const f32x2 g2 = {acc[ai][0][m][n][2 * h], acc[ai][0][m][n][2 * h + 1]}, u2 = {acc[ai][1][m][n][2 * h], acc[ai][1][m][n][2 * h + 1]};
                        const f32x2 t = g2 * k1; const f32x2 ex = {__builtin_amdgcn_exp2f(t.x), __builtin_amdgcn_exp2f(t.y)}; const f32x2 d = ex * cden + cden;
                        const f32x2 rr = {__builtin_amdgcn_rcpf(d.x), __builtin_amdgcn_rcpf(d.y)}; const f32x2 o = (g2 * u2) * rr; r[n * 4 + 2 * h] = o.x; r[n * 4 + 2 * h + 1] = o.y; }
                if constexpr (OUT8) { typedef unsigned u32x2v __attribute__((ext_vector_type(2))); u32x2v w; w.x = pk4_fp8(r[0], r[1], r[2], r[3]); w.y = pk4_fp8(r[4], r[5], r[6], r[7]);
                    *(u32x2v*)((unsigned char*)O + (size_t)(row0 + ai * HALF + m * 16) * ldc + col0) = w; }
                else { u32x4 w; w.x = cvt_pk_bf16(r[0], r[1]); w.y = cvt_pk_bf16(r[2], r[3]); w.z = cvt_pk_bf16(r[4], r[5]); w.w = cvt_pk_bf16(r[6], r[7]);
                    *(u32x4*)rowp = w; } }
    }
};
struct EpiBranch {
    static constexpr bool PERM = true, AFTER_DRAIN = false, MIDK = true; static constexpr int MID0 = 8, MID1 = 12;
    const bf16_t* G; int ldg; bf16_t* O; int ldc;
    __device__ __forceinline__ void mid(f32x4 (&acc)[2][2][4][2], const Unit& u, int t, int wr, int wc, int fr, int fq) const {
        int row0 = u.pm * BM + wr * 64 + fr, col0 = u.pn * BM + wc * 32 + 8 * fq;
        asm volatile("" : "+v"(row0), "+v"(col0));
        const bf16_t* gp = G + (t == MID0 ? 0 : 1024);
        u32x4 ld_[2][2][2], ln_[2][2][2];
#define BR_LOAD(bf, ai, mp) do { _Pragma("unroll") for (int mm = 0; mm < 2; ++mm) { const bf16_t* rp = gp + (size_t)(row0 + (ai) * HALF + (2 * (mp) + mm) * 16) * ldg + col0; \
            _Pragma("unroll") for (int bj = 0; bj < 2; ++bj) { ld_[bf][mm][bj] = *(const u32x4*)(rp + bj * HALF); ln_[bf][mm][bj] = *(const u32x4*)(rp + bj * HALF + 1024); } } } while (0)
#define BR_APPLY(bf, ai, mp) do { _Pragma("unroll") for (int mm = 0; mm < 2; ++mm) _Pragma("unroll") for (int bj = 0; bj < 2; ++bj) _Pragma("unroll") for (int q = 0; q < 4; ++q) { \
            const unsigned dw = ld_[bf][mm][bj][q], nw = ln_[bf][mm][bj][q];        \
            const f32x2 rd = {__builtin_amdgcn_rcpf(bfl(dw)), __builtin_amdgcn_rcpf(bfh(dw))}, nm = {bfl(nw), bfh(nw)}; const f32x2 ra = nm * rd; \
            acc[ai][bj][2 * (mp) + mm][q >> 1][2 * (q & 1)] *= ra.x; acc[ai][bj][2 * (mp) + mm][q >> 1][2 * (q & 1) + 1] *= ra.y; } } while (0)
        BR_LOAD(0, 0, 0); BR_LOAD(1, 0, 1); asm volatile("" ::: "memory");
        BR_APPLY(0, 0, 0); asm volatile("" ::: "memory"); BR_LOAD(0, 1, 0); asm volatile("" ::: "memory");
        BR_APPLY(1, 0, 1); asm volatile("" ::: "memory"); BR_LOAD(1, 1, 1); asm volatile("" ::: "memory");
        BR_APPLY(0, 1, 0); asm volatile("" ::: "memory"); BR_APPLY(1, 1, 1); asm volatile("" ::: "memory");
#undef BR_LOAD
#undef BR_APPLY
    }
    __device__ __forceinline__ void operator()(const f32x4 (&acc)[2][2][4][2], const Unit& u, int wr, int wc, int fr, int fq) const {
        const int row0 = u.pm * BM + wr * 64 + fr, col0 = u.pn * BM + wc * 32 + 8 * fq;
        u32x4 l2[2][2][2];
#define BR_LOAD(bf, ai, mp) do { _Pragma("unroll") for (int mm = 0; mm < 2; ++mm) _Pragma("unroll") for (int bj = 0; bj < 2; ++bj) \
            l2[bf][mm][bj] = *(const u32x4*)(G + 2048 + (size_t)(row0 + (ai) * HALF + (2 * (mp) + mm) * 16) * ldg + col0 + bj * HALF); } while (0)
#define BR_APPLY(bf, ai, mp) do { _Pragma("unroll") for (int mm = 0; mm < 2; ++mm) _Pragma("unroll") for (int bj = 0; bj < 2; ++bj) { u32x4 w; \
            _Pragma("unroll") for (int q = 0; q < 4; ++q) { const unsigned dw = l2[bf][mm][bj][q]; const f32x2 rd = {__builtin_amdgcn_rcpf(bfl(dw)), __builtin_amdgcn_rcpf(bfh(dw))}; \
                const f32x2 a2 = {acc[ai][bj][2 * (mp) + mm][q >> 1][2 * (q & 1)], acc[ai][bj][2 * (mp) + mm][q >> 1][2 * (q & 1) + 1]}; const f32x2 o = a2 * rd; w[q] = cvt_pk_bf16(o.x, o.y); } \
            *(u32x4*)(O + (size_t)(row0 + (ai) * HALF + (2 * (mp) + mm) * 16) * ldc + col0 + bj * HALF) = w; } } while (0)
        BR_LOAD(0, 0, 0); BR_LOAD(1, 0, 1); asm volatile("" ::: "memory");
        BR_APPLY(0, 0, 0); asm volatile("" ::: "memory"); BR_LOAD(0, 1, 0); asm volatile("" ::: "memory");
        BR_APPLY(1, 0, 1); asm volatile("" ::: "memory"); BR_LOAD(1, 1, 1); asm volatile("" ::: "memory");
        BR_APPLY(0, 1, 0); asm volatile("" ::: "memory"); BR_APPLY(1, 1, 1);
#undef BR_LOAD
#undef BR_APPLY
    }
};

}

constexpr int NWAVES = 8, NTHR = 512;
constexpr int BATCH = 4, SEQ = 4096, D = 1024, M = BATCH * SEQ, INC = 5632, FF = 3584, NE = 8, NHEAD = 8, HD = 64;
constexpr int C_Q = 0, C_K = 512, C_V = 1024, C_U = 1536, C_CH = 1792, C_CB = 2048, C_CC = 2304, C_G = 2560;
constexpr int MPAD = 2 * M + 2048;
constexpr int NCHUNK = M / 64;
constexpr float EPS = 1e-6f;
constexpr float SB_EXIT = -150.1f;

constexpr size_t MiB = 1u << 20;
constexpr size_t WS_CTL = 0, CTL_ZERO_BYTES = 65536;
constexpr int CW_BAR = 4096, CW_MOECNT = 8192;
constexpr size_t WS_TOPI = 1 * MiB, WS_TOPW = WS_TOPI + 256 * 1024, WS_SLOT = WS_TOPI + 512 * 1024;
constexpr size_t WS_TAB = 2 * MiB, TAB_STRIDE = 512 * 1024, TAB_ABAR = 0, TAB_BBAR = 64 * 1024, TAB_CMATB = 256 * 1024, TAB_BBF = 320 * 1024;
constexpr size_t WS_HB8 = 236 * MiB;
constexpr size_t WS_WING8 = 77 * MiB;
constexpr size_t WS_Y2 = 224 * MiB;
constexpr size_t WS_E = 4 * MiB, WS_SSP = 6 * MiB;
constexpr size_t WS_XNN = 8 * MiB;
constexpr size_t WS_WIN0 = 72 * MiB, WS_WCAT0 = 83 * MiB, WS_WOUT0 = 85 * MiB, WS_WGLU0 = 87 * MiB, WS_WGU0 = 88 * MiB, WS_WD0 = 102 * MiB;
constexpr size_t WS_WIN1 = 109 * MiB, WS_WCAT1 = 120 * MiB, WS_WOUT1 = 122 * MiB, WS_WGLU1 = 124 * MiB;
constexpr size_t WS_LSTRIDE = WS_WIN1 - WS_WIN0;
static_assert(WS_WCAT1 - WS_WCAT0 == WS_LSTRIDE && WS_WOUT1 - WS_WOUT0 == WS_LSTRIDE && WS_WGLU1 - WS_WGLU0 == WS_LSTRIDE, "layer stride");
constexpr size_t WS_YCAT0 = 125 * MiB, WS_MERGED0 = 157 * MiB, WS_XN = 252 * MiB, WS_BIG = 284 * MiB;
constexpr size_t WS_YCAT1 = 72 * MiB, WS_MERGED1 = 460 * MiB;
constexpr size_t WS_XS = 72 * MiB, WS_WMOE = 140 * MiB, WS_WD8 = 196 * MiB, WS_ACTM = 284 * MiB, WS_YS = 404 * MiB, WS_END = 492 * MiB;
constexpr float SC_XS = 4.f, SC_W = 64.f, SC_ACT = 8.f;
static_assert(WS_XS + (size_t)MPAD * D <= WS_WIN1 && WS_WMOE + (size_t)NE * 2 * FF * D <= WS_WD8 && WS_WD8 + (size_t)NE * FF * D <= 224 * MiB && WS_ACTM + (size_t)MPAD * FF <= WS_YS && WS_YS + (size_t)MPAD * D * 2 <= WS_END, "MoE map");
static_assert(WS_BIG + (size_t)M * INC * 2 <= WS_END && WS_XN + (size_t)M * D * 2 <= WS_BIG && WS_MERGED0 + (size_t)M * D * 2 <= WS_XN && WS_MERGED1 + (size_t)M * D * 2 <= WS_END && WS_YCAT1 + (size_t)M * D * 2 <= WS_WIN1, "mixer map");

constexpr int RING_BYTES = 131072, MISC_OFF = RING_BYTES, LDS_BYTES = 147456;

#define LAS __attribute__((address_space(3)))
#ifndef TP_A
#define TP_A -2
#define TP_B -2
#endif
#define TP_MUL 8
__device__ __forceinline__ void tp_stamp(LAS unsigned char* lds, int k) {
    if (TP_A == -2) return;
    if (threadIdx.x == 0 && blockIdx.x == 0) { if (k == TP_A) *(volatile LAS long long*)(lds + 140288) = wall_clock64(); if (k == TP_B) *(volatile LAS long long*)(lds + 140296) = wall_clock64(); }
}
typedef unsigned short bf16;
typedef unsigned v4u __attribute__((ext_vector_type(4)));
typedef unsigned v2u __attribute__((ext_vector_type(2)));
typedef float f32x4 __attribute__((ext_vector_type(4)));
typedef float f32x16 __attribute__((ext_vector_type(16)));
typedef float f32x2v __attribute__((ext_vector_type(2)));
typedef short bf16x8 __attribute__((ext_vector_type(8)));
#define RLX_AGENT __ATOMIC_RELAXED, __HIP_MEMORY_SCOPE_AGENT
#define LDS_WAIT() asm volatile("s_waitcnt lgkmcnt(0)" ::: "memory")
__device__ __forceinline__ float bfl(unsigned w) { return __uint_as_float(w << 16); }
__device__ __forceinline__ float bfh(unsigned w) { return __uint_as_float(w & 0xffff0000u); }
__device__ __forceinline__ float bf2f(bf16 x) { return __uint_as_float(((unsigned)x) << 16); }
typedef float f32x2c __attribute__((ext_vector_type(2))); typedef __bf16 bf16x2c __attribute__((ext_vector_type(2)));
__device__ __forceinline__ unsigned pk2(float lo, float hi) { const f32x2c v = {lo, hi}; return __builtin_bit_cast(unsigned, __builtin_convertvector(v, bf16x2c)); }
__device__ __forceinline__ unsigned f2bf(float f) { return pk2(f, f) & 0xffffu; }
__device__ __forceinline__ float wave_sum(float v) {
#pragma unroll
    for (int o = 1; o < 64; o <<= 1) v += __shfl_xor(v, o);
    return v;
}

#define XB_TMO      128
#define XB_XCNT(j)  (256  + 64 * (j))
#define XB_XSUB(j)  (1280 + 64 * (j))
#define XB_XGEN(j)  (2304 + 64 * (j))
#define XB_TOP      3328
#define XB_TOPGEN   3392
#define XCD_BAR_WORDS 3456
#define XB_SPIN_CAP (1u << 18)
__device__ __forceinline__ unsigned xb_ld(unsigned* p)              { return __hip_atomic_load(p, __ATOMIC_RELAXED, __HIP_MEMORY_SCOPE_AGENT); }
__device__ __forceinline__ unsigned xb_add(unsigned* p, unsigned v) { return __hip_atomic_fetch_add(p, v, __ATOMIC_RELAXED, __HIP_MEMORY_SCOPE_AGENT); }
__device__ __forceinline__ unsigned xb_xcc_id() { return (unsigned)__builtin_amdgcn_s_getreg((3 << 11) | 20) & 0xFu; }
#define XB_SPIN(cond, bar) do { unsigned _sp = 0; while (cond) { __builtin_amdgcn_s_sleep(1); \
    if ((++_sp & 255u) == 0u) { if (xb_ld(&(bar)[XB_TMO])) break; if (_sp > XB_SPIN_CAP) { atomicAdd(&(bar)[XB_TMO], 1u); break; } } } } while (0)
struct XcdBarrier { unsigned* bar; unsigned x; volatile LAS unsigned* st; };
__device__ __forceinline__ XcdBarrier xcd_barrier_post(unsigned* bar, volatile LAS unsigned* st) {
    XcdBarrier b; b.bar = bar; b.x = xb_xcc_id(); b.st = st;
    if (threadIdx.x == 0) (void)xb_add(&bar[XB_XCNT(b.x)], 1u);
    return b;
}
__device__ __forceinline__ void xcd_barrier_complete(unsigned* bar, unsigned x, unsigned& nloc, unsigned& nx) {
    const unsigned G = gridDim.x * gridDim.y * gridDim.z;
    unsigned sum, cnt, mine, sp = 0u;
    for (;;) {
        sum = 0u; cnt = 0u; mine = 0u;
#pragma unroll
        for (unsigned j = 0; j < 16; ++j) { const unsigned c = xb_ld(&bar[XB_XCNT(j)]); sum += c; cnt += (c > 0u) ? 1u : 0u; mine = (j == x) ? c : mine; }
        if (sum == G) break;
        __builtin_amdgcn_s_sleep(1);
        if ((++sp & 255u) == 0u) { if (xb_ld(&bar[XB_TMO])) break; if (sp > XB_SPIN_CAP) { atomicAdd(&bar[XB_TMO], 1u); break; } }
    }
    nloc = mine > 0u ? mine : 1u; nx = cnt > 0u ? cnt : 1u;
}
__device__ __forceinline__ void xcd_barrier(const XcdBarrier& b) {
    asm volatile("s_waitcnt vmcnt(0)" ::: "memory");
    __syncthreads();
    if (threadIdx.x == 0) {
        unsigned* bar = b.bar;
        __builtin_amdgcn_s_waitcnt(0);
        unsigned nloc = b.st[0], nx = b.st[1];
        if (nloc == 0u) { xcd_barrier_complete(bar, b.x, nloc, nx); b.st[0] = nloc; b.st[1] = nx; }
        const unsigned old = xb_add(&bar[XB_XSUB(b.x)], 1u);
        const unsigned gen = old / nloc;
        if (old + 1u == (gen + 1u) * nloc) {
            __builtin_amdgcn_fence(__ATOMIC_RELEASE, "agent");
            asm volatile("s_waitcnt vmcnt(0)" ::: "memory");
            const unsigned og = xb_add(&bar[XB_TOP], 1u);
            const unsigned tg = og / nx;
            if (og + 1u == (tg + 1u) * nx) xb_add(&bar[XB_TOPGEN], 1u);
            else XB_SPIN(xb_ld(&bar[XB_TOPGEN]) == tg, bar);
            __builtin_amdgcn_fence(__ATOMIC_ACQUIRE, "agent");
            xb_add(&bar[XB_XGEN(b.x)], 1u);
            asm volatile("s_waitcnt vmcnt(0)" ::: "memory");
        } else {
            XB_SPIN(xb_ld(&bar[XB_XGEN(b.x)]) == gen, bar);
            __builtin_amdgcn_fence(__ATOMIC_ACQUIRE, "agent");
            asm volatile("s_waitcnt vmcnt(0)" ::: "memory");
        }
    }
    __syncthreads();
}

struct Args { const float* in[26]; float* out; unsigned char* ws; int ph_lo, ph_hi; };
enum InIdx { I_X = 0, I_NORM_MIX, I_W_IN, I_LAM_RE, I_LAM_IM, I_LOG_DT, I_B_RE, I_B_IM, I_C_RE, I_C_IM, I_SSM_D, I_W_GLU, I_CONV_W, I_W_BR_A, I_W_BR_B, I_W_BR_C, I_W_OUT,
             I_NORM_FFN, I_DW_GATE, I_DW_UP, I_DW_DOWN, I_ROUTER, I_MW_GATE, I_MW_UP, I_MW_DOWN, I_FINAL_NORM };
struct Frame {
    LAS unsigned char* lds;
    unsigned* ctl;
    unsigned char* ws;
    const float* const* in;
    float* out;
    int tid, lane, wave, vcu, G;
    size_t ycat_off;
};

struct CvtJob { const float* src; bf16* dst; int K, N, ld, koff, mode; const float* gain; int fp8; int src_ld, c0; };
__device__ __forceinline__ CvtJob get_job(const Frame& F, int j) {
    CvtJob J; J.koff = 0; J.mode = 0; J.gain = nullptr; J.fp8 = 0; J.src_ld = 0; J.c0 = 0;
    if (j >= 39) { const int l = j - 39;
        J.src = F.in[I_W_IN] + (size_t)l * D * INC; J.K = D; J.N = INC - C_G; J.src_ld = INC; J.c0 = C_G; J.dst = (bf16*)(F.ws + WS_WING8 + (size_t)l * WS_LSTRIDE); J.ld = D; J.gain = F.in[I_NORM_MIX] + l * D; J.fp8 = 1; return J; }
    if (j < 12) { const int l = j / 6, r = j % 6; unsigned char* wl = F.ws + (size_t)l * WS_LSTRIDE;
        if (r == 0)      { J.src = F.in[I_W_IN] + (size_t)l * D * INC;   J.K = D;   J.N = C_G; J.src_ld = INC; J.dst = (bf16*)(wl + WS_WIN0);  J.ld = D; J.gain = F.in[I_NORM_MIX] + l * D; }
        else if (r == 1) { J.src = F.in[I_W_BR_A] + (size_t)l * 512 * D; J.K = 512; J.N = D;   J.dst = (bf16*)(wl + WS_WCAT0); J.ld = D; }
        else if (r == 2) { J.src = F.in[I_W_BR_B] + (size_t)l * 256 * D; J.K = 256; J.N = D;   J.dst = (bf16*)(wl + WS_WCAT0); J.ld = D; J.koff = 512; }
        else if (r == 3) { J.src = F.in[I_W_BR_C] + (size_t)l * 256 * D; J.K = 256; J.N = D;   J.dst = (bf16*)(wl + WS_WCAT0); J.ld = D; J.koff = 768; }
        else if (r == 4) { J.src = F.in[I_W_OUT] + (size_t)l * D * D;    J.K = D;   J.N = D;   J.dst = (bf16*)(wl + WS_WOUT0); J.ld = D; }
        else             { J.src = F.in[I_W_GLU] + (size_t)l * 256 * 256; J.K = 256; J.N = 256; J.dst = (bf16*)(wl + WS_WGLU0); J.ld = 256; }
    } else if (j == 12) { J.src = F.in[I_DW_GATE]; J.K = D; J.N = FF; J.dst = (bf16*)(F.ws + WS_WGU0); J.ld = D; J.mode = 1; J.gain = F.in[I_NORM_FFN]; }
    else if (j == 13)   { J.src = F.in[I_DW_UP];   J.K = D; J.N = FF; J.dst = (bf16*)(F.ws + WS_WGU0); J.ld = D; J.mode = 2; J.gain = F.in[I_NORM_FFN]; }
    else if (j == 14)   { J.src = F.in[I_DW_DOWN]; J.K = FF; J.N = D; J.dst = (bf16*)(F.ws + WS_WD0);  J.ld = FF; J.fp8 = 1; }
    else if (j < 31)    { const int e = (j - 15) >> 1, up = (j - 15) & 1; const float* sg = F.in[I_MW_GATE]; const float* su = F.in[I_MW_UP]; J.src = (up ? su : sg) + (size_t)e * D * FF; J.K = D; J.N = FF;
                          J.dst = (bf16*)(F.ws + WS_WMOE + (size_t)e * 2 * FF * D); J.ld = D; J.mode = 1 + up; J.fp8 = 1; }
    else                { const int e = j - 31; J.src = F.in[I_MW_DOWN] + (size_t)e * FF * D; J.K = FF; J.N = D; J.dst = (bf16*)(F.ws + WS_WD8 + (size_t)e * D * FF); J.ld = FF; J.fp8 = 1; }
    if (!J.src_ld) J.src_ld = J.N;
    return J;
}
__device__ __forceinline__ void cvt_load(const CvtJob& J, int item, int lane, f32x4 (&ld)[16]) {
    const int nblk = J.N / 64, kb = item / nblk, nb = item % nblk;
    const float* p = J.src + (size_t)(64 * kb + (lane >> 4)) * J.src_ld + J.c0 + 64 * nb + (lane & 15) * 4;
#pragma unroll
    for (int i = 0; i < 16; ++i) ld[i] = *(const f32x4*)(p + (size_t)(4 * i) * J.src_ld);
}
__device__ __forceinline__ void cvt_to_lds(const CvtJob& J, int item, int lane, f32x4 (&ld)[16], LAS float* scr) {
    const int nblk = J.N / 64, kb = item / nblk, k0 = 64 * kb;
    if (J.gain) {
#pragma unroll
        for (int i = 0; i < 16; ++i) ld[i] = ld[i] * J.gain[k0 + (lane >> 4) + 4 * i]; }
#pragma unroll
    for (int i = 0; i < 16; ++i) { const int k = (lane >> 4) + 4 * i; *(LAS f32x4*)(scr + k * 64 + 4 * ((lane & 15) ^ (((k >> 3) ^ k) & 7))) = ld[i]; }
    LDS_WAIT(); asm volatile("" ::: "memory");
}
__device__ __forceinline__ void cvt_store(const CvtJob& J, int item, int lane, const LAS float* scr) {
    const int nblk = J.N / 64, kb = item / nblk, nb = item % nblk, k0 = 64 * kb, n0 = 64 * nb;
    const int drow0 = (J.mode == 0) ? n0 : ((n0 >> 7) * 256 + (n0 & 127) + (J.mode == 2 ? 128 : 0));
    const int c = lane & 7;
#pragma unroll
    for (int j = 0; j < 8; ++j) { const int n = (lane >> 3) + 8 * j; float v[8];
#pragma unroll
        for (int q = 0; q < 8; ++q) v[q] = scr[(8 * c + q) * 64 + 4 * ((n >> 2) ^ ((c ^ q) & 7)) + (n & 3)];
        if (J.fp8) { v2u o8; o8.x = pg8::pk4_fp8(v[0] * SC_W, v[1] * SC_W, v[2] * SC_W, v[3] * SC_W); o8.y = pg8::pk4_fp8(v[4] * SC_W, v[5] * SC_W, v[6] * SC_W, v[7] * SC_W);
            *(v2u*)((unsigned char*)J.dst + (size_t)(drow0 + n) * J.ld + J.koff + k0 + 8 * c) = o8; }
        else { v4u o; o.x = pk2(v[0], v[1]); o.y = pk2(v[2], v[3]); o.z = pk2(v[4], v[5]); o.w = pk2(v[6], v[7]);
            *(v4u*)(J.dst + (size_t)(drow0 + n) * J.ld + J.koff + k0 + 8 * c) = o; } }
    LDS_WAIT(); asm volatile("" ::: "memory");
}
struct CvtCursor { int j, base, n; CvtJob J; };
__device__ __forceinline__ bool cvt_advance(const Frame& F, CvtCursor& C, int jb, int jc, int jd, int flat, int& item) {
    while (flat - C.base >= C.n) { C.base += C.n; ++C.j; if (C.j == jb) C.j = jc; if (C.j >= jd) { C.n = 0x3fffffff; return false; } C.J = get_job(F, C.j); C.n = (C.J.K / 64) * (C.J.N / 64); }
    item = flat - C.base; return true;
}
__device__ __forceinline__ void convert_jobs(const Frame& F, int ja, int jb, int jc, int jd, int widx, int nw) {
    if (widx < 0) return;
    LAS float* scr = (LAS float*)(F.lds + F.wave * 16384);
    CvtCursor C; C.j = (ja < jb) ? ja : jc; if (C.j >= jd) return; C.base = 0; C.J = get_job(F, C.j); C.n = (C.J.K / 64) * (C.J.N / 64);
    int flat = widx, itc = 0; bool ok = cvt_advance(F, C, jb, jc, jd, flat, itc);
    CvtJob Jc = C.J; f32x4 ld[16];
    if (ok) cvt_load(Jc, itc, F.lane, ld);
    while (ok) {
        cvt_to_lds(Jc, itc, F.lane, ld, scr);
        flat += nw; int itn = 0; const bool okn = cvt_advance(F, C, jb, jc, jd, flat, itn); const CvtJob Jn = C.J;
        if (okn) cvt_load(Jn, itn, F.lane, ld);
        asm volatile("" ::: "memory");
        cvt_store(Jc, itc, F.lane, scr);
        Jc = Jn; itc = itn; ok = okn;
    }
}
__device__ __forceinline__ void convert_jobs(const Frame& F, int jlo, int jhi, int widx, int nw) { convert_jobs(F, jlo, jhi, jhi, jhi, widx, nw); }

__device__ __forceinline__ void ssm_tables(const Frame& F, int gt, int NT) {
    for (int i = gt; i < 2 * 16 * 64; i += NT) {
        const int l = i >> 10, g = (i >> 6) & 15, p = i & 63;
        unsigned char* tab = F.ws + WS_TAB + (size_t)l * TAB_STRIDE;
        const float lr = fminf(F.in[I_LAM_RE][i], -1e-4f), li = F.in[I_LAM_IM][i], dt = expf(F.in[I_LOG_DT][l * 16 + g]);
        const float mag = expf(lr * dt), ar = mag * cosf(li * dt), ai = mag * sinf(li * dt);
        const float den = lr * lr + li * li, nr = ar - 1.0f, ni = ai;
        const float fr = (nr * lr + ni * li) / den, fi = (ni * lr - nr * li) / den;
        const double ang = (double)li * (double)dt * 64.0; const double rev = ang * 0.15915494309189535; const float rf = (float)((rev - rint(rev)) * 6.283185307179586);
        const float magT = expf(64.0f * lr * dt);
        ((f32x4*)(tab + TAB_ABAR))[g * 64 + p] = (f32x4){ar, ai, magT * cosf(rf), magT * sinf(rf)};
        float* bb = (float*)(tab + TAB_BBAR) + (size_t)(g * 64 + p) * 32;
        const float* bre = F.in[I_B_RE] + (size_t)i * 16; const float* bim = F.in[I_B_IM] + (size_t)i * 16;
#pragma unroll
        for (int h = 0; h < 16; ++h) { const float br = bre[h], bi = bim[h]; bb[2 * h] = fr * br - fi * bi; bb[2 * h + 1] = fr * bi + fi * br; }
    }
    for (int i = gt; i < 2 * 16 * 8 * 64; i += NT) {
        const int l = i >> 13, g = (i >> 9) & 15, cbk = (i >> 6) & 7, ln = i & 63;
        const int c = cbk * 16 + (ln & 15), p = c >> 1, ri = c & 1, kh = ln >> 4;
        unsigned w[4] = {0u, 0u, 0u, 0u};
        if (kh < 2) {
            const int idx = (l * 16 + g) * 64 + p;
            const float lr = fminf(F.in[I_LAM_RE][idx], -1e-4f), li = F.in[I_LAM_IM][idx], dt = expf(F.in[I_LOG_DT][l * 16 + g]);
            const float mag = expf(lr * dt), ar = mag * cosf(li * dt), ai = mag * sinf(li * dt);
            const float den = lr * lr + li * li, nr = ar - 1.0f, ni = ai;
            const float fr = (nr * lr + ni * li) / den, fi = (ni * lr - nr * li) / den;
            const float* bre = F.in[I_B_RE] + (size_t)idx * 16 + 8 * kh; const float* bim = F.in[I_B_IM] + (size_t)idx * 16 + 8 * kh;
            float v[8];
#pragma unroll
            for (int j = 0; j < 8; ++j) { const float br = bre[j], bi = bim[j]; v[j] = ri ? (fr * bi + fi * br) : (fr * br - fi * bi); }
            w[0] = pk2(v[0], v[1]); w[1] = pk2(v[2], v[3]); w[2] = pk2(v[4], v[5]); w[3] = pk2(v[6], v[7]);
        }
        ((v4u*)(F.ws + WS_TAB + (size_t)l * TAB_STRIDE + TAB_BBF))[i & 8191] = (v4u){w[0], w[1], w[2], w[3]};
    }
    for (int i = gt; i < 2 * 16 * 4 * 64; i += NT) {
        const int l = i >> 12, g = (i >> 8) & 15, ks = (i >> 6) & 3, ln = i & 63;
        const int hp = ln & 15;
        const float* cre = F.in[I_C_RE] + ((size_t)(l * 16 + g) * 16 + hp) * 64; const float* cim = F.in[I_C_IM] + ((size_t)(l * 16 + g) * 16 + hp) * 64;
        unsigned w[4];
#pragma unroll
        for (int jj = 0; jj < 4; ++jj) { const int k = ks * 32 + 8 * (ln >> 4) + 2 * jj, p = k >> 1; w[jj] = pk2(cre[p], -cim[p]); }
        ((v4u*)(F.ws + WS_TAB + (size_t)l * TAB_STRIDE + TAB_CMATB))[i & 4095] = (v4u){w[0], w[1], w[2], w[3]};
    }
}

__device__ __forceinline__ void router_fill(const Frame& F) {
    LAS float* wrt = (LAS float*)F.lds; const float* wr = F.in[I_ROUTER];
    for (int i = F.tid; i < D * NE; i += NTHR) wrt[(i & 7) * D + (i >> 3)] = wr[i];
    __syncthreads();
}
template <bool ROUTER>
__device__ __forceinline__ void norm_rows(const Frame& F, const bf16* src, const float* gain, bf16* dst, int gw, int NGW) {
    LAS float* wrt = (LAS float*)F.lds;
    f32x4 gv[4];
#pragma unroll
    for (int j = 0; j < 4; ++j) gv[j] = ((const f32x4*)gain)[F.lane + 64 * j];
    v2u nv[4];
    if (gw < M) {
#pragma unroll
        for (int j = 0; j < 4; ++j) nv[j] = ((const v2u*)(src + (size_t)gw * D) + F.lane)[64 * j]; }
    for (int m = gw; m < M; m += NGW) {
        f32x4 v[4]; float s = 0.f;
#pragma unroll
        for (int j = 0; j < 4; ++j) v[j] = (f32x4){bfl(nv[j].x), bfh(nv[j].x), bfl(nv[j].y), bfh(nv[j].y)};
        if (m + NGW < M) {
#pragma unroll
            for (int j = 0; j < 4; ++j) nv[j] = ((const v2u*)(src + (size_t)(m + NGW) * D) + F.lane)[64 * j]; }
#pragma unroll
        for (int j = 0; j < 4; ++j) s += (v[j].x * v[j].x + v[j].y * v[j].y) + (v[j].z * v[j].z + v[j].w * v[j].w);
        const float rstd = 1.0f / sqrtf(wave_sum(s) * (1.0f / D) + EPS);
        if (ROUTER) { unsigned* o4 = (unsigned*)((unsigned char*)dst + (size_t)m * D) + F.lane;
#pragma unroll
            for (int j = 0; j < 4; ++j) { v[j] = v[j] * rstd * gv[j]; o4[64 * j] = pg8::pk4_fp8(v[j].x * SC_XS, v[j].y * SC_XS, v[j].z * SC_XS, v[j].w * SC_XS); } }
        else { unsigned long long* o8 = (unsigned long long*)(dst + (size_t)m * D) + F.lane;
#pragma unroll
            for (int j = 0; j < 4; ++j) { v[j] = v[j] * rstd * gv[j]; o8[64 * j] = (unsigned long long)pk2(v[j].x, v[j].y) | ((unsigned long long)pk2(v[j].z, v[j].w) << 32); } }
        if (ROUTER) {
            float lg[8];
#pragma unroll
            for (int e = 0; e < 8; ++e) { float a = 0.f;
#pragma unroll
                for (int j = 0; j < 4; ++j) { const f32x4 w = *(const LAS f32x4*)(wrt + e * D + 4 * F.lane + 256 * j); a += (v[j].x * w.x + v[j].y * w.y) + (v[j].z * w.z + v[j].w * w.w); }
                lg[e] = wave_sum(a); }
            if (F.lane == 0) {
                int i1 = 0; float v1 = lg[0];
#pragma unroll
                for (int e = 1; e < 8; ++e) if (lg[e] > v1) { v1 = lg[e]; i1 = e; }
                int i2 = -1; float v2 = -INFINITY;
#pragma unroll
                for (int e = 0; e < 8; ++e) if (e != i1 && lg[e] > v2) { v2 = lg[e]; i2 = e; }
                const float e2 = expf(v2 - v1), w1 = 1.0f / (1.0f + e2);
                ((int2*)(F.ws + WS_TOPI))[m] = make_int2(i1, i2);
                ((float2*)(F.ws + WS_TOPW))[m] = make_float2(w1, e2 * w1);
            }
        }
    }
}

__device__ __forceinline__ void cast_rows(const Frame& F, const float* src, bf16* dst, int gw, int NGW) {
    float* ssp = (float*)(F.ws + WS_SSP);
    f32x4 nv[4];
    if (gw < M) {
#pragma unroll
        for (int j = 0; j < 4; ++j) nv[j] = ((const f32x4*)(src + (size_t)gw * D) + F.lane)[64 * j]; }
    for (int m = gw; m < M; m += NGW) {
        f32x4 v[4]; float s = 0.f;
#pragma unroll
        for (int j = 0; j < 4; ++j) v[j] = nv[j];
        if (m + NGW < M) {
#pragma unroll
            for (int j = 0; j < 4; ++j) nv[j] = ((const f32x4*)(src + (size_t)(m + NGW) * D) + F.lane)[64 * j]; }
#pragma unroll
        for (int j = 0; j < 4; ++j) s += (v[j].x * v[j].x + v[j].y * v[j].y) + (v[j].z * v[j].z + v[j].w * v[j].w);
        s = wave_sum(s);
        unsigned long long* o8 = (unsigned long long*)(dst + (size_t)m * D) + F.lane;
#pragma unroll
        for (int j = 0; j < 4; ++j) o8[64 * j] = (unsigned long long)pk2(v[j].x, v[j].y) | ((unsigned long long)pk2(v[j].z, v[j].w) << 32);
        unsigned* o4 = (unsigned*)(F.ws + WS_HB8 + (size_t)m * D) + F.lane;
#pragma unroll
        for (int j = 0; j < 4; ++j) o4[64 * j] = pg8::pk4_fp8(v[j].x * SC_XS, v[j].y * SC_XS, v[j].z * SC_XS, v[j].w * SC_XS);
        if (F.lane < 16) ssp[(size_t)m * 16 + F.lane] = (F.lane == 0) ? s : 0.f;
    }
}
__device__ __forceinline__ void cfma(float& sr, float& si, float ar, float ai, float br, float bi) {
    float t1, t2, nr, ni; const float nai = -ai;
    asm volatile("v_fma_f32 %0, %1, %2, %3" : "=v"(t1) : "v"(ar), "v"(sr), "v"(br));
    asm volatile("v_fma_f32 %0, %1, %2, %3" : "=v"(nr) : "v"(nai), "v"(si), "v"(t1));
    asm volatile("v_fma_f32 %0, %1, %2, %3" : "=v"(t2) : "v"(ar), "v"(si), "v"(bi));
    asm volatile("v_fma_f32 %0, %1, %2, %3" : "=v"(ni) : "v"(ai), "v"(sr), "v"(t2));
    sr = nr; si = ni;
}
constexpr int BUP = 132;
__device__ __forceinline__ bf16x8 ssm_u_frag(const bf16* proj, int tokb, int g, int lane) {
    bf16x8 a = {0, 0, 0, 0, 0, 0, 0, 0};
    if ((lane >> 4) < 2) a = *(const bf16x8*)(proj + (size_t)(tokb + (lane & 15)) * INC + C_U + g * 16 + 8 * (lane >> 4));
    return a;
}
__device__ __forceinline__ void ssm_bu_block(LAS float* bu, const bf16x8 (&bbf)[8], bf16x8 a, int lane) {
    const int kh = lane >> 4;
#pragma unroll
    for (int cb = 0; cb < 8; ++cb) {
        const pg8::f32x4 d = __builtin_amdgcn_mfma_f32_16x16x32_bf16(a, bbf[cb], (pg8::f32x4){0.f, 0.f, 0.f, 0.f}, 0, 0, 0);
#pragma unroll
        for (int r = 0; r < 4; ++r) bu[(4 * kh + r) * BUP + cb * 16 + (lane & 15)] = d[r];
    }
    LDS_WAIT(); asm volatile("" ::: "memory");
}
#define SSM_STEP(tt_) do { const f32x2v b_ = *(const LAS f32x2v*)(bu + (tt_) * BUP + 2 * p); \
    cfma(sr, si, ab.x, ab.y, b_.x, b_.y); } while (0)

__device__ __forceinline__ void ssm_pass1_unit(const Frame& F, int l, int unit) {
    const bf16* proj = (const bf16*)(F.ws + WS_BIG);
    const unsigned char* tab = F.ws + WS_TAB + (size_t)l * TAB_STRIDE;
    LAS float* bu = (LAS float*)(F.lds + F.wave * (16 * BUP * 4));
    const int p = F.lane, tok0 = unit * 64;
    for (int gi = 0; gi < 2; ++gi) {
        const int g = F.wave * 2 + gi;
        bf16x8 bbf[8];
#pragma unroll
        for (int cb = 0; cb < 8; ++cb) bbf[cb] = ((const bf16x8*)(tab + TAB_BBF))[(g * 8 + cb) * 64 + F.lane];
        const f32x4 ab = ((const f32x4*)(tab + TAB_ABAR))[g * 64 + p];
        bf16x8 af[4];
#pragma unroll
        for (int tb = 0; tb < 4; ++tb) af[tb] = ssm_u_frag(proj, tok0 + tb * 16, g, F.lane);
        float sr = 0.f, si = 0.f;
#pragma unroll
        for (int tb = 0; tb < 4; ++tb) {
            ssm_bu_block(bu, bbf, af[tb], F.lane);
#pragma unroll
            for (int tt = 0; tt < 16; ++tt) SSM_STEP(tt);
        }
        ((float2*)(F.ws + WS_E))[((size_t)unit * 16 + g) * 64 + p] = make_float2(sr, si);
        LDS_WAIT(); asm volatile("" ::: "memory");
    }
}
__device__ __forceinline__ void conv_unit(const Frame& F, int l, int unit) {
    const bf16* proj = (const bf16*)(F.ws + WS_BIG); bf16* ycat = (bf16*)(F.ws + F.ycat_off);
    const float* cw = F.in[I_CONV_W] + (size_t)l * 3 * 256;
    for (int it = F.tid; it < 64 * 32; it += NTHR) {
        const int tt = it >> 5, cg = (it & 31) * 8, tok = unit * 64 + tt, tl = tok & (SEQ - 1);
        const bf16* row = proj + (size_t)tok * INC;
        float u[3][8];
        v4u hv[3], cv[3];
#pragma unroll
        for (int d = 0; d < 3; ++d) { const size_t back = (tl >= d) ? (size_t)d * INC : 0; hv[d] = *(const v4u*)(row - back + C_CH + cg); cv[d] = *(const v4u*)(row - back + C_CC + cg); }
#pragma unroll
        for (int d = 0; d < 3; ++d) {
            const float keep = (tl >= d) ? 1.f : 0.f;
            const unsigned hw[4] = {hv[d].x, hv[d].y, hv[d].z, hv[d].w}, cww[4] = {cv[d].x, cv[d].y, cv[d].z, cv[d].w};
#pragma unroll
            for (int q = 0; q < 4; ++q) { u[d][2 * q] = keep * (bfl(hw[q]) * bfl(cww[q])); u[d][2 * q + 1] = keep * (bfh(hw[q]) * bfh(cww[q])); }
        }
        const v4u bv = *(const v4u*)(row + C_CB + cg); const unsigned bw[4] = {bv.x, bv.y, bv.z, bv.w};
        float o[8];
#pragma unroll
        for (int q = 0; q < 8; ++q) { const float y = cw[cg + q] * u[2][q] + cw[256 + cg + q] * u[1][q] + cw[512 + cg + q] * u[0][q]; const float bg = (q & 1) ? bfh(bw[q >> 1]) : bfl(bw[q >> 1]); o[q] = bg * y; }
        *(v4u*)(ycat + (size_t)tok * D + 768 + cg) = (v4u){pk2(o[0], o[1]), pk2(o[2], o[3]), pk2(o[4], o[5]), pk2(o[6], o[7])};
    }
}
__device__ __forceinline__ int crow(int r, int hi) { return (r & 3) + 8 * (r >> 2) + 4 * hi; }
constexpr int VPITCH = 144;
typedef short v4i16_t __attribute__((ext_vector_type(4)));
__device__ __forceinline__ bf16x8 pack8(float a, float b, float c, float d, float e, float f, float g, float h) {
    v4u w = {pk2(a, b), pk2(c, d), pk2(e, f), pk2(g, h)}; return __builtin_bit_cast(bf16x8, w); }
__device__ __forceinline__ void attn_unit(const Frame& F, int uidx, LAS unsigned char* vl) {
    const int lane = F.lane, r32 = lane & 31, hh = lane >> 5;
    const int bh = uidx >> 7, qb = uidx & 127, b = bh >> 3, h = bh & 7, t0 = qb * 32, tq = t0 + r32;
    const bf16* P = (const bf16*)(F.ws + WS_BIG) + (size_t)b * SEQ * INC;
    bf16* ycat = (bf16*)(F.ws + F.ycat_off);
    bf16x8 qf[4];
#pragma unroll
    for (int ks = 0; ks < 4; ++ks) qf[ks] = *(const bf16x8*)(P + (size_t)tq * INC + C_Q + h * 64 + 16 * ks + 8 * hh);
    f32x16 o0 = {}, o1 = {};
    float carry = 0.f;
    const int trb = ((lane & 15) >> 2) * VPITCH + (16 * ((lane >> 4) & 1) + 4 * (lane & 3)) * 2 + 4 * hh * VPITCH;
    bf16x8 kf0[4], kf1[4];
    v4u vv[8];
    const unsigned vlo = (unsigned)(((lane >> 3) * INC + (lane & 7) * 8) * 2), klo = (unsigned)((r32 * INC + 8 * hh) * 2);
    const char* Pv = (const char*)(P + C_V + h * 64); const char* Pk = (const char*)(P + C_K + h * 64);
#define AT_LOADV(KSB) do { const char* vb_ = Pv + (size_t)(KSB) * (INC * 2); _Pragma("unroll") for (int i = 0; i < 8; ++i) vv[i] = *(const v4u*)(vb_ + (size_t)(8 * i) * (INC * 2) + vlo); } while (0)
#define AT_LOADK(KSB) do { const char* kb_ = Pk + (size_t)(KSB) * (INC * 2); \
            _Pragma("unroll") for (int ks = 0; ks < 4; ++ks) { kf0[ks] = *(const bf16x8*)(kb_ + klo + 32 * ks); kf1[ks] = *(const bf16x8*)(kb_ + (size_t)32 * (INC * 2) + klo + 32 * ks); } } while (0)
    { const int kb0 = t0 - 32 < 0 ? 0 : t0 - 32; AT_LOADV(kb0); AT_LOADK(kb0); }
    for (int kend = t0 + 32; kend > 0; kend -= 64) {
        const int ks0 = kend - 64;
        asm volatile("" : "+v"(vv[0]), "+v"(vv[1]), "+v"(vv[2]), "+v"(vv[3]), "+v"(vv[4]), "+v"(vv[5]), "+v"(vv[6]), "+v"(vv[7]));
#pragma unroll
        for (int i = 0; i < 8; ++i) { const int row = (lane >> 3) + 8 * i; *(LAS v4u*)(vl + row * VPITCH + (lane & 7) * 16) = vv[i]; }
        const int ksb = ks0 < 0 ? 0 : ks0, ksn = ks0 - 64 < 0 ? 0 : ks0 - 64;
        AT_LOADV(ksn); asm volatile("" ::: "memory");
        f32x16 s0 = {}, s1 = {};
#pragma unroll
        for (int ks = 0; ks < 4; ++ks) { s0 = __builtin_amdgcn_mfma_f32_32x32x16_bf16(kf0[ks], qf[ks], s0, 0, 0, 0); s1 = __builtin_amdgcn_mfma_f32_32x32x16_bf16(kf1[ks], qf[ks], s1, 0, 0, 0); }
        asm volatile("" : "+v"(s0), "+v"(s1));
        AT_LOADK(ksn); asm volatile("" ::: "memory");
        f32x16 c0, c1; float tot = 0.f; const int kmax = kend < tq ? kend : tq;
#define SP_ELEM(S, C, I, KEY, MASKED) do { const float z2 = 0.18033688011112042f * S[I]; const float sp = fmaxf(z2, 0.f) + __builtin_amdgcn_logf(1.f + __builtin_amdgcn_exp2f(-fabsf(z2))); \
            if (MASKED) { const bool valid = (KEY) < kmax; C[I] = valid ? (z2 - sp) + carry : -INFINITY; S[I] = valid ? -sp : 0.f; } else { C[I] = (z2 - sp) + carry; S[I] = -sp; } tot += S[I]; } while (0)
        if (ks0 >= 0 && kend <= t0) {
#pragma unroll
            for (int i = 0; i < 16; ++i) SP_ELEM(s1, c1, i, 0, false);
            tot += __shfl_xor(tot, 32); carry += tot; tot = 0.f;
#pragma unroll
            for (int i = 0; i < 16; ++i) SP_ELEM(s0, c0, i, 0, false);
        } else {
#pragma unroll
            for (int i = 0; i < 16; ++i) { const int key1 = ksb + 32 + crow(i, hh); SP_ELEM(s1, c1, i, key1, true); }
            tot += __shfl_xor(tot, 32); carry += tot; tot = 0.f;
#pragma unroll
            for (int i = 0; i < 16; ++i) { const int key0 = ksb + crow(i, hh); SP_ELEM(s0, c0, i, key0, true); }
        }
#undef SP_ELEM
        tot += __shfl_xor(tot, 32); carry += tot;
        {
#define HIW(S, q8) ((v4u){pk2(S[(q8)], S[(q8) + 1]), pk2(S[(q8) + 2], S[(q8) + 3]), pk2(S[(q8) + 4], S[(q8) + 5]), pk2(S[(q8) + 6], S[(q8) + 7])})
#define LOW(S, q8, H) ((v4u){pk2(S[(q8)] - bfl((H).x), S[(q8) + 1] - bfh((H).x)), pk2(S[(q8) + 2] - bfl((H).y), S[(q8) + 3] - bfh((H).y)), pk2(S[(q8) + 4] - bfl((H).z), S[(q8) + 5] - bfh((H).z)), pk2(S[(q8) + 6] - bfl((H).w), S[(q8) + 7] - bfh((H).w))})
#define CUM6(X00, X01, X10, X11) do { c0 = __builtin_amdgcn_mfma_f32_32x32x16_bf16(T0, X00, c0, 0, 0, 0); c0 = __builtin_amdgcn_mfma_f32_32x32x16_bf16(T1, X01, c0, 0, 0, 0); \
            c1 = __builtin_amdgcn_mfma_f32_32x32x16_bf16(T0, X10, c1, 0, 0, 0); c1 = __builtin_amdgcn_mfma_f32_32x32x16_bf16(T1, X11, c1, 0, 0, 0); } while (0)
            bf16x8 T0, T1;
            { int lt = lane; asm volatile("" : "+v"(lt)); const int rt = lt & 31, ht = lt >> 5;
#pragma unroll
              for (int j = 0; j < 8; ++j) { const int ko = 8 * (j >> 2) + 4 * ht + (j & 3); T0[j] = (ko > rt) ? (short)0x3F80 : (short)0; T1[j] = (16 + ko > rt) ? (short)0x3F80 : (short)0; } }
            const v4u h00 = HIW(s0, 0), h01 = HIW(s0, 8), h10 = HIW(s1, 0), h11 = HIW(s1, 8);
            CUM6(__builtin_bit_cast(bf16x8, h00), __builtin_bit_cast(bf16x8, h01), __builtin_bit_cast(bf16x8, h10), __builtin_bit_cast(bf16x8, h11));
            const v4u l00 = LOW(s0, 0, h00), l01 = LOW(s0, 8, h01), l10 = LOW(s1, 0, h10), l11 = LOW(s1, 8, h11);
            CUM6(__builtin_bit_cast(bf16x8, l00), __builtin_bit_cast(bf16x8, l01), __builtin_bit_cast(bf16x8, l10), __builtin_bit_cast(bf16x8, l11));
#undef HIW
#undef LOW
#undef CUM6
        }
#pragma unroll
        for (int i = 0; i < 16; ++i) { c0[i] = __builtin_amdgcn_exp2f(c0[i]); c1[i] = __builtin_amdgcn_exp2f(c1[i]); }
#pragma unroll
        for (int kq = 0; kq < 4; ++kq) {
            const bf16x8 wa = (kq & 2) ? pack8(c1[8 * (kq & 1)], c1[8 * (kq & 1) + 1], c1[8 * (kq & 1) + 2], c1[8 * (kq & 1) + 3], c1[8 * (kq & 1) + 4], c1[8 * (kq & 1) + 5], c1[8 * (kq & 1) + 6], c1[8 * (kq & 1) + 7])
                                       : pack8(c0[8 * (kq & 1)], c0[8 * (kq & 1) + 1], c0[8 * (kq & 1) + 2], c0[8 * (kq & 1) + 3], c0[8 * (kq & 1) + 4], c0[8 * (kq & 1) + 5], c0[8 * (kq & 1) + 6], c0[8 * (kq & 1) + 7]);
#pragma unroll
            for (int db = 0; db < 2; ++db) {
                LAS unsigned char* vp = vl + trb + 16 * kq * VPITCH + 64 * db;
                const v4i16_t lo = __builtin_amdgcn_ds_read_tr16_b64_v4i16((LAS v4i16_t*)vp), hi = __builtin_amdgcn_ds_read_tr16_b64_v4i16((LAS v4i16_t*)(vp + 8 * VPITCH));
                const bf16x8 vf = {lo[0], lo[1], lo[2], lo[3], hi[0], hi[1], hi[2], hi[3]};
                if (db == 0) o0 = __builtin_amdgcn_mfma_f32_32x32x16_bf16(wa, vf, o0, 0, 0, 0); else o1 = __builtin_amdgcn_mfma_f32_32x32x16_bf16(wa, vf, o1, 0, 0, 0);
            }
        }
        if (__all(carry < SB_EXIT)) break;
    }
#undef AT_LOADV
#undef AT_LOADK
    int lz = lane; asm volatile("" : "+v"(lz));
    bf16* op = ycat + (size_t)(b * SEQ + t0 + 4 * (lz >> 5)) * D + h * 64 + (lz & 31);
#pragma unroll
    for (int i = 0; i < 16; ++i) { const int q = crow(i, 0); op[(size_t)q * D] = (bf16)f2bf(o0[i]); op[(size_t)q * D + 32] = (bf16)f2bf(o1[i]); }
    LDS_WAIT(); asm volatile("" ::: "memory");
}
__device__ __forceinline__ void mixer_b(const Frame& F, int l, int nrep_s, int nrep_a) {
    for (int rep = 0; rep < nrep_s; ++rep)
    for (int u = blockIdx.x; u < NCHUNK; u += F.G) { ssm_pass1_unit(F, l, u); conv_unit(F, l, u); }
    tp_stamp(F.lds, 200 + 10 * l);
    __syncthreads();
    LAS unsigned char* vl = F.lds + 32768 + F.wave * (64 * VPITCH);
    const int gw = blockIdx.x * NWAVES + F.wave, NGW = F.G * NWAVES;
    for (int rep = 0; rep < nrep_a; ++rep)
    for (int uidx = gw; uidx < BATCH * NHEAD * (SEQ / 32); uidx += NGW) attn_unit(F, uidx, vl);
    tp_stamp(F.lds, 201 + 10 * l);
}

__device__ __forceinline__ void ssm_pass2_unit(const Frame& F, int l, int unit) {
    const bf16* proj = (const bf16*)(F.ws + WS_BIG); bf16* ycat = (bf16*)(F.ws + F.ycat_off);
    const unsigned char* tab = F.ws + WS_TAB + (size_t)l * TAB_STRIDE;
    const float* dsk = F.in[I_SSM_D] + l * 256;
    const bf16* wglu = (const bf16*)(F.ws + WS_WGLU0 + (size_t)l * WS_LSTRIDE);
    LAS float* bu = (LAS float*)(F.lds + F.wave * (16 * BUP * 4));
    LAS unsigned char* sst = (LAS unsigned char*)bu;
    LAS unsigned char* yg = F.lds + 8 * (16 * BUP * 4);
    const int lane = F.lane, p = lane, tok0 = unit * 64, cfirst = unit & ~63;
    float s0r = 0.f, s0i = 0.f, s1r = 0.f, s1i = 0.f;
    { const f32x4 ab0 = ((const f32x4*)(tab + TAB_ABAR))[(F.wave * 2) * 64 + p], ab1 = ((const f32x4*)(tab + TAB_ABAR))[(F.wave * 2 + 1) * 64 + p];
      const float2* ep = (const float2*)(F.ws + WS_E) + (size_t)(F.wave * 2) * 64 + p;
      float2 e0[8], e1[8], f0[8], f1[8];
#define HORNER_LOAD(A0, A1, CC) do { _Pragma("unroll") for (int q = 0; q < 8; ++q) { const int ci = ((CC) + q < unit) ? (CC) + q : cfirst; A0[q] = ep[(size_t)ci * 1024]; A1[q] = ep[(size_t)ci * 1024 + 64]; } } while (0)
#define HORNER_APPLY(A0, A1, CC) do { _Pragma("unroll") for (int q = 0; q < 8; ++q) if ((CC) + q < unit) { cfma(s0r, s0i, ab0.z, ab0.w, A0[q].x, A0[q].y); cfma(s1r, s1i, ab1.z, ab1.w, A1[q].x, A1[q].y); } } while (0)
      if (cfirst < unit) HORNER_LOAD(e0, e1, cfirst);
      for (int cc = cfirst; cc < unit; cc += 16) {
          if (cc + 8 < unit) HORNER_LOAD(f0, f1, cc + 8);
          asm volatile("" ::: "memory");
          HORNER_APPLY(e0, e1, cc);
          if (cc + 16 < unit) HORNER_LOAD(e0, e1, cc + 16);
          asm volatile("" ::: "memory");
          if (cc + 8 < unit) HORNER_APPLY(f0, f1, cc + 8);
      }
#undef HORNER_LOAD
#undef HORNER_APPLY
    }
    for (int gi = 0; gi < 2; ++gi) {
        const int g = F.wave * 2 + gi;
        bf16x8 bbf[8];
#pragma unroll
        for (int cb = 0; cb < 8; ++cb) bbf[cb] = ((const bf16x8*)(tab + TAB_BBF))[(g * 8 + cb) * 64 + lane];
        const f32x4 ab = ((const f32x4*)(tab + TAB_ABAR))[g * 64 + p];
        bf16x8 cb4[4];
#pragma unroll
        for (int ks = 0; ks < 4; ++ks) cb4[ks] = ((const bf16x8*)(tab + TAB_CMATB))[(g * 4 + ks) * 64 + lane];
        bf16x8 af[4]; bf16 uvs[4][4];
#pragma unroll
        for (int tb = 0; tb < 4; ++tb) { af[tb] = ssm_u_frag(proj, tok0 + tb * 16, g, lane);
#pragma unroll
            for (int r = 0; r < 4; ++r) uvs[tb][r] = proj[(size_t)(tok0 + tb * 16 + 4 * (lane >> 4) + r) * INC + C_U + g * 16 + (lane & 15)]; }
        float sr = gi ? s1r : s0r, si = gi ? s1i : s0i;
        const float dk = dsk[g * 16 + (lane & 15)];
#pragma unroll
        for (int tb = 0; tb < 4; ++tb) {
            ssm_bu_block(bu, bbf, af[tb], lane);
#pragma unroll
            for (int tt = 0; tt < 16; ++tt) { SSM_STEP(tt); *(LAS unsigned*)(sst + tt * (BUP * 4) + p * 4) = pk2(sr, si); }
            pg8::f32x4 acc = {0.f, 0.f, 0.f, 0.f};
#pragma unroll
            for (int ks = 0; ks < 4; ++ks) { const bf16x8 a = *(const LAS bf16x8*)(sst + (lane & 15) * (BUP * 4) + (ks * 32 + 8 * (lane >> 4)) * 2); acc = __builtin_amdgcn_mfma_f32_16x16x32_bf16(a, cb4[ks], acc, 0, 0, 0); }
#pragma unroll
            for (int r = 0; r < 4; ++r) { const int t = tb * 16 + 4 * (lane >> 4) + r; const float y = acc[r] + dk * bf2f(uvs[tb][r]);
                const float gl = y * __builtin_amdgcn_rcpf(1.f + __builtin_amdgcn_exp2f(-2.3022081986f * (y + 0.044715f * y * y * y)));
                *(LAS bf16*)(yg + t * 528 + (g * 16 + (lane & 15)) * 2) = (bf16)f2bf(gl); }
        }
        LDS_WAIT(); asm volatile("" ::: "memory");
    }
    const int n0 = 32 * F.wave, r32 = lane & 31, hh = lane >> 5;
    bf16x8 wfr[16];
    { const bf16* wrow = wglu + (size_t)(n0 + r32) * 256 + 8 * hh;
#pragma unroll
      for (int ks = 0; ks < 16; ++ks) wfr[ks] = *(const bf16x8*)(wrow + 16 * ks); }
    __syncthreads();
    {
        f32x16 a0 = {}, a1 = {};
#pragma unroll
        for (int ks = 0; ks < 16; ++ks) {
            const bf16x8 bfr = wfr[ks];
            const bf16x8 x0 = *(const LAS bf16x8*)(yg + r32 * 528 + (16 * ks + 8 * hh) * 2), x1 = *(const LAS bf16x8*)(yg + (32 + r32) * 528 + (16 * ks + 8 * hh) * 2);
            a0 = __builtin_amdgcn_mfma_f32_32x32x16_bf16(x0, bfr, a0, 0, 0, 0); a1 = __builtin_amdgcn_mfma_f32_32x32x16_bf16(x1, bfr, a1, 0, 0, 0);
        }
#pragma unroll
        for (int r = 0; r < 16; ++r) { const int t = crow(r, hh);
            { const float yv = bf2f(*(const LAS bf16*)(yg + t * 528 + (n0 + r32) * 2)); ycat[(size_t)(tok0 + t) * D + 512 + n0 + r32] = (bf16)f2bf(yv * __builtin_amdgcn_rcpf(1.f + __builtin_amdgcn_exp2f(-1.4426950409f * a0[r]))); }
            { const float yv = bf2f(*(const LAS bf16*)(yg + (32 + t) * 528 + (n0 + r32) * 2)); ycat[(size_t)(tok0 + 32 + t) * D + 512 + n0 + r32] = (bf16)f2bf(yv * __builtin_amdgcn_rcpf(1.f + __builtin_amdgcn_exp2f(-1.4426950409f * a1[r]))); } }
    }
    __syncthreads();
}

__device__ __forceinline__ void moe_gather(const Frame& F) {
    LAS int* cnt = (LAS int*)F.lds;
    LAS int* tot = (LAS int*)(F.lds + 16384);
    LAS int* slot_l = (LAS int*)(F.lds + 16384 + 256);
    const int2* topi = (const int2*)(F.ws + WS_TOPI);
    const unsigned char* xn = F.ws + WS_XNN; unsigned char* xs = F.ws + WS_XS;
    {   int c0 = 0, c1 = 0, c2 = 0, c3 = 0, c4 = 0, c5 = 0, c6 = 0, c7 = 0;
        for (int k = 0; k < 32; ++k) { const int2 ti = topi[F.tid * 32 + k];
            c0 += (ti.x == 0) + (ti.y == 0); c1 += (ti.x == 1) + (ti.y == 1); c2 += (ti.x == 2) + (ti.y == 2); c3 += (ti.x == 3) + (ti.y == 3);
            c4 += (ti.x == 4) + (ti.y == 4); c5 += (ti.x == 5) + (ti.y == 5); c6 += (ti.x == 6) + (ti.y == 6); c7 += (ti.x == 7) + (ti.y == 7); }
        cnt[0 * 512 + F.tid] = c0; cnt[1 * 512 + F.tid] = c1; cnt[2 * 512 + F.tid] = c2; cnt[3 * 512 + F.tid] = c3;
        cnt[4 * 512 + F.tid] = c4; cnt[5 * 512 + F.tid] = c5; cnt[6 * 512 + F.tid] = c6; cnt[7 * 512 + F.tid] = c7; }
    __syncthreads();
    {   LAS int* ce = cnt + F.wave * 512 + F.lane * 8;
        int v[8], s = 0;
#pragma unroll
        for (int q = 0; q < 8; ++q) { v[q] = ce[q]; s += v[q]; }
        int inc = s;
#pragma unroll
        for (int d = 1; d < 64; d <<= 1) { const int y = __shfl_up(inc, d); if (F.lane >= d) inc += y; }
        int run = inc - s;
#pragma unroll
        for (int q = 0; q < 8; ++q) { ce[q] = run; run += v[q]; }
        if (F.lane == 63) tot[F.wave] = inc; }
    __syncthreads();
    int seg[8]; { int a = 0;
#pragma unroll
        for (int e = 0; e < 8; ++e) { seg[e] = a; a += (tot[e] + 255) & ~255; } }
    if (blockIdx.x == 0 && F.tid < 8) __hip_atomic_store(F.ctl + CW_MOECNT + F.tid, (unsigned)tot[F.tid], RLX_AGENT);
    for (int u = blockIdx.x; u < NCHUNK; u += F.G) {
        if (F.wave == 0) {
            const int tk = 64 * u + F.lane, tp = tk >> 5; const int2 ti = topi[tk];
            const unsigned long long low = ((1ull << F.lane) - 1ull) & (F.lane >= 32 ? 0xFFFFFFFF00000000ull : 0x00000000FFFFFFFFull);
            int s1 = 0, s2 = 0;
#pragma unroll
            for (int e = 0; e < 8; ++e) { const unsigned long long mk = __ballot(ti.x == e || ti.y == e); const int within = __popcll(mk & low); const int pos = seg[e] + cnt[e * 512 + tp] + within;
                if (ti.x == e) s1 = pos; if (ti.y == e) s2 = pos; }
            ((int2*)(F.ws + WS_SLOT))[tk] = make_int2(s1, s2);
            slot_l[F.lane * 2] = s1; slot_l[F.lane * 2 + 1] = s2;
        }
        __syncthreads();
        {   v4u ra[8];
#pragma unroll
            for (int j = 0; j < 8; ++j) ra[j] = ((const v4u*)(xn + (size_t)(64 * u + F.wave * 8 + j) * D))[F.lane];
#pragma unroll
            for (int j = 0; j < 8; ++j) { const int s1 = slot_l[(F.wave * 8 + j) * 2], s2 = slot_l[(F.wave * 8 + j) * 2 + 1];
                ((v4u*)(xs + (size_t)s1 * D))[F.lane] = ra[j]; ((v4u*)(xs + (size_t)s2 * D))[F.lane] = ra[j]; }
        }
        __syncthreads();
    }
}
template <bool TS> struct MoeOrder {
    static constexpr bool VARK = TS;
    int nM, nN, G, c; int cs[9]; int nfull, nsplit, ntk, parts;
    __device__ __forceinline__ void init(unsigned* cntw, int nN_, int G_, int c_, int ntk_) { nN = nN_; G = G_; c = c_; ntk = ntk_; cs[0] = 0;
#pragma unroll
        for (int e = 0; e < 8; ++e) cs[e + 1] = cs[e] + (int)((__hip_atomic_load(cntw + e, RLX_AGENT) + 255u) >> 8);
        nM = cs[8]; const int total = nM * nN; nfull = TS ? (total / G) * G : total; nsplit = total - nfull;
        if (nsplit > 32) { nfull = total; nsplit = 0; }
        parts = 2; }
    __device__ __forceinline__ bool next(int i, pg8::Unit& u) const {
        const long L = (long)i * G + c; if (L >= (long)nfull + parts * nsplit) return false;
        int base = (int)L; u.nt = ntk; u.koff = 0; u.aux = -1;
        if (TS && L >= nfull) { const int q = ((int)L - nfull) / parts, part = ((int)L - nfull) % parts; base = nfull + q; u.nt = ntk / parts; u.koff = part * (ntk / parts) * 128; u.aux = part ? q * 3 + part - 1 : -1; }
        pg8::order_map(base, nM, nN, u);
        int e = 0;
#pragma unroll
        for (int k = 1; k < 8; ++k) e += (u.pm >= cs[k]) ? 1 : 0;
        u.pn += e * nN; return true; }
    __device__ __forceinline__ void a_ready(const pg8::Unit&) const {}
    __device__ __forceinline__ void done(const pg8::Unit&) const {}
};
__device__ __forceinline__ void final_rows(const Frame& F) {
    const int gw = F.vcu * NWAVES + F.wave, NGW = F.G * NWAVES;
    const bf16* H = (const bf16*)(F.ws + WS_XN); const bf16* ys = (const bf16*)(F.ws + WS_YS); const bf16* y2 = (const bf16*)(F.ws + WS_Y2);
    const int2* slot = (const int2*)(F.ws + WS_SLOT); const float2* tw = (const float2*)(F.ws + WS_TOPW);
    LAS int* stab = (LAS int*)F.lds;
    int nside;
    { MoeOrder<true> S; S.init(F.ctl + CW_MOECNT, D / 256, F.G, 0, FF / 128); nside = S.parts - 1;
      for (int i = F.tid; i < S.nM * 4; i += NTHR) stab[i] = -1;
      __syncthreads();
      for (int q = F.tid; q < S.nsplit; q += NTHR) { pg8::Unit u; pg8::order_map(S.nfull + q, S.nM, 4, u); stab[u.pm * 4 + u.pn] = q; }
      __syncthreads(); }
    f32x4 gv[4];
#pragma unroll
    for (int j = 0; j < 4; ++j) gv[j] = ((const f32x4*)F.in[I_FINAL_NORM])[F.lane + 64 * j];
    for (int m = gw; m < M; m += NGW) {
        const int2 sl = slot[m]; const float2 w = tw[m];
        const v2u* xr = (const v2u*)(H + (size_t)m * D) + F.lane;
        const v2u* y1p = (const v2u*)(ys + (size_t)sl.x * D) + F.lane; const v2u* y2p = (const v2u*)(ys + (size_t)sl.y * D) + F.lane;
        f32x4 v[4]; float s = 0.f;
#pragma unroll
        for (int j = 0; j < 4; ++j) { const v2u a = y1p[64 * j], b = y2p[64 * j];
            f32x4 ya = (f32x4){bfl(a.x), bfh(a.x), bfl(a.y), bfh(a.y)}, yb = (f32x4){bfl(b.x), bfh(b.x), bfl(b.y), bfh(b.y)};
            const int qa = stab[(sl.x >> 8) * 4 + j], qb = stab[(sl.y >> 8) * 4 + j];
            if (qa >= 0) { for (int pc = 0; pc < nside; ++pc) { const v2u t = *((const v2u*)(y2 + (size_t)(qa * 3 + pc) * 65536 + (size_t)(sl.x & 255) * 256) + F.lane); ya += (f32x4){bfl(t.x), bfh(t.x), bfl(t.y), bfh(t.y)}; } }
            if (qb >= 0) { for (int pc = 0; pc < nside; ++pc) { const v2u t = *((const v2u*)(y2 + (size_t)(qb * 3 + pc) * 65536 + (size_t)(sl.y & 255) * 256) + F.lane); yb += (f32x4){bfl(t.x), bfh(t.x), bfl(t.y), bfh(t.y)}; } }
            const v2u hx = xr[64 * j];
            v[j] = (f32x4){bfl(hx.x), bfh(hx.x), bfl(hx.y), bfh(hx.y)} + w.x * ya + w.y * yb;
            s += (v[j].x * v[j].x + v[j].y * v[j].y) + (v[j].z * v[j].z + v[j].w * v[j].w); }
        const float rstd = 1.0f / sqrtf(wave_sum(s) * (1.0f / D) + EPS);
        f32x4* o = (f32x4*)(F.out + (size_t)m * D) + F.lane;
#pragma unroll
        for (int j = 0; j < 4; ++j) o[64 * j] = v[j] * rstd * gv[j];
    }
}

constexpr int RTAB_OFF = MISC_OFF + 1024;
__device__ __forceinline__ void build_rstd_tables(const Frame& F, const pg8::StaticOrder& S, const float* ssp) {
    LAS float* rtab = (LAS float*)(F.lds + RTAB_OFF);
    const int r = F.tid & 255, ih = F.tid >> 8;
    f32x4 pa[4][4]; bool ok[4];
#pragma unroll
    for (int k = 0; k < 4; ++k) { pg8::Unit u; ok[k] = S.next(2 * k + ih, u); const int pm = ok[k] ? u.pm : 0;
        const f32x4* p = (const f32x4*)(ssp + (size_t)(pm * 256 + r) * 16);
#pragma unroll
        for (int q = 0; q < 4; ++q) pa[k][q] = p[q]; }
#pragma unroll
    for (int k = 0; k < 4; ++k) if (ok[k]) {
        const float P0 = (pa[k][0][0] + pa[k][0][1]) + (pa[k][0][2] + pa[k][0][3]), P1 = (pa[k][1][0] + pa[k][1][1]) + (pa[k][1][2] + pa[k][1][3]);
        const float P2 = (pa[k][2][0] + pa[k][2][1]) + (pa[k][2][2] + pa[k][2][3]), P3 = (pa[k][3][0] + pa[k][3][1]) + (pa[k][3][2] + pa[k][3][3]);
        rtab[(2 * k + ih) * 256 + r] = __builtin_amdgcn_rsqf(((P0 + P1) + (P2 + P3)) * (1.0f / 1024.0f) + 1e-6f); }
    __syncthreads();
}

#ifndef PHMASK
#define PHMASK 0xFFFFu
#endif
#define EN(b) ((PHMASK >> (b)) & 1u)
#ifndef PROBE_MASK
#define PROBE_MASK 0u
#endif
#define NREP(b) (1 + (int)((PROBE_MASK >> (b)) & 1u))
constexpr int PH_PRO = 0, PH_L = 1, PH_PER_LAYER = 10, PH_FINAL = 21, NPH = 22;
__global__ void __launch_bounds__(NTHR, 2) mk_fwd(Args args) {
    extern __shared__ __attribute__((aligned(16))) unsigned char lds_raw[];
    Frame F;
    F.lds = (LAS unsigned char*)lds_raw;
    F.tid = threadIdx.x; F.lane = F.tid & 63; F.wave = __builtin_amdgcn_readfirstlane(F.tid >> 6);
    F.G = gridDim.x; { const int bx = blockIdx.x; F.vcu = (F.G % 8 == 0) ? (bx % 8) * (F.G / 8) + bx / 8 : bx; }
    F.ws = args.ws; F.ctl = (unsigned*)(args.ws + WS_CTL); F.in = args.in; F.out = args.out;
    volatile LAS unsigned* MISC = (volatile LAS unsigned*)(F.lds + MISC_OFF);
    for (int u = F.tid; u < (LDS_BYTES - MISC_OFF) / 4; u += NTHR) MISC[u] = 0u;
    __syncthreads();
    const int lo = args.ph_lo, hi = args.ph_hi;
    XcdBarrier bar; bar.bar = F.ctl + CW_BAR; bar.x = 0; bar.st = nullptr;
    if (hi - lo > 1) bar = xcd_barrier_post(F.ctl + CW_BAR, MISC + 8);
#define IN(k) (lo <= (k) && (k) < hi)
#define FRESH() do { int tz_ = threadIdx.x; asm volatile("" : "+v"(tz_)); F.tid = tz_; F.lane = tz_ & 63; F.wave = __builtin_amdgcn_readfirstlane(tz_ >> 6); } while (0)
#define SEAM(k) do { if (IN(k) && IN((k) + 1)) xcd_barrier(bar); STAMP(k); } while (0)
#define STAMP(k) tp_stamp(F.lds, (k))
    STAMP(-1);
    unsigned char* ws = args.ws;
    bf16* XN = (bf16*)(ws + WS_XN); bf16* PROJ = (bf16*)(ws + WS_BIG);

    if (EN(0) && IN(PH_PRO)) { FRESH();
        if (F.wave < 4) cast_rows(F, F.in[I_X], XN, F.vcu * 4 + F.wave, F.G * 4);
        else { convert_jobs(F, 0, 1, 39, 40, F.vcu * 4 + F.wave - 4, F.G * 4); ssm_tables(F, F.vcu * 256 + F.tid - 256, F.G * 256); } }
    SEAM(PH_PRO);
    for (int l = 0; l < 2; ++l) {
        const int pb = PH_L + l * PH_PER_LAYER;
        unsigned char* wl = ws + (size_t)l * WS_LSTRIDE;
        F.ycat_off = l ? WS_YCAT1 : WS_YCAT0;
        bf16* YCAT = (bf16*)(ws + F.ycat_off); bf16* MERGED = (bf16*)(ws + (l ? WS_MERGED1 : WS_MERGED0));
        if (EN(1) && IN(pb + 0)) {
            pg8::Gemm g{XN, (const bf16*)(wl + WS_WIN0), M, C_G, D}; pg8::StaticOrder S; S.init(M, C_G, F.G, (int)blockIdx.x);
            FRESH(); build_rstd_tables(F, S, (const float*)(ws + WS_SSP));
            pg8::EpiProj E{PROJ, INC, 1 << 30, (const float*)(ws + WS_SSP), (const LAS float*)(F.lds + RTAB_OFF), 0, 1.f};
            for (int rep = 0; rep < NREP(1); ++rep) pg8::gemm_phase<pg8::EpiProj, pg8::StaticOrder, true, true>(F.lds, g, S, E);
            STAMP(100 + 10 * l);
            const int nfull = S.nwg % F.G;
            if (nfull != 0) { FRESH(); const int widx = ((int)blockIdx.x >= nfull) ? ((int)blockIdx.x - nfull) * NWAVES + F.wave : -1, nw = (F.G - nfull) * NWAVES;
                if (l == 0) convert_jobs(F, 1, 15, 40, 41, widx, nw); else convert_jobs(F, 23, 27, widx, nw); }
            else { FRESH(); const int widx = F.vcu * NWAVES + F.wave, nw = F.G * NWAVES; if (l == 0) convert_jobs(F, 1, 15, 40, 41, widx, nw); else convert_jobs(F, 23, 27, widx, nw); }
            __syncthreads();
            STAMP(101 + 10 * l);
            pg8::Gemm g8{(const bf16*)(ws + WS_HB8), (const bf16*)(wl + WS_WING8), M, INC - C_G, D / 2}; pg8::StaticOrder S8; S8.init(M, INC - C_G, F.G, (int)blockIdx.x);
            FRESH(); build_rstd_tables(F, S8, (const float*)(ws + WS_SSP));
            pg8::EpiProj E8{PROJ, INC, 0, (const float*)(ws + WS_SSP), (const LAS float*)(F.lds + RTAB_OFF), C_G, 1.0f / (SC_XS * SC_W)};
            for (int rep = 0; rep < NREP(1); ++rep) pg8::gemm_phase<pg8::EpiProj, pg8::StaticOrder, true, true, true>(F.lds, g8, S8, E8);
            STAMP(103 + 10 * l);
        }
        SEAM(pb + 0);
        if (EN(2) && IN(pb + 1)) { FRESH(); mixer_b(F, l, NREP(9), NREP(2)); }
        SEAM(pb + 1);
        if (EN(3) && IN(pb + 2)) { FRESH(); for (int rep = 0; rep < NREP(3); ++rep) for (int u = blockIdx.x; u < NCHUNK; u += F.G) ssm_pass2_unit(F, l, u); STAMP(202 + 10 * l); }
        SEAM(pb + 2);
        if (EN(4) && IN(pb + 3)) {
            pg8::Gemm g{YCAT, (const bf16*)(wl + WS_WCAT0), M, D, D}; pg8::StaticOrder S; S.init(M, D, F.G, (int)blockIdx.x);
            pg8::EpiBranch E{PROJ + C_G, INC, MERGED, D};
            for (int rep = 0; rep < NREP(4); ++rep) pg8::gemm_phase<pg8::EpiBranch, pg8::StaticOrder, false, true>(F.lds, g, S, E);
            STAMP(300 + 10 * l);
        }
        SEAM(pb + 3);
        if (EN(5) && IN(pb + 4)) {
            pg8::Gemm g{MERGED, (const bf16*)(wl + WS_WOUT0), M, D, D}; pg8::StaticOrder S; S.init(M, D, F.G, (int)blockIdx.x);
            if (l == 0) { pg8::EpiResid<1, false> E{F.in[I_X], (pg8::bf16_t*)XN, D, (float*)(ws + WS_SSP), nullptr, 1.f, 1.f};
                pg8::gemm_phase<pg8::EpiResid<1, false>, pg8::StaticOrder, false, true>(F.lds, g, S, E); }
            else { for (int rep = 0; rep < NREP(5); ++rep) { pg8::EpiResid<0, true> E{XN, (rep + 1 < NREP(5)) ? (pg8::bf16_t*)PROJ : (pg8::bf16_t*)XN, D, nullptr, nullptr, 1.f, 1.f};
                pg8::gemm_phase<pg8::EpiResid<0, true>, pg8::StaticOrder, false, true>(F.lds, g, S, E); } }
        }
        SEAM(pb + 4);
        if (l == 0) {
            if (EN(7) && IN(pb + 6)) {
                pg8::Gemm g{XN, (const bf16*)(ws + WS_WGU0), M, 2 * FF, D}; pg8::StaticOrder S; S.init(M, 2 * FF, F.G, (int)blockIdx.x);
                FRESH(); build_rstd_tables(F, S, (const float*)(ws + WS_SSP));
                pg8::EpiSwiglu<true, true> E{PROJ, FF, 2 * FF / 256, (const float*)(ws + WS_SSP), (const LAS float*)(F.lds + RTAB_OFF), SC_ACT};
                for (int rep = 0; rep < NREP(7); ++rep) pg8::gemm_phase<pg8::EpiSwiglu<true, true>, pg8::StaticOrder, true, true>(F.lds, g, S, E);
            }
            SEAM(pb + 6);
            if (EN(8) && IN(pb + 7)) {
                pg8::Gemm g{PROJ, (const bf16*)(ws + WS_WD0), M, D, FF / 2}; pg8::StaticOrder S; S.init(M, D, F.G, (int)blockIdx.x);
                pg8::EpiResid<3, true> E{XN, (pg8::bf16_t*)XN, D, (float*)(ws + WS_SSP), ws + WS_HB8, SC_XS, 1.0f / (SC_ACT * SC_W)};
                pg8::gemm_phase<pg8::EpiResid<3, true>, pg8::StaticOrder, false, true, true>(F.lds, g, S, E);
            }
            SEAM(pb + 7);
        } else {
            if (EN(10) && IN(pb + 5)) { FRESH(); router_fill(F);
                if (F.wave < 3) norm_rows<true>(F, XN, F.in[I_NORM_FFN] + D, (bf16*)(ws + WS_XNN), F.vcu * 3 + F.wave, F.G * 3);
                else convert_jobs(F, 15, 23, 27, 39, F.vcu * 5 + F.wave - 3, F.G * 5);
                STAMP(400); }
            SEAM(pb + 5);
            if (EN(11) && IN(pb + 6)) { FRESH(); for (int rep = 0; rep < NREP(11); ++rep) moe_gather(F); }
            SEAM(pb + 6);
            if (EN(12) && IN(pb + 7)) {
                pg8::Gemm g{(const bf16*)(ws + WS_XS), (const bf16*)(ws + WS_WMOE), MPAD, 2 * FF, D / 2}; MoeOrder<false> S; S.init(F.ctl + CW_MOECNT, 2 * FF / 256, F.G, (int)blockIdx.x, D / 128);
                pg8::EpiSwiglu8 E{ws + WS_ACTM, FF, 2 * FF / 256, -1.4426950408889634f / (SC_XS * SC_W), (SC_XS * SC_W) * (SC_XS * SC_W) / SC_ACT};
                for (int rep = 0; rep < NREP(12); ++rep) pg8::gemm_phase<pg8::EpiSwiglu8, MoeOrder<false>, true, true, true>(F.lds, g, S, E);
            }
            if (IN(pb + 7) && IN(pb + 9)) xcd_barrier(bar);
            STAMP(pb + 7);
            if (EN(14) && IN(pb + 9)) {
                pg8::Gemm g{(const bf16*)(ws + WS_ACTM), (const bf16*)(ws + WS_WD8), MPAD, D, FF / 2}; MoeOrder<true> S; S.init(F.ctl + CW_MOECNT, D / 256, F.G, (int)blockIdx.x, FF / 128);
                pg8::EpiMoeDown E{(bf16*)(ws + WS_YS), D, D / 256, (bf16*)(ws + WS_Y2), 1.0f / (SC_ACT * SC_W)};
                for (int rep = 0; rep < NREP(14); ++rep) pg8::gemm_phase<pg8::EpiMoeDown, MoeOrder<true>, true, true, true>(F.lds, g, S, E);
            }
            SEAM(pb + 9);
        }
    }
    if (EN(15) && IN(PH_FINAL)) { FRESH(); for (int rep = 0; rep < NREP(15); ++rep) final_rows(F); }
    STAMP(PH_FINAL);
    if (TP_A != -2 && blockIdx.x == 0 && threadIdx.x == 0) { const long long tend = wall_clock64(), hold = (*(volatile LAS long long*)(F.lds + 140296) - *(volatile LAS long long*)(F.lds + 140288)) * TP_MUL; while (wall_clock64() - tend < hold) __builtin_amdgcn_s_sleep(32); }
#undef IN
#undef SEAM
}

extern "C" void kernel_launch(void* const* d_in, const int* in_sizes, int n_in, void* d_out, int out_size, void* d_ws, size_t ws_size, hipStream_t stream) {
    static int grid = 0;
    if (grid == 0) {
        if (n_in != 26 || in_sizes[0] != M * D || out_size != M * D || ws_size < WS_END) { fprintf(stderr, "kernel_launch: unexpected shapes (n_in %d, in0 %d, out %d, ws %zu < %zu); nothing launched\n", n_in, n_in > 0 ? in_sizes[0] : -1, out_size, ws_size, (size_t)WS_END); grid = -1; return; }
        int dev = 0, cus = 0;
        if (hipGetDevice(&dev) != hipSuccess || hipDeviceGetAttribute(&cus, hipDeviceAttributeMultiprocessorCount, dev) != hipSuccess) { fprintf(stderr, "kernel_launch: device query failed\n"); grid = -1; return; }
        if (hipFuncSetAttribute((const void*)mk_fwd, hipFuncAttributeMaxDynamicSharedMemorySize, LDS_BYTES) != hipSuccess) { fprintf(stderr, "kernel_launch: hipFuncSetAttribute failed\n"); grid = -1; return; }
        int per_cu = 0;
        if (hipOccupancyMaxActiveBlocksPerMultiprocessor(&per_cu, (const void*)mk_fwd, NTHR, LDS_BYTES) != hipSuccess || per_cu < 1) fprintf(stderr, "kernel_launch: occupancy query reports %d blocks per CU\n", per_cu);
        (void)hipGetLastError();
        grid = cus;
    }
    if (grid < 0) return;
    if (hipMemsetAsync((char*)d_ws + WS_CTL, 0, CTL_ZERO_BYTES, stream) != hipSuccess) { fprintf(stderr, "kernel_launch: memset failed\n"); return; }
    Args a{};
    for (int i = 0; i < 26; ++i) a.in[i] = (const float*)d_in[i];
    a.out = (float*)d_out; a.ws = (unsigned char*)d_ws;
#if MK_ONE_LAUNCH
    a.ph_lo = 0; a.ph_hi = NPH;
    hipLaunchKernelGGL(mk_fwd, dim3(grid), dim3(NTHR), LDS_BYTES, stream, a);
#else
    for (int ph = 0; ph < NPH; ++ph) {
        if (ph == PH_L + 9) continue;
        a.ph_lo = ph; a.ph_hi = ph + 1;
        hipLaunchKernelGGL(mk_fwd, dim3(grid), dim3(NTHR), LDS_BYTES, stream, a);
    }
#endif
    const hipError_t le = hipPeekAtLastError();
    if (le != hipSuccess) fprintf(stderr, "kernel_launch: launch failed: %s\n", hipGetErrorName(le));
}
```

```cpp
#include <hip/hip_runtime.h>
#include <cstdio>
#include <cstdint>

#ifndef MK_ONE_LAUNCH
#define MK_ONE_LAUNCH 1
#endif

namespace pg8 {
#define PG8_LAS __attribute__((address_space(3)))
typedef unsigned short bf16_t;
typedef short bf16x8 __attribute__((ext_vector_type(8)));
typedef float f32x4 __attribute__((ext_vector_type(4)));
typedef float f32x2 __attribute__((ext_vector_type(2)));
typedef unsigned u32x4 __attribute__((ext_vector_type(4)));
constexpr int BM = 256, BK = 64, HALF = 128, HTB = HALF * BK * 2  , STAGE_BYTES = 8 * HTB, NXCD = 8, WGM = 8;

__host__ __device__ __forceinline__ int lds_byte(int r, int c) { const int st = (r >> 4) * 2 + (c >> 5), rr = r & 15, cc = c & 31, ob = rr * 64 + cc * 2; return st * 1024 + (ob ^ (((ob >> 9) & 1) << 5)); }
__host__ __device__ __forceinline__ void stage_rc(int b, int& R, int& C) { const int st = b / 1024, sb = b % 1024, swz = sb ^ (((sb >> 9) & 1) << 5); R = (st >> 1) * 16 + swz / 64; C = (st & 1) * 32 + (swz % 64) / 2; }
__host__ __device__ __forceinline__ int perm32(int rho) { const int n = rho >> 4, i = rho & 15; return 8 * (i >> 2) + 4 * n + (i & 3); }

struct Unit { int pm, pn; int nt, koff, aux; };
struct Gemm { const bf16_t* A; const bf16_t* Bt; int M, N, K; };

__host__ __device__ __forceinline__ void order_map(int L, int nM, int nN, Unit& u) {
    const int nwg = nM * nN;
    int wgid = L; { const int q = nwg / NXCD, r = nwg % NXCD, xcd = wgid % NXCD, off = wgid / NXCD; wgid = (xcd < r ? xcd * (q + 1) : r * (q + 1) + (xcd - r) * q) + off; }
    const int nig = WGM * nN, gid = wgid / nig, fm = gid * WGM, gsz = (nM - fm) < WGM ? (nM - fm) : WGM;
    u.pm = fm + ((wgid % nig) % gsz); u.pn = (wgid % nig) / gsz;
}
struct StaticOrder {
    static constexpr bool VARK = false;
    int nM, nN, nwg, G, c;
    __host__ __device__ void init(int M, int N, int G_, int c_) { nM = M / BM; nN = N / BM; nwg = nM * nN; G = G_; c = c_; }
    __host__ __device__ bool next(int i, Unit& u) const {
        const long L = (long)i * G + c; if (L >= nwg) return false;
        order_map((int)L, nM, nN, u); u.aux = i; return true;
    }
    __device__ __forceinline__ void a_ready(const Unit&) const {}
    __device__ __forceinline__ void done(const Unit&) const {}
};
typedef __bf16 bf16x2n __attribute__((ext_vector_type(2)));
__device__ __forceinline__ unsigned cvt_pk_bf16(float lo, float hi) { const f32x2 v = {lo, hi}; return __builtin_bit_cast(unsigned, __builtin_convertvector(v, bf16x2n)); }

template <class Epi, class Sched, bool ALIGN_EPI = false, bool SP2 = false, bool FP8 = false>
__device__ __forceinline__ void gemm_phase(PG8_LAS unsigned char* lds, const Gemm g, const Sched& S, const Epi& E) {
    int tid_ = threadIdx.x; asm volatile("" : "+v"(tid_));
    const int tid = tid_, wid = __builtin_amdgcn_readfirstlane(tid >> 6), lane = tid & 63, wr = wid >> 2, wc = wid & 3, fr = lane & 15, fq = lane >> 4;
    const int K = g.K, nt = K / BK;
    unsigned voffA[2], voffB[2];
#pragma unroll
    for (int i = 0; i < 2; ++i) { int R, C; stage_rc(tid * 16 + i * 8192, R, C); const int Rb = Epi::PERM ? ((R & ~31) + perm32(R & 31)) : R;
        voffA[i] = (unsigned)(R * K + C) * 2u; voffB[i] = (unsigned)(Rb * K + C) * 2u; }
    const size_t kstep = (size_t)(BK * 2);
    const size_t hstep = (size_t)HALF * K * 2;
    const size_t tstep = 2 * hstep;
    const unsigned ldsw = (unsigned)wid * 1024u;
    const int aoff = lds_byte(wr * 64 + fr, fq * 8), boff = lds_byte(wc * 32 + fr, fq * 8);
#define PG8_SA(b, h) (((b) * 2 + (h)) * HTB)
#define PG8_SB(b, h) ((4 + (b) * 2 + (h)) * HTB)
#define PG8_STAGE(bufoff, gbase, voff) do { _Pragma("unroll") for (int _i = 0; _i < 2; ++_i) \
        __builtin_amdgcn_global_load_lds((const unsigned*)((const char*)(gbase) + (voff)[_i]), (PG8_LAS unsigned*)(lds + (bufoff) + ldsw + _i * 8192), 16, 0, 0); } while (0)
#define PG8_LDA(dst, b, h) do { _Pragma("unroll") for (int m = 0; m < 4; ++m) { if constexpr (FP8) { dst##w[m] = __builtin_shufflevector(*(const PG8_LAS bf16x8*)(lds + PG8_SA(b, h) + aoff + m * 2048), *(const PG8_LAS bf16x8*)(lds + PG8_SA(b, h) + aoff + m * 2048 + 1024), 0, 1, 2, 3, 4, 5, 6, 7, 8, 9, 10, 11, 12, 13, 14, 15); } \
        else { _Pragma("unroll") for (int k = 0; k < 2; ++k) dst[m][k] = *(const PG8_LAS bf16x8*)(lds + PG8_SA(b, h) + aoff + m * 2048 + k * 1024); } } } while (0)
#define PG8_LDB(dst, b, h) do { _Pragma("unroll") for (int n = 0; n < 2; ++n) { if constexpr (FP8) { dst##w[n] = __builtin_shufflevector(*(const PG8_LAS bf16x8*)(lds + PG8_SB(b, h) + boff + n * 2048), *(const PG8_LAS bf16x8*)(lds + PG8_SB(b, h) + boff + n * 2048 + 1024), 0, 1, 2, 3, 4, 5, 6, 7, 8, 9, 10, 11, 12, 13, 14, 15); } \
        else { _Pragma("unroll") for (int k = 0; k < 2; ++k) dst[n][k] = *(const PG8_LAS bf16x8*)(lds + PG8_SB(b, h) + boff + n * 2048 + k * 1024); } } } while (0)
#define PG8_MMA(ai, bj, At, Bt) do { __builtin_amdgcn_s_setprio(1); _Pragma("unroll") for (int m = 0; m < 4; ++m) _Pragma("unroll") for (int n = 0; n < 2; ++n) { \
        if constexpr (FP8) { typedef int v8i_ __attribute__((ext_vector_type(8))); \
            asm volatile("v_mfma_scale_f32_16x16x128_f8f6f4 %0, %1, %2, %0, %3, %3 op_sel_hi:[0,0,0]" : "+v"(acc[ai][bj][m][n]) : "v"(__builtin_bit_cast(v8i_, Bt##w[n])), "v"(__builtin_bit_cast(v8i_, At##w[m])), "v"(sc8)); } \
        else { _Pragma("unroll") for (int k = 0; k < 2; ++k) acc[ai][bj][m][n] = __builtin_amdgcn_mfma_f32_16x16x32_bf16(Bt[n][k], At[m][k], acc[ai][bj][m][n], 0, 0, 0); } } \
        __builtin_amdgcn_s_setprio(0); } while (0)
#define PG8_WAIT_V(n) asm volatile("s_waitcnt vmcnt(" #n ")" ::: "memory")
#define PG8_WAIT_L(n) asm volatile("s_waitcnt lgkmcnt(" #n ")" ::: "memory")
#define PG8_BAR __builtin_amdgcn_s_barrier()
#define PG8_SCHED __builtin_amdgcn_sched_barrier(0)
    Unit cur, nxt; int ui = 0;
    if (!S.next(0, cur)) return;
    f32x4 acc[2][2][4][2];
#pragma unroll
    for (int a = 0; a < 2; ++a)
#pragma unroll
        for (int b = 0; b < 2; ++b)
#pragma unroll
            for (int m = 0; m < 4; ++m)
#pragma unroll
                for (int n = 0; n < 2; ++n) acc[a][b][m][n] = (f32x4){0.f, 0.f, 0.f, 0.f};
    bf16x8 At[4][2], B0[2][2], B1[2][2];
    typedef short bf16x16_ __attribute__((ext_vector_type(16))); bf16x16_ Atw[4], B0w[2], B1w[2];
    unsigned sc8 = 0x7F7F7F7Fu; asm volatile("" : "+v"(sc8));
    const char* cA = (const char*)g.A + (size_t)cur.pm * tstep; const char* cB = (const char*)g.Bt + (size_t)cur.pn * tstep;
    int cnt = nt;
    if constexpr (Sched::VARK) { cnt = cur.nt; cA += cur.koff; cB += cur.koff; }
    S.a_ready(cur);
    if constexpr (SP2) {
        PG8_STAGE(PG8_SB(0, 0), cB, voffB); PG8_STAGE(PG8_SB(0, 1), cB + hstep, voffB); PG8_STAGE(PG8_SA(0, 0), cA, voffA); PG8_STAGE(PG8_SA(0, 1), cA + hstep, voffA);
        if (wr == 1) PG8_BAR;
        PG8_WAIT_V(2); PG8_BAR;
        PG8_STAGE(PG8_SB(1, 0), cB + kstep, voffB); PG8_STAGE(PG8_SA(1, 0), cA + kstep, voffA); PG8_STAGE(PG8_SB(1, 1), cB + hstep + kstep, voffB);
        PG8_WAIT_V(6); PG8_BAR;
    } else {
        PG8_STAGE(PG8_SB(0, 0), cB, voffB); PG8_STAGE(PG8_SA(0, 0), cA, voffA); PG8_STAGE(PG8_SB(0, 1), cB + hstep, voffB); PG8_STAGE(PG8_SA(0, 1), cA + hstep, voffA);
        if (wr == 1) PG8_BAR;
        PG8_WAIT_V(4); PG8_BAR;
        PG8_STAGE(PG8_SB(1, 0), cB + kstep, voffB); PG8_STAGE(PG8_SA(1, 0), cA + kstep, voffA); PG8_STAGE(PG8_SB(1, 1), cB + hstep + kstep, voffB);
        PG8_WAIT_V(6); PG8_BAR;
    }
    for (;;) {
        const bool has_next = S.next(ui + 1, nxt);
        const char* nA = has_next ? (const char*)g.A + (size_t)nxt.pm * tstep : cA; const char* nB = has_next ? (const char*)g.Bt + (size_t)nxt.pn * tstep : cB;
        if constexpr (Sched::VARK) { if (has_next) { nA += nxt.koff; nB += nxt.koff; } }
        for (int t = 0; t < cnt; t += 2) {
            const bool last = (t == cnt - 2);
            const char* a1 = cA + (size_t)(t + 1) * kstep;
            const char* a2 = last ? nA : cA + (size_t)(t + 2) * kstep; const char* b2 = last ? nB : cB + (size_t)(t + 2) * kstep;
            const char* a3 = a2 + kstep; const char* b3 = b2 + kstep;
            if (last && has_next) S.a_ready(nxt);
            if constexpr (Epi::MIDK) { if (t == Epi::MID0 || t == Epi::MID1) { int tz_ = tid; asm volatile("" : "+v"(tz_)); const int ln_ = tz_ & 63; E.mid(acc, cur, t, wr, wc, ln_ & 15, ln_ >> 4); } }
            if constexpr (SP2) {
            PG8_LDB(B0, 0, 0); PG8_LDB(B1, 0, 1); PG8_SCHED; PG8_LDA(At, 0, 0); PG8_STAGE(PG8_SA(1, 1), a1 + hstep, voffA);
            PG8_WAIT_V(8); PG8_WAIT_L(0); PG8_BAR; PG8_MMA(0, 0, At, B0); PG8_MMA(0, 1, At, B1); PG8_BAR; PG8_SCHED;
            PG8_LDA(At, 0, 1); PG8_STAGE(PG8_SB(0, 0), b2, voffB); PG8_STAGE(PG8_SB(0, 1), b2 + hstep, voffB); PG8_STAGE(PG8_SA(0, 0), a2, voffA);
            PG8_WAIT_V(8); PG8_WAIT_L(0); PG8_BAR; PG8_MMA(1, 0, At, B0); PG8_MMA(1, 1, At, B1); PG8_BAR; PG8_SCHED;
            PG8_LDB(B0, 1, 0); PG8_LDB(B1, 1, 1); PG8_SCHED; PG8_LDA(At, 1, 0); PG8_STAGE(PG8_SA(0, 1), a2 + hstep, voffA);
            PG8_WAIT_V(8); PG8_WAIT_L(0); PG8_BAR; PG8_MMA(0, 0, At, B0); PG8_MMA(0, 1, At, B1); PG8_BAR; PG8_SCHED;
            PG8_LDA(At, 1, 1); PG8_STAGE(PG8_SB(1, 0), b3, voffB); PG8_STAGE(PG8_SB(1, 1), b3 + hstep, voffB); PG8_STAGE(PG8_SA(1, 0), a3, voffA);
            PG8_WAIT_V(8); PG8_WAIT_L(0); PG8_BAR; PG8_MMA(1, 0, At, B0); PG8_MMA(1, 1, At, B1); PG8_BAR; PG8_SCHED;
            } else {
            PG8_LDB(B0, 0, 0); PG8_SCHED; PG8_LDA(At, 0, 0); PG8_STAGE(PG8_SA(1, 1), a1 + hstep, voffA);
            PG8_WAIT_L(8); PG8_BAR; PG8_WAIT_L(0); PG8_MMA(0, 0, At, B0); PG8_BAR; PG8_SCHED;
            PG8_LDB(B1, 0, 1); PG8_STAGE(PG8_SB(0, 0), b2, voffB);
            PG8_BAR; PG8_WAIT_L(0); PG8_MMA(0, 1, At, B1); PG8_BAR;
            PG8_LDA(At, 0, 1); PG8_STAGE(PG8_SA(0, 0), a2, voffA);
            PG8_BAR; PG8_WAIT_L(0); PG8_MMA(1, 0, At, B0); PG8_BAR; PG8_SCHED;
            PG8_STAGE(PG8_SB(0, 1), b2 + hstep, voffB);
            PG8_WAIT_V(6); PG8_BAR; PG8_MMA(1, 1, At, B1); PG8_BAR;
            PG8_LDB(B0, 1, 0); PG8_SCHED; PG8_LDA(At, 1, 0); PG8_STAGE(PG8_SA(0, 1), a2 + hstep, voffA);
            PG8_WAIT_L(8); PG8_BAR; PG8_WAIT_L(0); PG8_MMA(0, 0, At, B0); PG8_BAR; PG8_SCHED;
            PG8_LDB(B1, 1, 1); PG8_STAGE(PG8_SB(1, 0), b3, voffB);
            PG8_BAR; PG8_WAIT_L(0); PG8_MMA(0, 1, At, B1); PG8_BAR;
            PG8_LDA(At, 1, 1); PG8_STAGE(PG8_SA(1, 0), a3, voffA);
            PG8_BAR; PG8_WAIT_L(0); PG8_MMA(1, 0, At, B0); PG8_BAR; PG8_SCHED;
            PG8_STAGE(PG8_SB(1, 1), b3 + hstep, voffB);
            PG8_WAIT_V(6); PG8_BAR; PG8_MMA(1, 1, At, B1); PG8_BAR;
            }
        }
        if constexpr (ALIGN_EPI) { if (wr == 0) PG8_BAR; }
        if constexpr (FP8) asm volatile("s_nop 15\n\ts_nop 15" ::: "memory");
        if constexpr (!Epi::AFTER_DRAIN) { int tz_ = tid; asm volatile("" : "+v"(tz_)); const int ln_ = tz_ & 63;
            E(acc, cur, wr, wc, ln_ & 15, ln_ >> 4); S.done(cur); }
        if (!has_next) break;
#pragma unroll
        for (int a = 0; a < 2; ++a)
#pragma unroll
            for (int b = 0; b < 2; ++b)
#pragma unroll
                for (int m = 0; m < 4; ++m)
#pragma unroll
                    for (int n = 0; n < 2; ++n) acc[a][b][m][n] = (f32x4){0.f, 0.f, 0.f, 0.f};
        cur = nxt; cA = nA; cB = nB; ++ui; if constexpr (Sched::VARK) cnt = cur.nt;
        if constexpr (ALIGN_EPI) { if (wr == 1) PG8_BAR; }
    }
    PG8_WAIT_V(0);
    if constexpr (!ALIGN_EPI) { if (wr == 0) PG8_BAR; }
    PG8_BAR;
    if constexpr (Epi::AFTER_DRAIN) { E.fused(acc, cur, wr, wc, fr, fq, lds, wid, lane); S.done(cur); }
#undef PG8_SA
#undef PG8_SB
#undef PG8_STAGE
#undef PG8_LDA
#undef PG8_LDB
#undef PG8_MMA
#undef PG8_WAIT_V
#undef PG8_WAIT_L
#undef PG8_BAR
#undef PG8_SCHED
}

__device__ __forceinline__ float bfl(unsigned w) { return __uint_as_float(w << 16); }
__device__ __forceinline__ float bfh(unsigned w) { return __uint_as_float(w & 0xffff0000u); }
__device__ __forceinline__ float sigmoid_clamped(float l) { l = fminf(fmaxf(l, -30.f), 30.f); return __builtin_amdgcn_rcpf(1.f + __expf(-l)); }
__device__ __forceinline__ float onepexp_clamped(float l) { l = fminf(fmaxf(l, -30.f), 30.f); return 1.f + __expf(-l); }

__device__ __forceinline__ float sum_fq(float x) {
    { const auto r = __builtin_amdgcn_permlane16_swap(__float_as_uint(x), __float_as_uint(x), false, false); x = __uint_as_float(r[0]) + __uint_as_float(r[1]); }
    { const auto r = __builtin_amdgcn_permlane32_swap(__float_as_uint(x), __float_as_uint(x), false, false); x = __uint_as_float(r[0]) + __uint_as_float(r[1]); }
    return x;
}
__device__ __forceinline__ float row_rstd(const float* ssp, int r, int fq) {
    const f32x4 p4 = *(const f32x4*)(ssp + (size_t)r * 16 + 4 * fq);
    float s = (p4[0] + p4[1]) + (p4[2] + p4[3]);
    s = sum_fq(s);
    return __builtin_amdgcn_rsqf(s * (1.0f / 1024.0f) + 1e-6f);
}
__device__ __forceinline__ void row_rstd8(const float* ssp, int row0, int fq, float (&rs)[2][4]) {
    f32x4 p4[2][4];
#pragma unroll
    for (int ai = 0; ai < 2; ++ai)
#pragma unroll
        for (int m = 0; m < 4; ++m) p4[ai][m] = *(const f32x4*)(ssp + (size_t)(row0 + ai * HALF + m * 16) * 16 + 4 * fq);
#pragma unroll
    for (int ai = 0; ai < 2; ++ai)
#pragma unroll
        for (int m = 0; m < 4; ++m) { float s = (p4[ai][m][0] + p4[ai][m][1]) + (p4[ai][m][2] + p4[ai][m][3]); s = sum_fq(s); rs[ai][m] = __builtin_amdgcn_rsqf(s * (1.0f / 1024.0f) + 1e-6f); }
}
__device__ __forceinline__ void rstd8(const PG8_LAS float* rtab, const float* ssp, const Unit& u, int row0, int rloc, int fq, float (&rs)[2][4]) {
    if (u.aux < 8) {
#pragma unroll
        for (int ai = 0; ai < 2; ++ai)
#pragma unroll
            for (int m = 0; m < 4; ++m) rs[ai][m] = rtab[u.aux * 256 + rloc + ai * HALF + m * 16];
    } else row_rstd8(ssp, row0, fq, rs);
}
struct EpiStoreBf16 {
    static constexpr bool PERM = true, AFTER_DRAIN = false, MIDK = false; static constexpr int MID0 = -1, MID1 = -1;
    bf16_t* O; int ldc; int nct;
    __device__ __forceinline__ void operator()(const f32x4 (&acc)[2][2][4][2], const Unit& u, int wr, int wc, int fr, int fq) const {
        const int row0 = u.pm * BM + wr * 64 + fr, col0 = (u.pn % nct) * BM + wc * 32 + 8 * fq;
#pragma unroll
        for (int ai = 0; ai < 2; ++ai)
#pragma unroll
            for (int m = 0; m < 4; ++m) { bf16_t* rowp = O + (size_t)(row0 + ai * HALF + m * 16) * ldc + col0;
#pragma unroll
                for (int bj = 0; bj < 2; ++bj) { const f32x4 v0 = acc[ai][bj][m][0], v1 = acc[ai][bj][m][1];
                    u32x4 w; w.x = cvt_pk_bf16(v0[0], v0[1]); w.y = cvt_pk_bf16(v0[2], v0[3]); w.z = cvt_pk_bf16(v1[0], v1[1]); w.w = cvt_pk_bf16(v1[2], v1[3]);
                    *(u32x4*)(rowp + bj * HALF) = w; } }
    }
};
struct EpiProj {
    static constexpr bool PERM = true, AFTER_DRAIN = false, MIDK = false; static constexpr int MID0 = -1, MID1 = -1;
    bf16_t* O; int ldc; int gate_tile0; const float* ssp; const PG8_LAS float* rtab; int col_off; float scale;
    __device__ __forceinline__ void operator()(const f32x4 (&acc)[2][2][4][2], const Unit& u, int wr, int wc, int fr, int fq) const {
        const int row0 = u.pm * BM + wr * 64 + fr, col0 = col_off + u.pn * BM + wc * 32 + 8 * fq;
        const bool gate = u.pn >= gate_tile0;
        float rsv[2][4]; rstd8(rtab, ssp, u, row0, wr * 64 + fr, fq, rsv);
#pragma unroll
        for (int ai = 0; ai < 2; ++ai)
#pragma unroll
            for (int m = 0; m < 4; ++m) { bf16_t* rowp = O + (size_t)(row0 + ai * HALF + m * 16) * ldc + col0;
                const float rs = rsv[ai][m] * scale;
                if (gate) { const float k1 = rs * -1.4426950408889634f;
#pragma unroll
                    for (int bj = 0; bj < 2; ++bj) { u32x4 w;
#pragma unroll
                        for (int q = 0; q < 4; ++q) { const f32x2 a2 = {acc[ai][bj][m][q >> 1][2 * (q & 1)], acc[ai][bj][m][q >> 1][2 * (q & 1) + 1]}; const f32x2 t = a2 * k1;
                            const f32x2 ex = {__builtin_amdgcn_exp2f(__builtin_amdgcn_fmed3f(t.x, -43.280851f, 43.280851f)), __builtin_amdgcn_exp2f(__builtin_amdgcn_fmed3f(t.y, -43.280851f, 43.280851f))};
                            const f32x2 o = ex + 1.0f; w[q] = cvt_pk_bf16(o.x, o.y); }
                        *(u32x4*)(rowp + bj * HALF) = w; } }
                else {
#pragma unroll
                    for (int bj = 0; bj < 2; ++bj) { const f32x4 v0 = acc[ai][bj][m][0] * rs, v1 = acc[ai][bj][m][1] * rs;
                        u32x4 w; w.x = cvt_pk_bf16(v0[0], v0[1]); w.y = cvt_pk_bf16(v0[2], v0[3]); w.z = cvt_pk_bf16(v1[0], v1[1]); w.w = cvt_pk_bf16(v1[2], v1[3]);
                        *(u32x4*)(rowp + bj * HALF) = w; } } }
    }
};
__device__ __forceinline__ unsigned pk4_fp8(float a, float b, float c, float d) {
    a = fminf(fmaxf(a, -448.f), 448.f); b = fminf(fmaxf(b, -448.f), 448.f); c = fminf(fmaxf(c, -448.f), 448.f); d = fminf(fmaxf(d, -448.f), 448.f);
    int p = __builtin_amdgcn_cvt_pk_fp8_f32(a, b, 0, false); p = __builtin_amdgcn_cvt_pk_fp8_f32(c, d, p, true); return (unsigned)p;
}
struct EpiSwiglu8 {
    static constexpr bool PERM = true, AFTER_DRAIN = false, MIDK = false; static constexpr int MID0 = -1, MID1 = -1;
    unsigned char* O; int ldc; int nct; float k1, cden;
    __device__ __forceinline__ void operator()(const f32x4 (&acc)[2][2][4][2], const Unit& u, int wr, int wc, int fr, int fq) const {
        const int row0 = u.pm * BM + wr * 64 + fr, col0 = (u.pn % nct) * HALF + wc * 32 + 8 * fq;
#pragma unroll
        for (int ai = 0; ai < 2; ++ai)
#pragma unroll
            for (int m = 0; m < 4; ++m) { unsigned char* rowp = O + (size_t)(row0 + ai * HALF + m * 16) * ldc + col0;
                float r[8];
#pragma unroll
                for (int n = 0; n < 2; ++n)
#pragma unroll
                    for (int h = 0; h < 2; ++h) { const f32x2 g2 = {acc[ai][0][m][n][2 * h], acc[ai][0][m][n][2 * h + 1]}, u2 = {acc[ai][1][m][n][2 * h], acc[ai][1][m][n][2 * h + 1]};
                        const f32x2 t = g2 * k1; const f32x2 ex = {__builtin_amdgcn_exp2f(t.x), __builtin_amdgcn_exp2f(t.y)}; const f32x2 d = ex * cden + cden;
                        const f32x2 rr = {__builtin_amdgcn_rcpf(d.x), __builtin_amdgcn_rcpf(d.y)}; const f32x2 o = (g2 * u2) * rr; r[n * 4 + 2 * h] = o.x; r[n * 4 + 2 * h + 1] = o.y; }
                typedef unsigned u32x2v __attribute__((ext_vector_type(2))); u32x2v w; w.x = pk4_fp8(r[0], r[1], r[2], r[3]); w.y = pk4_fp8(r[4], r[5], r[6], r[7]);
                *(u32x2v*)rowp = w; }
    }
};
struct EpiMoeDown {
    static constexpr bool PERM = true, AFTER_DRAIN = false, MIDK = false; static constexpr int MID0 = -1, MID1 = -1;
    bf16_t* O; int ldc; int nct; bf16_t* O2; float scale;
    __device__ __forceinline__ void operator()(const f32x4 (&acc)[2][2][4][2], const Unit& u, int wr, int wc, int fr, int fq) const {
        const bool second = u.aux >= 0;
        bf16_t* base = second ? O2 + (size_t)u.aux * 65536 + (size_t)(wr * 64 + fr) * 256 + wc * 32 + 8 * fq
                              : O + (size_t)(u.pm * BM + wr * 64 + fr) * ldc + (u.pn % nct) * BM + wc * 32 + 8 * fq;
        const int ld = second ? 256 : ldc;
#pragma unroll
        for (int ai = 0; ai < 2; ++ai)
#pragma unroll
            for (int m = 0; m < 4; ++m) { bf16_t* rowp = base + (size_t)(ai * HALF + m * 16) * ld;
#pragma unroll
                for (int bj = 0; bj < 2; ++bj) { const f32x4 v0 = acc[ai][bj][m][0] * scale, v1 = acc[ai][bj][m][1] * scale;
                    u32x4 w; w.x = cvt_pk_bf16(v0[0], v0[1]); w.y = cvt_pk_bf16(v0[2], v0[3]); w.z = cvt_pk_bf16(v1[0], v1[1]); w.w = cvt_pk_bf16(v1[2], v1[3]);
                    *(u32x4*)(rowp + bj * HALF) = w; } }
    }
};
template <int NORMOUT, bool BASE16> struct EpiResid {
    static constexpr bool PERM = true, AFTER_DRAIN = false, MIDK = false; static constexpr int MID0 = -1, MID1 = -1;
    const void* base; bf16_t* hb; int ldc; float* ssp; unsigned char* hb8; float hb8_scale; float ascale;
    __device__ __forceinline__ void row_out(const f32x4 (&o)[2][2], size_t off, int r, int pn, int wc, int fq) const {
        float q = 0.f;
#pragma unroll
        for (int bj = 0; bj < 2; ++bj) { const f32x4 o0 = o[bj][0], o1 = o[bj][1];
            if (NORMOUT & 1) q += ((o0[0] * o0[0] + o0[1] * o0[1]) + (o0[2] * o0[2] + o0[3] * o0[3])) + ((o1[0] * o1[0] + o1[1] * o1[1]) + (o1[2] * o1[2] + o1[3] * o1[3]));
            u32x4 w; w.x = cvt_pk_bf16(o0[0], o0[1]); w.y = cvt_pk_bf16(o0[2], o0[3]); w.z = cvt_pk_bf16(o1[0], o1[1]); w.w = cvt_pk_bf16(o1[2], o1[3]); *(u32x4*)(hb + off + bj * HALF) = w;
            if (NORMOUT & 2) { typedef unsigned u32x2v __attribute__((ext_vector_type(2))); u32x2v w8; w8.x = pk4_fp8(o0[0] * hb8_scale, o0[1] * hb8_scale, o0[2] * hb8_scale, o0[3] * hb8_scale); w8.y = pk4_fp8(o1[0] * hb8_scale, o1[1] * hb8_scale, o1[2] * hb8_scale, o1[3] * hb8_scale); *(u32x2v*)(hb8 + off + bj * HALF) = w8; } }
        if (NORMOUT & 1) { q = sum_fq(q); if (fq == 0) ssp[(size_t)r * 16 + 4 * pn + wc] = q; }
    }
    __device__ __forceinline__ void operator()(const f32x4 (&acc)[2][2][4][2], const Unit& u, int wr, int wc, int fr, int fq) const {
        const int row0 = u.pm * BM + wr * 64 + fr, col0 = u.pn * BM + wc * 32 + 8 * fq;
        if constexpr (BASE16) { const bf16_t* b16 = (const bf16_t*)base;
#pragma unroll
            for (int ai = 0; ai < 2; ++ai) { u32x4 bs[4][2];
#pragma unroll
                for (int m = 0; m < 4; ++m)
#pragma unroll
                    for (int bj = 0; bj < 2; ++bj) bs[m][bj] = *(const u32x4*)(b16 + (size_t)(row0 + ai * HALF + m * 16) * ldc + col0 + bj * HALF);
#pragma unroll
                for (int m = 0; m < 4; ++m) { const int r = row0 + ai * HALF + m * 16; f32x4 o[2][2];
#pragma unroll
                    for (int bj = 0; bj < 2; ++bj) { const u32x4 b = bs[m][bj];
                        o[bj][0] = (f32x4){bfl(b.x), bfh(b.x), bfl(b.y), bfh(b.y)} + acc[ai][bj][m][0] * ascale; o[bj][1] = (f32x4){bfl(b.z), bfh(b.z), bfl(b.w), bfh(b.w)} + acc[ai][bj][m][1] * ascale; }
                    row_out(o, (size_t)r * ldc + col0, r, u.pn, wc, fq); }
                asm volatile("" ::: "memory"); }
        } else { const float* b32 = (const float*)base;
#pragma unroll
            for (int ai = 0; ai < 2; ++ai)
#pragma unroll
                for (int mp = 0; mp < 2; ++mp) { f32x4 bs[2][2][2];
#pragma unroll
                    for (int mm = 0; mm < 2; ++mm) { const size_t off = (size_t)(row0 + ai * HALF + (2 * mp + mm) * 16) * ldc + col0;
#pragma unroll
                        for (int bj = 0; bj < 2; ++bj)
#pragma unroll
                            for (int n = 0; n < 2; ++n) bs[mm][bj][n] = *(const f32x4*)(b32 + off + bj * HALF + n * 4); }
#pragma unroll
                    for (int mm = 0; mm < 2; ++mm) { const int r = row0 + ai * HALF + (2 * mp + mm) * 16; f32x4 o[2][2];
#pragma unroll
                        for (int bj = 0; bj < 2; ++bj) { o[bj][0] = bs[mm][bj][0] + acc[ai][bj][2 * mp + mm][0] * ascale; o[bj][1] = bs[mm][bj][1] + acc[ai][bj][2 * mp + mm][1] * ascale; }
                        row_out(o, (size_t)r * ldc + col0, r, u.pn, wc, fq); }
                    asm volatile("" ::: "memory"); }
        }
    }
};
template <bool RS, bool OUT8 = false> struct EpiSwiglu {
    static constexpr bool PERM = true, AFTER_DRAIN = false, MIDK = false; static constexpr int MID0 = -1, MID1 = -1;
    bf16_t* O; int ldc; int nct; const float* ssp; const PG8_LAS float* rtab; float out_scale;
    __device__ __forceinline__ void operator()(const f32x4 (&acc)[2][2][4][2], const Unit& u, int wr, int wc, int fr, int fq) const {
        const int row0 = u.pm * BM + wr * 64 + fr, col0 = (u.pn % nct) * HALF + wc * 32 + 8 * fq;
        float rsv[2][4]; if (RS) rstd8(rtab, ssp, u, row0, wr * 64 + fr, fq, rsv);
#pragma unroll
        for (int ai = 0; ai < 2; ++ai)
#pragma unroll
            for (int m = 0; m < 4; ++m) { bf16_t* rowp = O + (size_t)(row0 + ai * HALF + m * 16) * ldc + col0;
                float r[8]; float rs = 1.f; if (RS) rs = rsv[ai][m];
                const float k1 = rs * -1.4426950408889634f, cden = (RS || OUT8) ? __builtin_amdgcn_rcpf(rs * rs * (OUT8 ? out_scale : 1.f)) : 1.f;
#pragma unroll
                for (int n = 0; n < 2; ++n)
#pragma unroll
                    for (int h = 0; h < 2; ++h) { const f32x2 g2 = {acc[ai][0][m][n][2 * h], acc[ai][0][m][n][2 * h + 1]}, u2 = {acc[ai][1][m][n][2 * h], acc[ai][1][m][n][2 * h + 1]};
                        const f32x2 t = g2 * k1; const f32x2 ex = {__builtin_amdgcn_exp2f(t.x), __builtin_amdgcn_exp2f(t.y)}; const f32x2 d = ex * cden + cden;
                        const f32x2 rr = {__builtin_amdgcn_rcpf(d.x), __builtin_amdgcn_rcpf(d.y)}; const f32x2 o = (g2 * u2) * rr; r[n * 4 + 2 * h] = o.x; r[n * 4 + 2 * h + 1] = o.y; }
                if constexpr (OUT8) { typedef unsigned u32x2v __attribute__((ext_vector_type(2))); u32x2v w; w.x = pk4_fp8(r[0], r[1], r[2], r[3]); w.y = pk4_fp8(r[4], r[5], r[6], r[7]);
                    *(u32x2v*)((unsigned char*)O + (size_t)(row0 + ai * HALF + m * 16) * ldc + col0) = w; }
                else { u32x4 w; w.x = cvt_pk_bf16(r[0], r[1]); w.y = cvt_pk_bf16(r[2], r[3]); w.z = cvt_pk_bf16(r[4], r[5]); w.w = cvt_pk_bf16(r[6], r[7]);
                    *(u32x4*)rowp = w; } }
    }
};
struct EpiBranch {
    static constexpr bool PERM = true, AFTER_DRAIN = false, MIDK = true; static constexpr int MID0 = 8, MID1 = 12;
    const bf16_t* G; int ldg; bf16_t* O; int ldc;
    __device__ __forceinline__ void mid(f32x4 (&acc)[2][2][4][2], const Unit& u, int t, int wr, int wc, int fr, int fq) const {
        int row0 = u.pm * BM + wr * 64 + fr, col0 = u.pn * BM + wc * 32 + 8 * fq;
        asm volatile("" : "+v"(row0), "+v"(col0));
        const bf16_t* gp = G + (t == MID0 ? 0 : 1024);
        u32x4 ld_[2][2][2], ln_[2][2][2];
#define BR_LOAD(bf, ai, mp) do { _Pragma("unroll") for (int mm = 0; mm < 2; ++mm) { const bf16_t* rp = gp + (size_t)(row0 + (ai) * HALF + (2 * (mp) + mm) * 16) * ldg + col0; \
            _Pragma("unroll") for (int bj = 0; bj < 2; ++bj) { ld_[bf][mm][bj] = *(const u32x4*)(rp + bj * HALF); ln_[bf][mm][bj] = *(const u32x4*)(rp + bj * HALF + 1024); } } } while (0)
#define BR_APPLY(bf, ai, mp) do { _Pragma("unroll") for (int mm = 0; mm < 2; ++mm) _Pragma("unroll") for (int bj = 0; bj < 2; ++bj) _Pragma("unroll") for (int q = 0; q < 4; ++q) { \
            const unsigned dw = ld_[bf][mm][bj][q], nw = ln_[bf][mm][bj][q];        \
            const f32x2 rd = {__builtin_amdgcn_rcpf(bfl(dw)), __builtin_amdgcn_rcpf(bfh(dw))}, nm = {bfl(nw), bfh(nw)}; const f32x2 ra = nm * rd; \
            acc[ai][bj][2 * (mp) + mm][q >> 1][2 * (q & 1)] *= ra.x; acc[ai][bj][2 * (mp) + mm][q >> 1][2 * (q & 1) + 1] *= ra.y; } } while (0)
        BR_LOAD(0, 0, 0); BR_LOAD(1, 0, 1); asm volatile("" ::: "memory");
        BR_APPLY(0, 0, 0); asm volatile("" ::: "memory"); BR_LOAD(0, 1, 0); asm volatile("" ::: "memory");
        BR_APPLY(1, 0, 1); asm volatile("" ::: "memory"); BR_LOAD(1, 1, 1); asm volatile("" ::: "memory");
        BR_APPLY(0, 1, 0); asm volatile("" ::: "memory"); BR_APPLY(1, 1, 1); asm volatile("" ::: "memory");
#undef BR_LOAD
#undef BR_APPLY
    }
    __device__ __forceinline__ void operator()(const f32x4 (&acc)[2][2][4][2], const Unit& u, int wr, int wc, int fr, int fq) const {
        const int row0 = u.pm * BM + wr * 64 + fr, col0 = u.pn * BM + wc * 32 + 8 * fq;
        u32x4 l2[2][2][2];
#define BR_LOAD(bf, ai, mp) do { _Pragma("unroll") for (int mm = 0; mm < 2; ++mm) _Pragma("unroll") for (int bj = 0; bj < 2; ++bj) \
            l2[bf][mm][bj] = *(const u32x4*)(G + 2048 + (size_t)(row0 + (ai) * HALF + (2 * (mp) + mm) * 16) * ldg + col0 + bj * HALF); } while (0)
#define BR_APPLY(bf, ai, mp) do { _Pragma("unroll") for (int mm = 0; mm < 2; ++mm) _Pragma("unroll") for (int bj = 0; bj < 2; ++bj) { u32x4 w; \
            _Pragma("unroll") for (int q = 0; q < 4; ++q) { const unsigned dw = l2[bf][mm][bj][q]; const f32x2 rd = {__builtin_amdgcn_rcpf(bfl(dw)), __builtin_amdgcn_rcpf(bfh(dw))}; \
                const f32x2 a2 = {acc[ai][bj][2 * (mp) + mm][q >> 1][2 * (q & 1)], acc[ai][bj][2 * (mp) + mm][q >> 1][2 * (q & 1) + 1]}; const f32x2 o = a2 * rd; w[q] = cvt_pk_bf16(o.x, o.y); } \
            *(u32x4*)(O + (size_t)(row0 + (ai) * HALF + (2 * (mp) + mm) * 16) * ldc + col0 + bj * HALF) = w; } } while (0)
        BR_LOAD(0, 0, 0); BR_LOAD(1, 0, 1); asm volatile("" ::: "memory");
        BR_APPLY(0, 0, 0); asm volatile("" ::: "memory"); BR_LOAD(0, 1, 0); asm volatile("" ::: "memory");
        BR_APPLY(1, 0, 1); asm volatile("" ::: "memory"); BR_LOAD(1, 1, 1); asm volatile("" ::: "memory");
        BR_APPLY(0, 1, 0); asm volatile("" ::: "memory"); BR_APPLY(1, 1, 1);
#undef BR_LOAD
#undef BR_APPLY
    }
};

}

constexpr int NWAVES = 8, NTHR = 512;
constexpr int BATCH = 4, SEQ = 4096, D = 1024, M = BATCH * SEQ, INC = 5632, FF = 3584, NE = 8, NHEAD = 8, HD = 64;
constexpr int C_Q = 0, C_K = 512, C_V = 1024, C_U = 1536, C_CH = 1792, C_CB = 2048, C_CC = 2304, C_G = 2560;
constexpr int MPAD = 2 * M + 2048;
constexpr int NCHUNK = M / 64;
constexpr float EPS = 1e-6f;
constexpr float SB_EXIT = -150.1f;

constexpr size_t MiB = 1u << 20;
constexpr size_t WS_CTL = 0, CTL_ZERO_BYTES = 65536;
constexpr int CW_BAR = 4096, CW_MOECNT = 8192;
constexpr size_t WS_TOPI = 1 * MiB, WS_TOPW = WS_TOPI + 256 * 1024, WS_SLOT = WS_TOPI + 512 * 1024;
constexpr size_t WS_TAB = 2 * MiB, TAB_STRIDE = 512 * 1024, TAB_ABAR = 0, TAB_BBAR = 64 * 1024, TAB_CMATB = 256 * 1024, TAB_BBF = 320 * 1024;
constexpr size_t WS_HB8 = 236 * MiB;
constexpr size_t WS_WING8 = 77 * MiB;
constexpr size_t WS_Y2 = 224 * MiB;
constexpr size_t WS_E = 4 * MiB, WS_SSP = 6 * MiB;
constexpr size_t WS_XNN = 8 * MiB;
constexpr size_t WS_WIN0 = 72 * MiB, WS_WCAT0 = 83 * MiB, WS_WOUT0 = 85 * MiB, WS_WGLU0 = 87 * MiB, WS_WGU0 = 88 * MiB, WS_WD0 = 102 * MiB;
constexpr size_t WS_WIN1 = 109 * MiB, WS_WCAT1 = 120 * MiB, WS_WOUT1 = 122 * MiB, WS_WGLU1 = 124 * MiB;
constexpr size_t WS_LSTRIDE = WS_WIN1 - WS_WIN0;
static_assert(WS_WCAT1 - WS_WCAT0 == WS_LSTRIDE && WS_WOUT1 - WS_WOUT0 == WS_LSTRIDE && WS_WGLU1 - WS_WGLU0 == WS_LSTRIDE, "layer stride");
constexpr size_t WS_YCAT0 = 125 * MiB, WS_MERGED0 = 157 * MiB, WS_XN = 252 * MiB, WS_BIG = 284 * MiB;
constexpr size_t WS_YCAT1 = 72 * MiB, WS_MERGED1 = 460 * MiB;
constexpr size_t WS_XS = 72 * MiB, WS_WMOE = 140 * MiB, WS_WD8 = 196 * MiB, WS_ACTM = 284 * MiB, WS_YS = 404 * MiB, WS_END = 492 * MiB;
constexpr float SC_XS = 4.f, SC_W = 64.f, SC_ACT = 8.f;
static_assert(WS_XS + (size_t)MPAD * D <= WS_WIN1 && WS_WMOE + (size_t)NE * 2 * FF * D <= WS_WD8 && WS_WD8 + (size_t)NE * FF * D <= 224 * MiB && WS_ACTM + (size_t)MPAD * FF <= WS_YS && WS_YS + (size_t)MPAD * D * 2 <= WS_END, "MoE map");
static_assert(WS_BIG + (size_t)M * INC * 2 <= WS_END && WS_XN + (size_t)M * D * 2 <= WS_BIG && WS_MERGED0 + (size_t)M * D * 2 <= WS_XN && WS_MERGED1 + (size_t)M * D * 2 <= WS_END && WS_YCAT1 + (size_t)M * D * 2 <= WS_WIN1, "mixer map");

constexpr int RING_BYTES = 131072, MISC_OFF = RING_BYTES, LDS_BYTES = 147456;

#define LAS __attribute__((address_space(3)))
#ifndef TP_A
#define TP_A -2
#define TP_B -2
#endif
#define TP_MUL 8
__device__ __forceinline__ void tp_stamp(LAS unsigned char* lds, int k) {
    if (TP_A == -2) return;
    if (threadIdx.x == 0 && blockIdx.x == 0) { if (k == TP_A) *(volatile LAS long long*)(lds + 140288) = wall_clock64(); if (k == TP_B) *(volatile LAS long long*)(lds + 140296) = wall_clock64(); }
}
typedef unsigned short bf16;
typedef unsigned v4u __attribute__((ext_vector_type(4)));
typedef unsigned v2u __attribute__((ext_vector_type(2)));
typedef float f32x4 __attribute__((ext_vector_type(4)));
typedef float f32x16 __attribute__((ext_vector_type(16)));
typedef float f32x2v __attribute__((ext_vector_type(2)));
typedef short bf16x8 __attribute__((ext_vector_type(8)));
#define RLX_AGENT __ATOMIC_RELAXED, __HIP_MEMORY_SCOPE_AGENT
#define LDS_WAIT() asm volatile("s_waitcnt lgkmcnt(0)" ::: "memory")
__device__ __forceinline__ float bfl(unsigned w) { return __uint_as_float(w << 16); }
__device__ __forceinline__ float bfh(unsigned w) { return __uint_as_float(w & 0xffff0000u); }
__device__ __forceinline__ float bf2f(bf16 x) { return __uint_as_float(((unsigned)x) << 16); }
typedef float f32x2c __attribute__((ext_vector_type(2))); typedef __bf16 bf16x2c __attribute__((ext_vector_type(2)));
__device__ __forceinline__ unsigned pk2(float lo, float hi) { const f32x2c v = {lo, hi}; return __builtin_bit_cast(unsigned, __builtin_convertvector(v, bf16x2c)); }
__device__ __forceinline__ unsigned f2bf(float f) { return pk2(f, f) & 0xffffu; }
__device__ __forceinline__ float wave_sum(float v) {
#pragma unroll
    for (int o = 1; o < 64; o <<= 1) v += __shfl_xor(v, o);
    return v;
}

#define XB_TMO      128
#define XB_XCNT(j)  (256  + 64 * (j))
#define XB_XSUB(j)  (1280 + 64 * (j))
#define XB_XGEN(j)  (2304 + 64 * (j))
#define XB_TOP      3328
#define XB_TOPGEN   3392
#define XCD_BAR_WORDS 3456
#define XB_SPIN_CAP (1u << 18)
__device__ __forceinline__ unsigned xb_ld(unsigned* p)              { return __hip_atomic_load(p, __ATOMIC_RELAXED, __HIP_MEMORY_SCOPE_AGENT); }
__device__ __forceinline__ unsigned xb_add(unsigned* p, unsigned v) { return __hip_atomic_fetch_add(p, v, __ATOMIC_RELAXED, __HIP_MEMORY_SCOPE_AGENT); }
__device__ __forceinline__ unsigned xb_xcc_id() { return (unsigned)__builtin_amdgcn_s_getreg((3 << 11) | 20) & 0xFu; }
#define XB_SPIN(cond, bar) do { unsigned _sp = 0; while (cond) { __builtin_amdgcn_s_sleep(1); \
    if ((++_sp & 255u) == 0u) { if (xb_ld(&(bar)[XB_TMO])) break; if (_sp > XB_SPIN_CAP) { atomicAdd(&(bar)[XB_TMO], 1u); break; } } } } while (0)
struct XcdBarrier { unsigned* bar; unsigned x; volatile LAS unsigned* st; };
__device__ __forceinline__ XcdBarrier xcd_barrier_post(unsigned* bar, volatile LAS unsigned* st) {
    XcdBarrier b; b.bar = bar; b.x = xb_xcc_id(); b.st = st;
    if (threadIdx.x == 0) (void)xb_add(&bar[XB_XCNT(b.x)], 1u);
    return b;
}
__device__ __forceinline__ void xcd_barrier_complete(unsigned* bar, unsigned x, unsigned& nloc, unsigned& nx) {
    const unsigned G = gridDim.x * gridDim.y * gridDim.z;
    unsigned sum, cnt, mine, sp = 0u;
    for (;;) {
        sum = 0u; cnt = 0u; mine = 0u;
#pragma unroll
        for (unsigned j = 0; j < 16; ++j) { const unsigned c = xb_ld(&bar[XB_XCNT(j)]); sum += c; cnt += (c > 0u) ? 1u : 0u; mine = (j == x) ? c : mine; }
        if (sum == G) break;
        __builtin_amdgcn_s_sleep(1);
        if ((++sp & 255u) == 0u) { if (xb_ld(&bar[XB_TMO])) break; if (sp > XB_SPIN_CAP) { atomicAdd(&bar[XB_TMO], 1u); break; } }
    }
    nloc = mine > 0u ? mine : 1u; nx = cnt > 0u ? cnt : 1u;
}
__device__ __forceinline__ void xcd_barrier(const XcdBarrier& b) {
    asm volatile("s_waitcnt vmcnt(0)" ::: "memory");
    __syncthreads();
    if (threadIdx.x == 0) {
        unsigned* bar = b.bar;
        __builtin_amdgcn_s_waitcnt(0);
        unsigned nloc = b.st[0], nx = b.st[1];
        if (nloc == 0u) { xcd_barrier_complete(bar, b.x, nloc, nx); b.st[0] = nloc; b.st[1] = nx; }
        const unsigned old = xb_add(&bar[XB_XSUB(b.x)], 1u);
        const unsigned gen = old / nloc;
        if (old + 1u == (gen + 1u) * nloc) {
            __builtin_amdgcn_fence(__ATOMIC_RELEASE, "agent");
            asm volatile("s_waitcnt vmcnt(0)" ::: "memory");
            const unsigned og = xb_add(&bar[XB_TOP], 1u);
            const unsigned tg = og / nx;
            if (og + 1u == (tg + 1u) * nx) xb_add(&bar[XB_TOPGEN], 1u);
            else XB_SPIN(xb_ld(&bar[XB_TOPGEN]) == tg, bar);
            __builtin_amdgcn_fence(__ATOMIC_ACQUIRE, "agent");
            xb_add(&bar[XB_XGEN(b.x)], 1u);
            asm volatile("s_waitcnt vmcnt(0)" ::: "memory");
        } else {
            XB_SPIN(xb_ld(&bar[XB_XGEN(b.x)]) == gen, bar);
            __builtin_amdgcn_fence(__ATOMIC_ACQUIRE, "agent");
            asm volatile("s_waitcnt vmcnt(0)" ::: "memory");
        }
    }
    __syncthreads();
}

struct Args { const float* in[26]; float* out; unsigned char* ws; int ph_lo, ph_hi; };
enum InIdx { I_X = 0, I_NORM_MIX, I_W_IN, I_LAM_RE, I_LAM_IM, I_LOG_DT, I_B_RE, I_B_IM, I_C_RE, I_C_IM, I_SSM_D, I_W_GLU, I_CONV_W, I_W_BR_A, I_W_BR_B, I_W_BR_C, I_W_OUT,
             I_NORM_FFN, I_DW_GATE, I_DW_UP, I_DW_DOWN, I_ROUTER, I_MW_GATE, I_MW_UP, I_MW_DOWN, I_FINAL_NORM };
struct Frame {
    LAS unsigned char* lds;
    unsigned* ctl;
    unsigned char* ws;
    const float* const* in;
    float* out;
    int tid, lane, wave, vcu, G;
    size_t ycat_off;
};

struct CvtJob { const float* src; bf16* dst; int K, N, ld, koff, mode; const float* gain; int fp8; int src_ld, c0; };
__device__ __forceinline__ CvtJob get_job(const Frame& F, int j) {
    CvtJob J; J.koff = 0; J.mode = 0; J.gain = nullptr; J.fp8 = 0; J.src_ld = 0; J.c0 = 0;
    if (j >= 39) { const int l = j - 39;
        J.src = F.in[I_W_IN] + (size_t)l * D * INC; J.K = D; J.N = INC - C_G; J.src_ld = INC; J.c0 = C_G; J.dst = (bf16*)(F.ws + WS_WING8 + (size_t)l * WS_LSTRIDE); J.ld = D; J.gain = F.in[I_NORM_MIX] + l * D; J.fp8 = 1; return J; }
    if (j < 12) { const int l = j / 6, r = j % 6; unsigned char* wl = F.ws + (size_t)l * WS_LSTRIDE;
        if (r == 0)      { J.src = F.in[I_W_IN] + (size_t)l * D * INC;   J.K = D;   J.N = C_G; J.src_ld = INC; J.dst = (bf16*)(wl + WS_WIN0);  J.ld = D; J.gain = F.in[I_NORM_MIX] + l * D; }
        else if (r == 1) { J.src = F.in[I_W_BR_A] + (size_t)l * 512 * D; J.K = 512; J.N = D;   J.dst = (bf16*)(wl + WS_WCAT0); J.ld = D; }
        else if (r == 2) { J.src = F.in[I_W_BR_B] + (size_t)l * 256 * D; J.K = 256; J.N = D;   J.dst = (bf16*)(wl + WS_WCAT0); J.ld = D; J.koff = 512; }
        else if (r == 3) { J.src = F.in[I_W_BR_C] + (size_t)l * 256 * D; J.K = 256; J.N = D;   J.dst = (bf16*)(wl + WS_WCAT0); J.ld = D; J.koff = 768; }
        else if (r == 4) { J.src = F.in[I_W_OUT] + (size_t)l * D * D;    J.K = D;   J.N = D;   J.dst = (bf16*)(wl + WS_WOUT0); J.ld = D; }
        else             { J.src = F.in[I_W_GLU] + (size_t)l * 256 * 256; J.K = 256; J.N = 256; J.dst = (bf16*)(wl + WS_WGLU0); J.ld = 256; }
    } else if (j == 12) { J.src = F.in[I_DW_GATE]; J.K = D; J.N = FF; J.dst = (bf16*)(F.ws + WS_WGU0); J.ld = D; J.mode = 1; J.gain = F.in[I_NORM_FFN]; }
    else if (j == 13)   { J.src = F.in[I_DW_UP];   J.K = D; J.N = FF; J.dst = (bf16*)(F.ws + WS_WGU0); J.ld = D; J.mode = 2; J.gain = F.in[I_NORM_FFN]; }
    else if (j == 14)   { J.src = F.in[I_DW_DOWN]; J.K = FF; J.N = D; J.dst = (bf16*)(F.ws + WS_WD0);  J.ld = FF; J.fp8 = 1; }
    else if (j < 31)    { const int e = (j - 15) >> 1, up = (j - 15) & 1; const float* sg = F.in[I_MW_GATE]; const float* su = F.in[I_MW_UP]; J.src = (up ? su : sg) + (size_t)e * D * FF; J.K = D; J.N = FF;
                          J.dst = (bf16*)(F.ws + WS_WMOE + (size_t)e * 2 * FF * D); J.ld = D; J.mode = 1 + up; J.fp8 = 1; }
    else                { const int e = j - 31; J.src = F.in[I_MW_DOWN] + (size_t)e * FF * D; J.K = FF; J.N = D; J.dst = (bf16*)(F.ws + WS_WD8 + (size_t)e * D * FF); J.ld = FF; J.fp8 = 1; }
    if (!J.src_ld) J.src_ld = J.N;
    return J;
}
__device__ __forceinline__ void cvt_load(const CvtJob& J, int item, int lane, f32x4 (&ld)[16]) {
    const int nblk = J.N / 64, kb = item / nblk, nb = item % nblk;
    const float* p = J.src + (size_t)(64 * kb + (lane >> 4)) * J.src_ld + J.c0 + 64 * nb + (lane & 15) * 4;
#pragma unroll
    for (int i = 0; i < 16; ++i) ld[i] = *(const f32x4*)(p + (size_t)(4 * i) * J.src_ld);
}
__device__ __forceinline__ void cvt_to_lds(const CvtJob& J, int item, int lane, f32x4 (&ld)[16], LAS float* scr) {
    const int nblk = J.N / 64, kb = item / nblk, k0 = 64 * kb;
    if (J.gain) {
#pragma unroll
        for (int i = 0; i < 16; ++i) ld[i] = ld[i] * J.gain[k0 + (lane >> 4) + 4 * i]; }
#pragma unroll
    for (int i = 0; i < 16; ++i) { const int k = (lane >> 4) + 4 * i; *(LAS f32x4*)(scr + k * 64 + 4 * ((lane & 15) ^ (((k >> 3) ^ k) & 7))) = ld[i]; }
    LDS_WAIT(); asm volatile("" ::: "memory");
}
__device__ __forceinline__ void cvt_store(const CvtJob& J, int item, int lane, const LAS float* scr) {
    const int nblk = J.N / 64, kb = item / nblk, nb = item % nblk, k0 = 64 * kb, n0 = 64 * nb;
    const int drow0 = (J.mode == 0) ? n0 : ((n0 >> 7) * 256 + (n0 & 127) + (J.mode == 2 ? 128 : 0));
    const int c = lane & 7;
#pragma unroll
    for (int j = 0; j < 8; ++j) { const int n = (lane >> 3) + 8 * j; float v[8];
#pragma unroll
        for (int q = 0; q < 8; ++q) v[q] = scr[(8 * c + q) * 64 + 4 * ((n >> 2) ^ ((c ^ q) & 7)) + (n & 3)];
        if (J.fp8) { v2u o8; o8.x = pg8::pk4_fp8(v[0] * SC_W, v[1] * SC_W, v[2] * SC_W, v[3] * SC_W); o8.y = pg8::pk4_fp8(v[4] * SC_W, v[5] * SC_W, v[6] * SC_W, v[7] * SC_W);
            *(v2u*)((unsigned char*)J.dst + (size_t)(drow0 + n) * J.ld + J.koff + k0 + 8 * c) = o8; }
        else { v4u o; o.x = pk2(v[0], v[1]); o.y = pk2(v[2], v[3]); o.z = pk2(v[4], v[5]); o.w = pk2(v[6], v[7]);
            *(v4u*)(J.dst + (size_t)(drow0 + n) * J.ld + J.koff + k0 + 8 * c) = o; } }
    LDS_WAIT(); asm volatile("" ::: "memory");
}
struct CvtCursor { int j, base, n; CvtJob J; };
__device__ __forceinline__ bool cvt_advance(const Frame& F, CvtCursor& C, int jb, int jc, int jd, int flat, int& item) {
    while (flat - C.base >= C.n) { C.base += C.n; ++C.j; if (C.j == jb) C.j = jc; if (C.j >= jd) { C.n = 0x3fffffff; return false; } C.J = get_job(F, C.j); C.n = (C.J.K / 64) * (C.J.N / 64); }
    item = flat - C.base; return true;
}
__device__ __forceinline__ void convert_jobs(const Frame& F, int ja, int jb, int jc, int jd, int widx, int nw) {
    if (widx < 0) return;
    LAS float* scr = (LAS float*)(F.lds + F.wave * 16384);
    CvtCursor C; C.j = (ja < jb) ? ja : jc; if (C.j >= jd) return; C.base = 0; C.J = get_job(F, C.j); C.n = (C.J.K / 64) * (C.J.N / 64);
    int flat = widx, itc = 0; bool ok = cvt_advance(F, C, jb, jc, jd, flat, itc);
    CvtJob Jc = C.J; f32x4 ld[16];
    if (ok) cvt_load(Jc, itc, F.lane, ld);
    while (ok) {
        cvt_to_lds(Jc, itc, F.lane, ld, scr);
        flat += nw; int itn = 0; const bool okn = cvt_advance(F, C, jb, jc, jd, flat, itn); const CvtJob Jn = C.J;
        if (okn) cvt_load(Jn, itn, F.lane, ld);
        asm volatile("" ::: "memory");
        cvt_store(Jc, itc, F.lane, scr);
        Jc = Jn; itc = itn; ok = okn;
    }
}
__device__ __forceinline__ void convert_jobs(const Frame& F, int jlo, int jhi, int widx, int nw) { convert_jobs(F, jlo, jhi, jhi, jhi, widx, nw); }

__device__ __forceinline__ void ssm_tables(const Frame& F, int gt, int NT) {
    for (int i = gt; i < 2 * 16 * 64; i += NT) {
        const int l = i >> 10, g = (i >> 6) & 15, p = i & 63;
        unsigned char* tab = F.ws + WS_TAB + (size_t)l * TAB_STRIDE;
        const float lr = fminf(F.in[I_LAM_RE][i], -1e-4f), li = F.in[I_LAM_IM][i], dt = expf(F.in[I_LOG_DT][l * 16 + g]);
        const float mag = expf(lr * dt), ar = mag * cosf(li * dt), ai = mag * sinf(li * dt);
        const float den = lr * lr + li * li, nr = ar - 1.0f, ni = ai;
        const float fr = (nr * lr + ni * li) / den, fi = (ni * lr - nr * li) / den;
        const double ang = (double)li * (double)dt * 64.0; const double rev = ang * 0.15915494309189535; const float rf = (float)((rev - rint(rev)) * 6.283185307179586);
        const float magT = expf(64.0f * lr * dt);
        ((f32x4*)(tab + TAB_ABAR))[g * 64 + p] = (f32x4){ar, ai, magT * cosf(rf), magT * sinf(rf)};
        float* bb = (float*)(tab + TAB_BBAR) + (size_t)(g * 64 + p) * 32;
        const float* bre = F.in[I_B_RE] + (size_t)i * 16; const float* bim = F.in[I_B_IM] + (size_t)i * 16;
#pragma unroll
        for (int h = 0; h < 16; ++h) { const float br = bre[h], bi = bim[h]; bb[2 * h] = fr * br - fi * bi; bb[2 * h + 1] = fr * bi + fi * br; }
    }
    for (int i = gt; i < 2 * 16 * 8 * 64; i += NT) {
        const int l = i >> 13, g = (i >> 9) & 15, cbk = (i >> 6) & 7, ln = i & 63;
        const int c = cbk * 16 + (ln & 15), p = c >> 1, ri = c & 1, kh = ln >> 4;
        unsigned w[4] = {0u, 0u, 0u, 0u};
        if (kh < 2) {
            const int idx = (l * 16 + g) * 64 + p;
            const float lr = fminf(F.in[I_LAM_RE][idx], -1e-4f), li = F.in[I_LAM_IM][idx], dt = expf(F.in[I_LOG_DT][l * 16 + g]);
            const float mag = expf(lr * dt), ar = mag * cosf(li * dt), ai = mag * sinf(li * dt);
            const float den = lr * lr + li * li, nr = ar - 1.0f, ni = ai;
            const float fr = (nr * lr + ni * li) / den, fi = (ni * lr - nr * li) / den;
            const float* bre = F.in[I_B_RE] + (size_t)idx * 16 + 8 * kh; const float* bim = F.in[I_B_IM] + (size_t)idx * 16 + 8 * kh;
            float v[8];
#pragma unroll
            for (int j = 0; j < 8; ++j) { const float br = bre[j], bi = bim[j]; v[j] = ri ? (fr * bi + fi * br) : (fr * br - fi * bi); }
            w[0] = pk2(v[0], v[1]); w[1] = pk2(v[2], v[3]); w[2] = pk2(v[4], v[5]); w[3] = pk2(v[6], v[7]);
        }
        ((v4u*)(F.ws + WS_TAB + (size_t)l * TAB_STRIDE + TAB_BBF))[i & 8191] = (v4u){w[0], w[1], w[2], w[3]};
    }
    for (int i = gt; i < 2 * 16 * 4 * 64; i += NT) {
        const int l = i >> 12, g = (i >> 8) & 15, ks = (i >> 6) & 3, ln = i & 63;
        const int hp = ln & 15;
        const float* cre = F.in[I_C_RE] + ((size_t)(l * 16 + g) * 16 + hp) * 64; const float* cim = F.in[I_C_IM] + ((size_t)(l * 16 + g) * 16 + hp) * 64;
        unsigned w[4];
#pragma unroll
        for (int jj = 0; jj < 4; ++jj) { const int k = ks * 32 + 8 * (ln >> 4) + 2 * jj, p = k >> 1; w[jj] = pk2(cre[p], -cim[p]); }
        ((v4u*)(F.ws + WS_TAB + (size_t)l * TAB_STRIDE + TAB_CMATB))[i & 4095] = (v4u){w[0], w[1], w[2], w[3]};
    }
}

__device__ __forceinline__ void router_fill(const Frame& F) {
    LAS float* wrt = (LAS float*)F.lds; const float* wr = F.in[I_ROUTER];
    for (int i = F.tid; i < D * NE; i += NTHR) wrt[(i & 7) * D + (i >> 3)] = wr[i];
    __syncthreads();
}
template <bool ROUTER>
__device__ __forceinline__ void norm_rows(const Frame& F, const bf16* src, const float* gain, bf16* dst, int gw, int NGW) {
    LAS float* wrt = (LAS float*)F.lds;
    f32x4 gv[4];
#pragma unroll
    for (int j = 0; j < 4; ++j) gv[j] = ((const f32x4*)gain)[F.lane + 64 * j];
    v2u nv[4];
    if (gw < M) {
#pragma unroll
        for (int j = 0; j < 4; ++j) nv[j] = ((const v2u*)(src + (size_t)gw * D) + F.lane)[64 * j]; }
    for (int m = gw; m < M; m += NGW) {
        f32x4 v[4]; float s = 0.f;
#pragma unroll
        for (int j = 0; j < 4; ++j) v[j] = (f32x4){bfl(nv[j].x), bfh(nv[j].x), bfl(nv[j].y), bfh(nv[j].y)};
        if (m + NGW < M) {
#pragma unroll
            for (int j = 0; j < 4; ++j) nv[j] = ((const v2u*)(src + (size_t)(m + NGW) * D) + F.lane)[64 * j]; }
#pragma unroll
        for (int j = 0; j < 4; ++j) s += (v[j].x * v[j].x + v[j].y * v[j].y) + (v[j].z * v[j].z + v[j].w * v[j].w);
        const float rstd = 1.0f / sqrtf(wave_sum(s) * (1.0f / D) + EPS);
        if (ROUTER) { unsigned* o4 = (unsigned*)((unsigned char*)dst + (size_t)m * D) + F.lane;
#pragma unroll
            for (int j = 0; j < 4; ++j) { v[j] = v[j] * rstd * gv[j]; o4[64 * j] = pg8::pk4_fp8(v[j].x * SC_XS, v[j].y * SC_XS, v[j].z * SC_XS, v[j].w * SC_XS); } }
        else { unsigned long long* o8 = (unsigned long long*)(dst + (size_t)m * D) + F.lane;
#pragma unroll
            for (int j = 0; j < 4; ++j) { v[j] = v[j] * rstd * gv[j]; o8[64 * j] = (unsigned long long)pk2(v[j].x, v[j].y) | ((unsigned long long)pk2(v[j].z, v[j].w) << 32); } }
        if (ROUTER) {
            float lg[8];
#pragma unroll
            for (int e = 0; e < 8; ++e) { float a = 0.f;
#pragma unroll
                for (int j = 0; j < 4; ++j) { const f32x4 w = *(const LAS f32x4*)(wrt + e * D + 4 * F.lane + 256 * j); a += (v[j].x * w.x + v[j].y * w.y) + (v[j].z * w.z + v[j].w * w.w); }
                lg[e] = wave_sum(a); }
            if (F.lane == 0) {
                int i1 = 0; float v1 = lg[0];
#pragma unroll
                for (int e = 1; e < 8; ++e) if (lg[e] > v1) { v1 = lg[e]; i1 = e; }
                int i2 = -1; float v2 = -INFINITY;
#pragma unroll
                for (int e = 0; e < 8; ++e) if (e != i1 && lg[e] > v2) { v2 = lg[e]; i2 = e; }
                const float e2 = expf(v2 - v1), w1 = 1.0f / (1.0f + e2);
                ((int2*)(F.ws + WS_TOPI))[m] = make_int2(i1, i2);
                ((float2*)(F.ws + WS_TOPW))[m] = make_float2(w1, e2 * w1);
            }
        }
    }
}

__device__ __forceinline__ void cast_rows(const Frame& F, const float* src, bf16* dst, int gw, int NGW) {
    float* ssp = (float*)(F.ws + WS_SSP);
    for (int m0 = gw; m0 < M; m0 += 4 * NGW) {
        f32x4 v[4][4];
#pragma unroll
        for (int r = 0; r < 4; ++r) { const int m = (m0 + r * NGW < M) ? m0 + r * NGW : m0;
#pragma unroll
            for (int j = 0; j < 4; ++j) v[r][j] = ((const f32x4*)(src + (size_t)m * D) + F.lane)[64 * j]; }
#pragma unroll
        for (int r = 0; r < 4; ++r) { const int m = m0 + r * NGW; if (m < M) {
            float s = 0.f;
#pragma unroll
            for (int j = 0; j < 4; ++j) s += (v[r][j].x * v[r][j].x + v[r][j].y * v[r][j].y) + (v[r][j].z * v[r][j].z + v[r][j].w * v[r][j].w);
            s = wave_sum(s);
            unsigned long long* o8 = (unsigned long long*)(dst + (size_t)m * D) + F.lane;
#pragma unroll
            for (int j = 0; j < 4; ++j) o8[64 * j] = (unsigned long long)pk2(v[r][j].x, v[r][j].y) | ((unsigned long long)pk2(v[r][j].z, v[r][j].w) << 32);
            unsigned* o4 = (unsigned*)(F.ws + WS_HB8 + (size_t)m * D) + F.lane;
#pragma unroll
            for (int j = 0; j < 4; ++j) o4[64 * j] = pg8::pk4_fp8(v[r][j].x * SC_XS, v[r][j].y * SC_XS, v[r][j].z * SC_XS, v[r][j].w * SC_XS);
            if (F.lane < 16) ssp[(size_t)m * 16 + F.lane] = (F.lane == 0) ? s : 0.f; } }
    }
}
__device__ __forceinline__ void cfma(float& sr, float& si, float ar, float ai, float br, float bi) {
    float t1, t2, nr, ni; const float nai = -ai;
    asm volatile("v_fma_f32 %0, %1, %2, %3" : "=v"(t1) : "v"(ar), "v"(sr), "v"(br));
    asm volatile("v_fma_f32 %0, %1, %2, %3" : "=v"(nr) : "v"(nai), "v"(si), "v"(t1));
    asm volatile("v_fma_f32 %0, %1, %2, %3" : "=v"(t2) : "v"(ar), "v"(si), "v"(bi));
    asm volatile("v_fma_f32 %0, %1, %2, %3" : "=v"(ni) : "v"(ai), "v"(sr), "v"(t2));
    sr = nr; si = ni;
}
constexpr int BUP = 132;
__device__ __forceinline__ bf16x8 ssm_u_frag(const bf16* proj, int tokb, int g, int lane) {
    bf16x8 a = {0, 0, 0, 0, 0, 0, 0, 0};
    if ((lane >> 4) < 2) a = *(const bf16x8*)(proj + (size_t)(tokb + (lane & 15)) * INC + C_U + g * 16 + 8 * (lane >> 4));
    return a;
}
__device__ __forceinline__ void ssm_bu_block(LAS float* bu, const bf16x8 (&bbf)[8], bf16x8 a, int lane) {
    const int kh = lane >> 4;
#pragma unroll
    for (int cb = 0; cb < 8; ++cb) {
        const pg8::f32x4 d = __builtin_amdgcn_mfma_f32_16x16x32_bf16(a, bbf[cb], (pg8::f32x4){0.f, 0.f, 0.f, 0.f}, 0, 0, 0);
#pragma unroll
        for (int r = 0; r < 4; ++r) bu[(4 * kh + r) * BUP + cb * 16 + (lane & 15)] = d[r];
    }
    LDS_WAIT(); asm volatile("" ::: "memory");
}
#define SSM_STEP(tt_) do { const f32x2v b_ = *(const LAS f32x2v*)(bu + (tt_) * BUP + 2 * p); \
    cfma(sr, si, ab.x, ab.y, b_.x, b_.y); } while (0)

__device__ __forceinline__ void ssm_pass1_unit(const Frame& F, int l, int unit) {
    const bf16* proj = (const bf16*)(F.ws + WS_BIG);
    const unsigned char* tab = F.ws + WS_TAB + (size_t)l * TAB_STRIDE;
    LAS float* bu = (LAS float*)(F.lds + F.wave * (16 * BUP * 4));
    const int p = F.lane, tok0 = unit * 64;
    for (int gi = 0; gi < 2; ++gi) {
        const int g = F.wave * 2 + gi;
        bf16x8 bbf[8];
#pragma unroll
        for (int cb = 0; cb < 8; ++cb) bbf[cb] = ((const bf16x8*)(tab + TAB_BBF))[(g * 8 + cb) * 64 + F.lane];
        const f32x4 ab = ((const f32x4*)(tab + TAB_ABAR))[g * 64 + p];
        bf16x8 af[4];
#pragma unroll
        for (int tb = 0; tb < 4; ++tb) af[tb] = ssm_u_frag(proj, tok0 + tb * 16, g, F.lane);
        float sr = 0.f, si = 0.f;
#pragma unroll
        for (int tb = 0; tb < 4; ++tb) {
            ssm_bu_block(bu, bbf, af[tb], F.lane);
#pragma unroll
            for (int tt = 0; tt < 16; ++tt) SSM_STEP(tt);
        }
        ((float2*)(F.ws + WS_E))[((size_t)unit * 16 + g) * 64 + p] = make_float2(sr, si);
        LDS_WAIT(); asm volatile("" ::: "memory");
    }
}
__device__ __forceinline__ void conv_unit(const Frame& F, int l, int unit) {
    const bf16* proj = (const bf16*)(F.ws + WS_BIG); bf16* ycat = (bf16*)(F.ws + F.ycat_off);
    const float* cw = F.in[I_CONV_W] + (size_t)l * 3 * 256;
    for (int it = F.tid; it < 64 * 32; it += NTHR) {
        const int tt = it >> 5, cg = (it & 31) * 8, tok = unit * 64 + tt, tl = tok & (SEQ - 1);
        const bf16* row = proj + (size_t)tok * INC;
        float u[3][8];
        v4u hv[3], cv[3];
#pragma unroll
        for (int d = 0; d < 3; ++d) { const size_t back = (tl >= d) ? (size_t)d * INC : 0; hv[d] = *(const v4u*)(row - back + C_CH + cg); cv[d] = *(const v4u*)(row - back + C_CC + cg); }
#pragma unroll
        for (int d = 0; d < 3; ++d) {
            const float keep = (tl >= d) ? 1.f : 0.f;
            const unsigned hw[4] = {hv[d].x, hv[d].y, hv[d].z, hv[d].w}, cww[4] = {cv[d].x, cv[d].y, cv[d].z, cv[d].w};
#pragma unroll
            for (int q = 0; q < 4; ++q) { u[d][2 * q] = keep * (bfl(hw[q]) * bfl(cww[q])); u[d][2 * q + 1] = keep * (bfh(hw[q]) * bfh(cww[q])); }
        }
        const v4u bv = *(const v4u*)(row + C_CB + cg); const unsigned bw[4] = {bv.x, bv.y, bv.z, bv.w};
        float o[8];
#pragma unroll
        for (int q = 0; q < 8; ++q) { const float y = cw[cg + q] * u[2][q] + cw[256 + cg + q] * u[1][q] + cw[512 + cg + q] * u[0][q]; const float bg = (q & 1) ? bfh(bw[q >> 1]) : bfl(bw[q >> 1]); o[q] = bg * y; }
        *(v4u*)(ycat + (size_t)tok * D + 768 + cg) = (v4u){pk2(o[0], o[1]), pk2(o[2], o[3]), pk2(o[4], o[5]), pk2(o[6], o[7])};
    }
}
__device__ __forceinline__ int crow(int r, int hi) { return (r & 3) + 8 * (r >> 2) + 4 * hi; }
constexpr int VPITCH = 144;
typedef short v4i16_t __attribute__((ext_vector_type(4)));
__device__ __forceinline__ bf16x8 pack8(float a, float b, float c, float d, float e, float f, float g, float h) {
    v4u w = {pk2(a, b), pk2(c, d), pk2(e, f), pk2(g, h)}; return __builtin_bit_cast(bf16x8, w); }
__device__ __forceinline__ void attn_unit(const Frame& F, int uidx, LAS unsigned char* vl) {
    const int lane = F.lane, r32 = lane & 31, hh = lane >> 5;
    const int bh = uidx >> 7, qb = uidx & 127, b = bh >> 3, h = bh & 7, t0 = qb * 32, tq = t0 + r32;
    const bf16* P = (const bf16*)(F.ws + WS_BIG) + (size_t)b * SEQ * INC;
    bf16* ycat = (bf16*)(F.ws + F.ycat_off);
    bf16x8 qf[4];
#pragma unroll
    for (int ks = 0; ks < 4; ++ks) qf[ks] = *(const bf16x8*)(P + (size_t)tq * INC + C_Q + h * 64 + 16 * ks + 8 * hh);
    f32x16 o0 = {}, o1 = {};
    float carry = 0.f;
    const int trb = ((lane & 15) >> 2) * VPITCH + (16 * ((lane >> 4) & 1) + 4 * (lane & 3)) * 2 + 4 * hh * VPITCH;
    bf16x8 kf0[4], kf1[4];
    v4u vv[8];
    const unsigned vlo = (unsigned)(((lane >> 3) * INC + (lane & 7) * 8) * 2), klo = (unsigned)((r32 * INC + 8 * hh) * 2);
    const char* Pv = (const char*)(P + C_V + h * 64); const char* Pk = (const char*)(P + C_K + h * 64);
#define AT_LOADV(KSB) do { const char* vb_ = Pv + (size_t)(KSB) * (INC * 2); _Pragma("unroll") for (int i = 0; i < 8; ++i) vv[i] = *(const v4u*)(vb_ + (size_t)(8 * i) * (INC * 2) + vlo); } while (0)
#define AT_LOADK(KSB) do { const char* kb_ = Pk + (size_t)(KSB) * (INC * 2); \
            _Pragma("unroll") for (int ks = 0; ks < 4; ++ks) { kf0[ks] = *(const bf16x8*)(kb_ + klo + 32 * ks); kf1[ks] = *(const bf16x8*)(kb_ + (size_t)32 * (INC * 2) + klo + 32 * ks); } } while (0)
    { const int kb0 = t0 - 32 < 0 ? 0 : t0 - 32; AT_LOADV(kb0); AT_LOADK(kb0); }
    for (int kend = t0 + 32; kend > 0; kend -= 64) {
        const int ks0 = kend - 64;
        asm volatile("" : "+v"(vv[0]), "+v"(vv[1]), "+v"(vv[2]), "+v"(vv[3]), "+v"(vv[4]), "+v"(vv[5]), "+v"(vv[6]), "+v"(vv[7]));
#pragma unroll
        for (int i = 0; i < 8; ++i) { const int row = (lane >> 3) + 8 * i; *(LAS v4u*)(vl + row * VPITCH + (lane & 7) * 16) = vv[i]; }
        const int ksb = ks0 < 0 ? 0 : ks0, ksn = ks0 - 64 < 0 ? 0 : ks0 - 64;
        AT_LOADV(ksn); asm volatile("" ::: "memory");
        f32x16 s0 = {}, s1 = {};
#pragma unroll
        for (int ks = 0; ks < 4; ++ks) { s0 = __builtin_amdgcn_mfma_f32_32x32x16_bf16(kf0[ks], qf[ks], s0, 0, 0, 0); s1 = __builtin_amdgcn_mfma_f32_32x32x16_bf16(kf1[ks], qf[ks], s1, 0, 0, 0); }
        asm volatile("" : "+v"(s0), "+v"(s1));
        AT_LOADK(ksn); asm volatile("" ::: "memory");
        f32x16 c0, c1; float tot = 0.f; const int kmax = kend < tq ? kend : tq;
#define SP_ELEM(S, C, I, KEY, MASKED) do { const float z2 = 0.18033688011112042f * S[I]; const float sp = fmaxf(z2, 0.f) + __builtin_amdgcn_logf(1.f + __builtin_amdgcn_exp2f(-fabsf(z2))); \
            if (MASKED) { const bool valid = (KEY) < kmax; C[I] = valid ? (z2 - sp) + carry : -INFINITY; S[I] = valid ? -sp : 0.f; } else { C[I] = (z2 - sp) + carry; S[I] = -sp; } tot += S[I]; } while (0)
        if (ks0 >= 0 && kend <= t0) {
#pragma unroll
            for (int i = 0; i < 16; ++i) SP_ELEM(s1, c1, i, 0, false);
            tot += __shfl_xor(tot, 32); carry += tot; tot = 0.f;
#pragma unroll
            for (int i = 0; i < 16; ++i) SP_ELEM(s0, c0, i, 0, false);
        } else {
#pragma unroll
            for (int i = 0; i < 16; ++i) { const int key1 = ksb + 32 + crow(i, hh); SP_ELEM(s1, c1, i, key1, true); }
            tot += __shfl_xor(tot, 32); carry += tot; tot = 0.f;
#pragma unroll
            for (int i = 0; i < 16; ++i) { const int key0 = ksb + crow(i, hh); SP_ELEM(s0, c0, i, key0, true); }
        }
#undef SP_ELEM
        tot += __shfl_xor(tot, 32); carry += tot;
        {
#define HIW(S, q8) ((v4u){pk2(S[(q8)], S[(q8) + 1]), pk2(S[(q8) + 2], S[(q8) + 3]), pk2(S[(q8) + 4], S[(q8) + 5]), pk2(S[(q8) + 6], S[(q8) + 7])})
#define LOW(S, q8, H) ((v4u){pk2(S[(q8)] - bfl((H).x), S[(q8) + 1] - bfh((H).x)), pk2(S[(q8) + 2] - bfl((H).y), S[(q8) + 3] - bfh((H).y)), pk2(S[(q8) + 4] - bfl((H).z), S[(q8) + 5] - bfh((H).z)), pk2(S[(q8) + 6] - bfl((H).w), S[(q8) + 7] - bfh((H).w))})
#define CUM6(X00, X01, X10, X11) do { c0 = __builtin_amdgcn_mfma_f32_32x32x16_bf16(T0, X00, c0, 0, 0, 0); c0 = __builtin_amdgcn_mfma_f32_32x32x16_bf16(T1, X01, c0, 0, 0, 0); \
            c1 = __builtin_amdgcn_mfma_f32_32x32x16_bf16(T0, X10, c1, 0, 0, 0); c1 = __builtin_amdgcn_mfma_f32_32x32x16_bf16(T1, X11, c1, 0, 0, 0); } while (0)
            bf16x8 T0, T1;
            { int lt = lane; asm volatile("" : "+v"(lt)); const int rt = lt & 31, ht = lt >> 5;
#pragma unroll
              for (int j = 0; j < 8; ++j) { const int ko = 8 * (j >> 2) + 4 * ht + (j & 3); T0[j] = (ko > rt) ? (short)0x3F80 : (short)0; T1[j] = (16 + ko > rt) ? (short)0x3F80 : (short)0; } }
            const v4u h00 = HIW(s0, 0), h01 = HIW(s0, 8), h10 = HIW(s1, 0), h11 = HIW(s1, 8);
            CUM6(__builtin_bit_cast(bf16x8, h00), __builtin_bit_cast(bf16x8, h01), __builtin_bit_cast(bf16x8, h10), __builtin_bit_cast(bf16x8, h11));
            const v4u l00 = LOW(s0, 0, h00), l01 = LOW(s0, 8, h01), l10 = LOW(s1, 0, h10), l11 = LOW(s1, 8, h11);
            CUM6(__builtin_bit_cast(bf16x8, l00), __builtin_bit_cast(bf16x8, l01), __builtin_bit_cast(bf16x8, l10), __builtin_bit_cast(bf16x8, l11));
#undef HIW
#undef LOW
#undef CUM6
        }
#pragma unroll
        for (int i = 0; i < 16; ++i) { c0[i] = __builtin_amdgcn_exp2f(c0[i]); c1[i] = __builtin_amdgcn_exp2f(c1[i]); }
#pragma unroll
        for (int kq = 0; kq < 4; ++kq) {
            const bf16x8 wa = (kq & 2) ? pack8(c1[8 * (kq & 1)], c1[8 * (kq & 1) + 1], c1[8 * (kq & 1) + 2], c1[8 * (kq & 1) + 3], c1[8 * (kq & 1) + 4], c1[8 * (kq & 1) + 5], c1[8 * (kq & 1) + 6], c1[8 * (kq & 1) + 7])
                                       : pack8(c0[8 * (kq & 1)], c0[8 * (kq & 1) + 1], c0[8 * (kq & 1) + 2], c0[8 * (kq & 1) + 3], c0[8 * (kq & 1) + 4], c0[8 * (kq & 1) + 5], c0[8 * (kq & 1) + 6], c0[8 * (kq & 1) + 7]);
#pragma unroll
            for (int db = 0; db < 2; ++db) {
                LAS unsigned char* vp = vl + trb + 16 * kq * VPITCH + 64 * db;
                const v4i16_t lo = __builtin_amdgcn_ds_read_tr16_b64_v4i16((LAS v4i16_t*)vp), hi = __builtin_amdgcn_ds_read_tr16_b64_v4i16((LAS v4i16_t*)(vp + 8 * VPITCH));
                const bf16x8 vf = {lo[0], lo[1], lo[2], lo[3], hi[0], hi[1], hi[2], hi[3]};
                if (db == 0) o0 = __builtin_amdgcn_mfma_f32_32x32x16_bf16(wa, vf, o0, 0, 0, 0); else o1 = __builtin_amdgcn_mfma_f32_32x32x16_bf16(wa, vf, o1, 0, 0, 0);
            }
        }
        if (__all(carry < SB_EXIT)) break;
    }
#undef AT_LOADV
#undef AT_LOADK
    int lz = lane; asm volatile("" : "+v"(lz));
    bf16* op = ycat + (size_t)(b * SEQ + t0 + 4 * (lz >> 5)) * D + h * 64 + (lz & 31);
#pragma unroll
    for (int i = 0; i < 16; ++i) { const int q = crow(i, 0); op[(size_t)q * D] = (bf16)f2bf(o0[i]); op[(size_t)q * D + 32] = (bf16)f2bf(o1[i]); }
    LDS_WAIT(); asm volatile("" ::: "memory");
}
__device__ __forceinline__ void mixer_b(const Frame& F, int l, int nrep_s, int nrep_a) {
    for (int rep = 0; rep < nrep_s; ++rep)
    for (int u = blockIdx.x; u < NCHUNK; u += F.G) { ssm_pass1_unit(F, l, u); conv_unit(F, l, u); }
    __syncthreads();
    LAS unsigned char* vl = F.lds + 32768 + F.wave * (64 * VPITCH);
    const int gw = blockIdx.x * NWAVES + F.wave, NGW = F.G * NWAVES;
    for (int rep = 0; rep < nrep_a; ++rep)
    for (int uidx = gw; uidx < BATCH * NHEAD * (SEQ / 32); uidx += NGW) attn_unit(F, uidx, vl);
}

__device__ __forceinline__ void ssm_pass2_unit(const Frame& F, int l, int unit) {
    const bf16* proj = (const bf16*)(F.ws + WS_BIG); bf16* ycat = (bf16*)(F.ws + F.ycat_off);
    const unsigned char* tab = F.ws + WS_TAB + (size_t)l * TAB_STRIDE;
    const float* dsk = F.in[I_SSM_D] + l * 256;
    const bf16* wglu = (const bf16*)(F.ws + WS_WGLU0 + (size_t)l * WS_LSTRIDE);
    LAS float* bu = (LAS float*)(F.lds + F.wave * (16 * BUP * 4));
    LAS unsigned char* sst = (LAS unsigned char*)bu;
    LAS unsigned char* yg = F.lds + 8 * (16 * BUP * 4);
    const int lane = F.lane, p = lane, tok0 = unit * 64, cfirst = unit & ~63;
    float s0r = 0.f, s0i = 0.f, s1r = 0.f, s1i = 0.f;
    { const f32x4 ab0 = ((const f32x4*)(tab + TAB_ABAR))[(F.wave * 2) * 64 + p], ab1 = ((const f32x4*)(tab + TAB_ABAR))[(F.wave * 2 + 1) * 64 + p];
      const float2* ep = (const float2*)(F.ws + WS_E) + (size_t)(F.wave * 2) * 64 + p;
      float2 e0[8], e1[8], f0[8], f1[8];
#define HORNER_LOAD(A0, A1, CC) do { _Pragma("unroll") for (int q = 0; q < 8; ++q) { const int ci = ((CC) + q < unit) ? (CC) + q : cfirst; A0[q] = ep[(size_t)ci * 1024]; A1[q] = ep[(size_t)ci * 1024 + 64]; } } while (0)
#define HORNER_APPLY(A0, A1, CC) do { _Pragma("unroll") for (int q = 0; q < 8; ++q) if ((CC) + q < unit) { cfma(s0r, s0i, ab0.z, ab0.w, A0[q].x, A0[q].y); cfma(s1r, s1i, ab1.z, ab1.w, A1[q].x, A1[q].y); } } while (0)
      if (cfirst < unit) HORNER_LOAD(e0, e1, cfirst);
      for (int cc = cfirst; cc < unit; cc += 16) {
          if (cc + 8 < unit) HORNER_LOAD(f0, f1, cc + 8);
          asm volatile("" ::: "memory");
          HORNER_APPLY(e0, e1, cc);
          if (cc + 16 < unit) HORNER_LOAD(e0, e1, cc + 16);
          asm volatile("" ::: "memory");
          if (cc + 8 < unit) HORNER_APPLY(f0, f1, cc + 8);
      }
#undef HORNER_LOAD
#undef HORNER_APPLY
    }
    for (int gi = 0; gi < 2; ++gi) {
        const int g = F.wave * 2 + gi;
        bf16x8 bbf[8];
#pragma unroll
        for (int cb = 0; cb < 8; ++cb) bbf[cb] = ((const bf16x8*)(tab + TAB_BBF))[(g * 8 + cb) * 64 + lane];
        const f32x4 ab = ((const f32x4*)(tab + TAB_ABAR))[g * 64 + p];
        bf16x8 cb4[4];
#pragma unroll
        for (int ks = 0; ks < 4; ++ks) cb4[ks] = ((const bf16x8*)(tab + TAB_CMATB))[(g * 4 + ks) * 64 + lane];
        bf16x8 af[4]; bf16 uvs[4][4];
#pragma unroll
        for (int tb = 0; tb < 4; ++tb) { af[tb] = ssm_u_frag(proj, tok0 + tb * 16, g, lane);
#pragma unroll
            for (int r = 0; r < 4; ++r) uvs[tb][r] = proj[(size_t)(tok0 + tb * 16 + 4 * (lane >> 4) + r) * INC + C_U + g * 16 + (lane & 15)]; }
        float sr = gi ? s1r : s0r, si = gi ? s1i : s0i;
        const float dk = dsk[g * 16 + (lane & 15)];
#pragma unroll
        for (int tb = 0; tb < 4; ++tb) {
            ssm_bu_block(bu, bbf, af[tb], lane);
            { f32x2v bq[16];
#pragma unroll
              for (int tt = 0; tt < 16; ++tt) bq[tt] = *(const LAS f32x2v*)(bu + tt * BUP + 2 * p);
              LDS_WAIT(); asm volatile("" ::: "memory");
#pragma unroll
              for (int tt = 0; tt < 16; ++tt) { cfma(sr, si, ab.x, ab.y, bq[tt].x, bq[tt].y); *(LAS unsigned*)(sst + tt * (BUP * 4) + p * 4) = pk2(sr, si); } }
            pg8::f32x4 acc = {0.f, 0.f, 0.f, 0.f};
#pragma unroll
            for (int ks = 0; ks < 4; ++ks) { const bf16x8 a = *(const LAS bf16x8*)(sst + (lane & 15) * (BUP * 4) + (ks * 32 + 8 * (lane >> 4)) * 2); acc = __builtin_amdgcn_mfma_f32_16x16x32_bf16(a, cb4[ks], acc, 0, 0, 0); }
#pragma unroll
            for (int r = 0; r < 4; ++r) { const int t = tb * 16 + 4 * (lane >> 4) + r; const float y = acc[r] + dk * bf2f(uvs[tb][r]);
                const float gl = y * __builtin_amdgcn_rcpf(1.f + __builtin_amdgcn_exp2f(-2.3022081986f * (y + 0.044715f * y * y * y)));
                *(LAS bf16*)(yg + t * 528 + (g * 16 + (lane & 15)) * 2) = (bf16)f2bf(gl); }
        }
        LDS_WAIT(); asm volatile("" ::: "memory");
    }
    const int n0 = 32 * F.wave, r32 = lane & 31, hh = lane >> 5;
    bf16x8 wfr[16];
    { const bf16* wrow = wglu + (size_t)(n0 + r32) * 256 + 8 * hh;
#pragma unroll
      for (int ks = 0; ks < 16; ++ks) wfr[ks] = *(const bf16x8*)(wrow + 16 * ks); }
    __syncthreads();
    {
        f32x16 a0 = {}, a1 = {};
#pragma unroll
        for (int ks = 0; ks < 16; ++ks) {
            const bf16x8 bfr = wfr[ks];
            const bf16x8 x0 = *(const LAS bf16x8*)(yg + r32 * 528 + (16 * ks + 8 * hh) * 2), x1 = *(const LAS bf16x8*)(yg + (32 + r32) * 528 + (16 * ks + 8 * hh) * 2);
            a0 = __builtin_amdgcn_mfma_f32_32x32x16_bf16(x0, bfr, a0, 0, 0, 0); a1 = __builtin_amdgcn_mfma_f32_32x32x16_bf16(x1, bfr, a1, 0, 0, 0);
        }
#pragma unroll
        for (int r = 0; r < 16; ++r) { const int t = crow(r, hh);
            { const float yv = bf2f(*(const LAS bf16*)(yg + t * 528 + (n0 + r32) * 2)); ycat[(size_t)(tok0 + t) * D + 512 + n0 + r32] = (bf16)f2bf(yv * __builtin_amdgcn_rcpf(1.f + __builtin_amdgcn_exp2f(-1.4426950409f * a0[r]))); }
            { const float yv = bf2f(*(const LAS bf16*)(yg + (32 + t) * 528 + (n0 + r32) * 2)); ycat[(size_t)(tok0 + 32 + t) * D + 512 + n0 + r32] = (bf16)f2bf(yv * __builtin_amdgcn_rcpf(1.f + __builtin_amdgcn_exp2f(-1.4426950409f * a1[r]))); } }
    }
    __syncthreads();
}

__device__ __forceinline__ void moe_gather(const Frame& F) {
    LAS int* cnt = (LAS int*)F.lds;
    LAS int* tot = (LAS int*)(F.lds + 16384);
    LAS int* slot_l = (LAS int*)(F.lds + 16384 + 256);
    const int2* topi = (const int2*)(F.ws + WS_TOPI);
    const unsigned char* xn = F.ws + WS_XNN; unsigned char* xs = F.ws + WS_XS;
    {   int c0 = 0, c1 = 0, c2 = 0, c3 = 0, c4 = 0, c5 = 0, c6 = 0, c7 = 0;
        for (int k = 0; k < 32; ++k) { const int2 ti = topi[F.tid * 32 + k];
            c0 += (ti.x == 0) + (ti.y == 0); c1 += (ti.x == 1) + (ti.y == 1); c2 += (ti.x == 2) + (ti.y == 2); c3 += (ti.x == 3) + (ti.y == 3);
            c4 += (ti.x == 4) + (ti.y == 4); c5 += (ti.x == 5) + (ti.y == 5); c6 += (ti.x == 6) + (ti.y == 6); c7 += (ti.x == 7) + (ti.y == 7); }
        cnt[0 * 512 + F.tid] = c0; cnt[1 * 512 + F.tid] = c1; cnt[2 * 512 + F.tid] = c2; cnt[3 * 512 + F.tid] = c3;
        cnt[4 * 512 + F.tid] = c4; cnt[5 * 512 + F.tid] = c5; cnt[6 * 512 + F.tid] = c6; cnt[7 * 512 + F.tid] = c7; }
    __syncthreads();
    {   LAS int* ce = cnt + F.wave * 512 + F.lane * 8;
        int v[8], s = 0;
#pragma unroll
        for (int q = 0; q < 8; ++q) { v[q] = ce[q]; s += v[q]; }
        int inc = s;
#pragma unroll
        for (int d = 1; d < 64; d <<= 1) { const int y = __shfl_up(inc, d); if (F.lane >= d) inc += y; }
        int run = inc - s;
#pragma unroll
        for (int q = 0; q < 8; ++q) { ce[q] = run; run += v[q]; }
        if (F.lane == 63) tot[F.wave] = inc; }
    __syncthreads();
    int seg[8]; { int a = 0;
#pragma unroll
        for (int e = 0; e < 8; ++e) { seg[e] = a; a += (tot[e] + 255) & ~255; } }
    if (blockIdx.x == 0 && F.tid < 8) __hip_atomic_store(F.ctl + CW_MOECNT + F.tid, (unsigned)tot[F.tid], RLX_AGENT);
    for (int u = blockIdx.x; u < NCHUNK; u += F.G) {
        if (F.wave == 0) {
            const int tk = 64 * u + F.lane, tp = tk >> 5; const int2 ti = topi[tk];
            const unsigned long long low = ((1ull << F.lane) - 1ull) & (F.lane >= 32 ? 0xFFFFFFFF00000000ull : 0x00000000FFFFFFFFull);
            int s1 = 0, s2 = 0;
#pragma unroll
            for (int e = 0; e < 8; ++e) { const unsigned long long mk = __ballot(ti.x == e || ti.y == e); const int within = __popcll(mk & low); const int pos = seg[e] + cnt[e * 512 + tp] + within;
                if (ti.x == e) s1 = pos; if (ti.y == e) s2 = pos; }
            ((int2*)(F.ws + WS_SLOT))[tk] = make_int2(s1, s2);
            slot_l[F.lane * 2] = s1; slot_l[F.lane * 2 + 1] = s2;
        }
        __syncthreads();
        {   v4u ra[8];
#pragma unroll
            for (int j = 0; j < 8; ++j) ra[j] = ((const v4u*)(xn + (size_t)(64 * u + F.wave * 8 + j) * D))[F.lane];
#pragma unroll
            for (int j = 0; j < 8; ++j) { const int s1 = slot_l[(F.wave * 8 + j) * 2], s2 = slot_l[(F.wave * 8 + j) * 2 + 1];
                ((v4u*)(xs + (size_t)s1 * D))[F.lane] = ra[j]; ((v4u*)(xs + (size_t)s2 * D))[F.lane] = ra[j]; }
        }
        __syncthreads();
    }
}
template <bool TS> struct MoeOrder {
    static constexpr bool VARK = TS;
    int nM, nN, G, c; int cs[9]; int nfull, nsplit, ntk, parts;
    __device__ __forceinline__ void init(unsigned* cntw, int nN_, int G_, int c_, int ntk_) { nN = nN_; G = G_; c = c_; ntk = ntk_; cs[0] = 0;
#pragma unroll
        for (int e = 0; e < 8; ++e) cs[e + 1] = cs[e] + (int)((__hip_atomic_load(cntw + e, RLX_AGENT) + 255u) >> 8);
        nM = cs[8]; const int total = nM * nN; nfull = TS ? (total / G) * G : total; nsplit = total - nfull;
        if (nsplit > 32) { nfull = total; nsplit = 0; }
        parts = 2; }
    __device__ __forceinline__ bool next(int i, pg8::Unit& u) const {
        const long L = (long)i * G + c; if (L >= (long)nfull + parts * nsplit) return false;
        int base = (int)L; u.nt = ntk; u.koff = 0; u.aux = -1;
        if (TS && L >= nfull) { const int q = ((int)L - nfull) / parts, part = ((int)L - nfull) % parts; base = nfull + q; u.nt = ntk / parts; u.koff = part * (ntk / parts) * 128; u.aux = part ? q * 3 + part - 1 : -1; }
        pg8::order_map(base, nM, nN, u);
        int e = 0;
#pragma unroll
        for (int k = 1; k < 8; ++k) e += (u.pm >= cs[k]) ? 1 : 0;
        u.pn += e * nN; return true; }
    __device__ __forceinline__ void a_ready(const pg8::Unit&) const {}
    __device__ __forceinline__ void done(const pg8::Unit&) const {}
};
__device__ __forceinline__ void final_rows(const Frame& F) {
    const int gw = F.vcu * NWAVES + F.wave, NGW = F.G * NWAVES;
    const bf16* H = (const bf16*)(F.ws + WS_XN); const bf16* ys = (const bf16*)(F.ws + WS_YS); const bf16* y2 = (const bf16*)(F.ws + WS_Y2);
    const int2* slot = (const int2*)(F.ws + WS_SLOT); const float2* tw = (const float2*)(F.ws + WS_TOPW);
    LAS int* stab = (LAS int*)F.lds;
    int nside;
    { MoeOrder<true> S; S.init(F.ctl + CW_MOECNT, D / 256, F.G, 0, FF / 128); nside = S.parts - 1;
      for (int i = F.tid; i < S.nM * 4; i += NTHR) stab[i] = -1;
      __syncthreads();
      for (int q = F.tid; q < S.nsplit; q += NTHR) { pg8::Unit u; pg8::order_map(S.nfull + q, S.nM, 4, u); stab[u.pm * 4 + u.pn] = q; }
      __syncthreads(); }
    f32x4 gv[4];
#pragma unroll
    for (int j = 0; j < 4; ++j) gv[j] = ((const f32x4*)F.in[I_FINAL_NORM])[F.lane + 64 * j];
    for (int m = gw; m < M; m += NGW) {
        const int2 sl = slot[m]; const float2 w = tw[m];
        const v2u* xr = (const v2u*)(H + (size_t)m * D) + F.lane;
        const v2u* y1p = (const v2u*)(ys + (size_t)sl.x * D) + F.lane; const v2u* y2p = (const v2u*)(ys + (size_t)sl.y * D) + F.lane;
        f32x4 v[4]; float s = 0.f;
#pragma unroll
        for (int j = 0; j < 4; ++j) { const v2u a = y1p[64 * j], b = y2p[64 * j];
            f32x4 ya = (f32x4){bfl(a.x), bfh(a.x), bfl(a.y), bfh(a.y)}, yb = (f32x4){bfl(b.x), bfh(b.x), bfl(b.y), bfh(b.y)};
            const int qa = stab[(sl.x >> 8) * 4 + j], qb = stab[(sl.y >> 8) * 4 + j];
            if (qa >= 0) { for (int pc = 0; pc < nside; ++pc) { const v2u t = *((const v2u*)(y2 + (size_t)(qa * 3 + pc) * 65536 + (size_t)(sl.x & 255) * 256) + F.lane); ya += (f32x4){bfl(t.x), bfh(t.x), bfl(t.y), bfh(t.y)}; } }
            if (qb >= 0) { for (int pc = 0; pc < nside; ++pc) { const v2u t = *((const v2u*)(y2 + (size_t)(qb * 3 + pc) * 65536 + (size_t)(sl.y & 255) * 256) + F.lane); yb += (f32x4){bfl(t.x), bfh(t.x), bfl(t.y), bfh(t.y)}; } }
            const v2u hx = xr[64 * j];
            v[j] = (f32x4){bfl(hx.x), bfh(hx.x), bfl(hx.y), bfh(hx.y)} + w.x * ya + w.y * yb;
            s += (v[j].x * v[j].x + v[j].y * v[j].y) + (v[j].z * v[j].z + v[j].w * v[j].w); }
        const float rstd = 1.0f / sqrtf(wave_sum(s) * (1.0f / D) + EPS);
        f32x4* o = (f32x4*)(F.out + (size_t)m * D) + F.lane;
#pragma unroll
        for (int j = 0; j < 4; ++j) o[64 * j] = v[j] * rstd * gv[j];
    }
}

constexpr int RTAB_OFF = MISC_OFF + 1024;
__device__ __forceinline__ void build_rstd_tables(const Frame& F, const pg8::StaticOrder& S, const float* ssp) {
    LAS float* rtab = (LAS float*)(F.lds + RTAB_OFF);
    const int r = F.tid & 255, ih = F.tid >> 8;
    f32x4 pa[4][4]; bool ok[4];
#pragma unroll
    for (int k = 0; k < 4; ++k) { pg8::Unit u; ok[k] = S.next(2 * k + ih, u); const int pm = ok[k] ? u.pm : 0;
        const f32x4* p = (const f32x4*)(ssp + (size_t)(pm * 256 + r) * 16);
#pragma unroll
        for (int q = 0; q < 4; ++q) pa[k][q] = p[q]; }
#pragma unroll
    for (int k = 0; k < 4; ++k) if (ok[k]) {
        const float P0 = (pa[k][0][0] + pa[k][0][1]) + (pa[k][0][2] + pa[k][0][3]), P1 = (pa[k][1][0] + pa[k][1][1]) + (pa[k][1][2] + pa[k][1][3]);
        const float P2 = (pa[k][2][0] + pa[k][2][1]) + (pa[k][2][2] + pa[k][2][3]), P3 = (pa[k][3][0] + pa[k][3][1]) + (pa[k][3][2] + pa[k][3][3]);
        rtab[(2 * k + ih) * 256 + r] = __builtin_amdgcn_rsqf(((P0 + P1) + (P2 + P3)) * (1.0f / 1024.0f) + 1e-6f); }
    __syncthreads();
}

#ifndef PHMASK
#define PHMASK 0xFFFFu
#endif
#define EN(b) ((PHMASK >> (b)) & 1u)
#ifndef PROBE_MASK
#define PROBE_MASK 0u
#endif
#define NREP(b) (1 + (int)((PROBE_MASK >> (b)) & 1u))
constexpr int PH_PRO = 0, PH_L = 1, PH_PER_LAYER = 10, PH_FINAL = 21, NPH = 22;
__global__ void __launch_bounds__(NTHR, 2) mk_fwd(Args args) {
    extern __shared__ __attribute__((aligned(16))) unsigned char lds_raw[];
    Frame F;
    F.lds = (LAS unsigned char*)lds_raw;
    F.tid = threadIdx.x; F.lane = F.tid & 63; F.wave = __builtin_amdgcn_readfirstlane(F.tid >> 6);
    F.G = gridDim.x; { const int bx = blockIdx.x; F.vcu = (F.G % 8 == 0) ? (bx % 8) * (F.G / 8) + bx / 8 : bx; }
    F.ws = args.ws; F.ctl = (unsigned*)(args.ws + WS_CTL); F.in = args.in; F.out = args.out;
    volatile LAS unsigned* MISC = (volatile LAS unsigned*)(F.lds + MISC_OFF);
    for (int u = F.tid; u < (LDS_BYTES - MISC_OFF) / 4; u += NTHR) MISC[u] = 0u;
    __syncthreads();
    const int lo = args.ph_lo, hi = args.ph_hi;
    XcdBarrier bar; bar.bar = F.ctl + CW_BAR; bar.x = 0; bar.st = nullptr;
    if (hi - lo > 1) bar = xcd_barrier_post(F.ctl + CW_BAR, MISC + 8);
#define IN(k) (lo <= (k) && (k) < hi)
#define FRESH() do { int tz_ = threadIdx.x; asm volatile("" : "+v"(tz_)); F.tid = tz_; F.lane = tz_ & 63; F.wave = __builtin_amdgcn_readfirstlane(tz_ >> 6); } while (0)
#define SEAM(k) do { if (IN(k) && IN((k) + 1)) xcd_barrier(bar); STAMP(k); } while (0)
#define STAMP(k) tp_stamp(F.lds, (k))
    STAMP(-1);
    unsigned char* ws = args.ws;
    bf16* XN = (bf16*)(ws + WS_XN); bf16* PROJ = (bf16*)(ws + WS_BIG);

    if (EN(0) && IN(PH_PRO)) { FRESH();
        if (F.wave < 4) { cast_rows(F, F.in[I_X], XN, F.vcu * 4 + F.wave, F.G * 4); STAMP(500); }
        else { convert_jobs(F, 0, 1, 39, 40, F.vcu * 4 + F.wave - 4, F.G * 4); ssm_tables(F, F.vcu * 256 + F.tid - 256, F.G * 256); } }
    SEAM(PH_PRO);
    for (int l = 0; l < 2; ++l) {
        const int pb = PH_L + l * PH_PER_LAYER;
        unsigned char* wl = ws + (size_t)l * WS_LSTRIDE;
        F.ycat_off = l ? WS_YCAT1 : WS_YCAT0;
        bf16* YCAT = (bf16*)(ws + F.ycat_off); bf16* MERGED = (bf16*)(ws + (l ? WS_MERGED1 : WS_MERGED0));
        if (EN(1) && IN(pb + 0)) {
            pg8::Gemm g{XN, (const bf16*)(wl + WS_WIN0), M, C_G, D}; pg8::StaticOrder S; S.init(M, C_G, F.G, (int)blockIdx.x);
            FRESH(); build_rstd_tables(F, S, (const float*)(ws + WS_SSP));
            pg8::EpiProj E{PROJ, INC, 1 << 30, (const float*)(ws + WS_SSP), (const LAS float*)(F.lds + RTAB_OFF), 0, 1.f};
            for (int rep = 0; rep < NREP(1); ++rep) pg8::gemm_phase<pg8::EpiProj, pg8::StaticOrder, true, true>(F.lds, g, S, E);
            STAMP(100 + 10 * l);
            const int nfull = S.nwg % F.G;
            if (nfull != 0) { FRESH(); const int widx = ((int)blockIdx.x >= nfull) ? ((int)blockIdx.x - nfull) * NWAVES + F.wave : -1, nw = (F.G - nfull) * NWAVES;
                if (l == 0) convert_jobs(F, 1, 15, 40, 41, widx, nw); else convert_jobs(F, 23, 27, widx, nw); }
            else { FRESH(); const int widx = F.vcu * NWAVES + F.wave, nw = F.G * NWAVES; if (l == 0) convert_jobs(F, 1, 15, 40, 41, widx, nw); else convert_jobs(F, 23, 27, widx, nw); }
            __syncthreads();
            STAMP(101 + 10 * l);
            pg8::Gemm g8{(const bf16*)(ws + WS_HB8), (const bf16*)(wl + WS_WING8), M, INC - C_G, D / 2}; pg8::StaticOrder S8; S8.init(M, INC - C_G, F.G, (int)blockIdx.x);
            FRESH(); build_rstd_tables(F, S8, (const float*)(ws + WS_SSP));
            pg8::EpiProj E8{PROJ, INC, 0, (const float*)(ws + WS_SSP), (const LAS float*)(F.lds + RTAB_OFF), C_G, 1.0f / (SC_XS * SC_W)};
            for (int rep = 0; rep < NREP(1); ++rep) pg8::gemm_phase<pg8::EpiProj, pg8::StaticOrder, true, true, true>(F.lds, g8, S8, E8);
            STAMP(103 + 10 * l);
        }
        SEAM(pb + 0);
        if (EN(2) && IN(pb + 1)) { FRESH(); mixer_b(F, l, NREP(9), NREP(2)); }
        SEAM(pb + 1);
        if (EN(3) && IN(pb + 2)) { FRESH(); for (int rep = 0; rep < NREP(3); ++rep) for (int u = blockIdx.x; u < NCHUNK; u += F.G) ssm_pass2_unit(F, l, u); STAMP(202 + 10 * l); }
        SEAM(pb + 2);
        if (EN(4) && IN(pb + 3)) {
            pg8::Gemm g{YCAT, (const bf16*)(wl + WS_WCAT0), M, D, D}; pg8::StaticOrder S; S.init(M, D, F.G, (int)blockIdx.x);
            pg8::EpiBranch E{PROJ + C_G, INC, MERGED, D};
            for (int rep = 0; rep < NREP(4); ++rep) pg8::gemm_phase<pg8::EpiBranch, pg8::StaticOrder, false, true>(F.lds, g, S, E);
            STAMP(300 + 10 * l);
        }
        SEAM(pb + 3);
        if (EN(5) && IN(pb + 4)) {
            pg8::Gemm g{MERGED, (const bf16*)(wl + WS_WOUT0), M, D, D}; pg8::StaticOrder S; S.init(M, D, F.G, (int)blockIdx.x);
            if (l == 0) { pg8::EpiResid<1, false> E{F.in[I_X], (pg8::bf16_t*)XN, D, (float*)(ws + WS_SSP), nullptr, 1.f, 1.f};
                pg8::gemm_phase<pg8::EpiResid<1, false>, pg8::StaticOrder, false, true>(F.lds, g, S, E); }
            else { for (int rep = 0; rep < NREP(5); ++rep) { pg8::EpiResid<0, true> E{XN, (rep + 1 < NREP(5)) ? (pg8::bf16_t*)PROJ : (pg8::bf16_t*)XN, D, nullptr, nullptr, 1.f, 1.f};
                pg8::gemm_phase<pg8::EpiResid<0, true>, pg8::StaticOrder, false, true>(F.lds, g, S, E); } }
        }
        SEAM(pb + 4);
        if (l == 0) {
            if (EN(7) && IN(pb + 6)) {
                pg8::Gemm g{XN, (const bf16*)(ws + WS_WGU0), M, 2 * FF, D}; pg8::StaticOrder S; S.init(M, 2 * FF, F.G, (int)blockIdx.x);
                FRESH(); build_rstd_tables(F, S, (const float*)(ws + WS_SSP));
                pg8::EpiSwiglu<true, true> E{PROJ, FF, 2 * FF / 256, (const float*)(ws + WS_SSP), (const LAS float*)(F.lds + RTAB_OFF), SC_ACT};
                for (int rep = 0; rep < NREP(7); ++rep) pg8::gemm_phase<pg8::EpiSwiglu<true, true>, pg8::StaticOrder, true, true>(F.lds, g, S, E);
            }
            SEAM(pb + 6);
            if (EN(8) && IN(pb + 7)) {
                pg8::Gemm g{PROJ, (const bf16*)(ws + WS_WD0), M, D, FF / 2}; pg8::StaticOrder S; S.init(M, D, F.G, (int)blockIdx.x);
                pg8::EpiResid<3, true> E{XN, (pg8::bf16_t*)XN, D, (float*)(ws + WS_SSP), ws + WS_HB8, SC_XS, 1.0f / (SC_ACT * SC_W)};
                pg8::gemm_phase<pg8::EpiResid<3, true>, pg8::StaticOrder, false, true, true>(F.lds, g, S, E);
            }
            SEAM(pb + 7);
        } else {
            if (EN(10) && IN(pb + 5)) { FRESH(); router_fill(F);
                if (F.wave < 3) norm_rows<true>(F, XN, F.in[I_NORM_FFN] + D, (bf16*)(ws + WS_XNN), F.vcu * 3 + F.wave, F.G * 3);
                else convert_jobs(F, 15, 23, 27, 39, F.vcu * 5 + F.wave - 3, F.G * 5);
                STAMP(400); }
            SEAM(pb + 5);
            if (EN(11) && IN(pb + 6)) { FRESH(); for (int rep = 0; rep < NREP(11); ++rep) moe_gather(F); }
            SEAM(pb + 6);
            if (EN(12) && IN(pb + 7)) {
                pg8::Gemm g{(const bf16*)(ws + WS_XS), (const bf16*)(ws + WS_WMOE), MPAD, 2 * FF, D / 2}; MoeOrder<false> S; S.init(F.ctl + CW_MOECNT, 2 * FF / 256, F.G, (int)blockIdx.x, D / 128);
                pg8::EpiSwiglu8 E{ws + WS_ACTM, FF, 2 * FF / 256, -1.4426950408889634f / (SC_XS * SC_W), (SC_XS * SC_W) * (SC_XS * SC_W) / SC_ACT};
                for (int rep = 0; rep < NREP(12); ++rep) pg8::gemm_phase<pg8::EpiSwiglu8, MoeOrder<false>, true, true, true>(F.lds, g, S, E);
            }
            if (IN(pb + 7) && IN(pb + 9)) xcd_barrier(bar);
            STAMP(pb + 7);
            if (EN(14) && IN(pb + 9)) {
                pg8::Gemm g{(const bf16*)(ws + WS_ACTM), (const bf16*)(ws + WS_WD8), MPAD, D, FF / 2}; MoeOrder<true> S; S.init(F.ctl + CW_MOECNT, D / 256, F.G, (int)blockIdx.x, FF / 128);
                pg8::EpiMoeDown E{(bf16*)(ws + WS_YS), D, D / 256, (bf16*)(ws + WS_Y2), 1.0f / (SC_ACT * SC_W)};
                for (int rep = 0; rep < NREP(14); ++rep) pg8::gemm_phase<pg8::EpiMoeDown, MoeOrder<true>, true, true, true>(F.lds, g, S, E);
            }
            SEAM(pb + 9);
        }
    }
    if (EN(15) && IN(PH_FINAL)) { FRESH(); for (int rep = 0; rep < NREP(15); ++rep) final_rows(F); }
    STAMP(PH_FINAL);
    if (TP_A != -2 && blockIdx.x == 0 && threadIdx.x == 0) { const long long tend = wall_clock64(), hold = (*(volatile LAS long long*)(F.lds + 140296) - *(volatile LAS long long*)(F.lds + 140288)) * TP_MUL; while (wall_clock64() - tend < hold) __builtin_amdgcn_s_sleep(32); }
#undef IN
#undef SEAM
}

extern "C" void kernel_launch(void* const* d_in, const int* in_sizes, int n_in, void* d_out, int out_size, void* d_ws, size_t ws_size, hipStream_t stream) {
    static int grid = 0;
    if (grid == 0) {
        if (n_in != 26 || in_sizes[0] != M * D || out_size != M * D || ws_size < WS_END) { fprintf(stderr, "kernel_launch: unexpected shapes (n_in %d, in0 %d, out %d, ws %zu < %zu); nothing launched\n", n_in, n_in > 0 ? in_sizes[0] : -1, out_size, ws_size, (size_t)WS_END); grid = -1; return; }
        int dev = 0, cus = 0;
        if (hipGetDevice(&dev) != hipSuccess || hipDeviceGetAttribute(&cus, hipDeviceAttributeMultiprocessorCount, dev) != hipSuccess) { fprintf(stderr, "kernel_launch: device query failed\n"); grid = -1; return; }
        if (hipFuncSetAttribute((const void*)mk_fwd, hipFuncAttributeMaxDynamicSharedMemorySize, LDS_BYTES) != hipSuccess) { fprintf(stderr, "kernel_launch: hipFuncSetAttribute failed\n"); grid = -1; return; }
        int per_cu = 0;
        if (hipOccupancyMaxActiveBlocksPerMultiprocessor(&per_cu, (const void*)mk_fwd, NTHR, LDS_BYTES) != hipSuccess || per_cu < 1) fprintf(stderr, "kernel_launch: occupancy query reports %d blocks per CU\n", per_cu);
        (void)hipGetLastError();
        grid = cus;
    }
    if (grid < 0) return;
    if (hipMemsetAsync((char*)d_ws + WS_CTL, 0, CTL_ZERO_BYTES, stream) != hipSuccess) { fprintf(stderr, "kernel_launch: memset failed\n"); return; }
    Args a{};
    for (int i = 0; i < 26; ++i) a.in[i] = (const float*)d_in[i];
    a.out = (float*)d_out; a.ws = (unsigned char*)d_ws;
#if MK_ONE_LAUNCH
    a.ph_lo = 0; a.ph_hi = NPH;
    hipLaunchKernelGGL(mk_fwd, dim3(grid), dim3(NTHR), LDS_BYTES, stream, a);
#else
    for (int ph = 0; ph < NPH; ++ph) {
        if (ph == PH_L + 9) continue;
        a.ph_lo = ph; a.ph_hi = ph + 1;
        hipLaunchKernelGGL(mk_fwd, dim3(grid), dim3(NTHR), LDS_BYTES, stream, a);
    }
#endif
    const hipError_t le = hipPeekAtLastError();
    if (le != hipSuccess) fprintf(stderr, "kernel_launch: launch failed: %s\n", hipGetErrorName(le));
}
```

```cpp
#include <hip/hip_runtime.h>
#include <cstdio>
#include <cstdint>

#ifndef MK_ONE_LAUNCH
#define MK_ONE_LAUNCH 1
#endif

namespace pg8 {
#define PG8_LAS __attribute__((address_space(3)))
typedef unsigned short bf16_t;
typedef short bf16x8 __attribute__((ext_vector_type(8)));
typedef float f32x4 __attribute__((ext_vector_type(4)));
typedef float f32x2 __attribute__((ext_vector_type(2)));
typedef unsigned u32x4 __attribute__((ext_vector_type(4)));
constexpr int BM = 256, BK = 64, HALF = 128, HTB = HALF * BK * 2  , STAGE_BYTES = 8 * HTB, NXCD = 8, WGM = 8;

__host__ __device__ __forceinline__ int lds_byte(int r, int c) { const int st = (r >> 4) * 2 + (c >> 5), rr = r & 15, cc = c & 31, ob = rr * 64 + cc * 2; return st * 1024 + (ob ^ (((ob >> 9) & 1) << 5)); }
__host__ __device__ __forceinline__ void stage_rc(int b, int& R, int& C) { const int st = b / 1024, sb = b % 1024, swz = sb ^ (((sb >> 9) & 1) << 5); R = (st >> 1) * 16 + swz / 64; C = (st & 1) * 32 + (swz % 64) / 2; }
__host__ __device__ __forceinline__ int perm32(int rho) { const int n = rho >> 4, i = rho & 15; return 8 * (i >> 2) + 4 * n + (i & 3); }

struct Unit { int pm, pn; int nt, koff, aux; };
struct Gemm { const bf16_t* A; const bf16_t* Bt; int M, N, K; };

__host__ __device__ __forceinline__ void order_map(int L, int nM, int nN, Unit& u) {
    const int nwg = nM * nN;
    int wgid = L; { const int q = nwg / NXCD, r = nwg % NXCD, xcd = wgid % NXCD, off = wgid / NXCD; wgid = (xcd < r ? xcd * (q + 1) : r * (q + 1) + (xcd - r) * q) + off; }
    const int nig = WGM * nN, gid = wgid / nig, fm = gid * WGM, gsz = (nM - fm) < WGM ? (nM - fm) : WGM;
    u.pm = fm + ((wgid % nig) % gsz); u.pn = (wgid % nig) / gsz;
}
struct StaticOrder {
    static constexpr bool VARK = false;
    int nM, nN, nwg, G, c;
    __host__ __device__ void init(int M, int N, int G_, int c_) { nM = M / BM; nN = N / BM; nwg = nM * nN; G = G_; c = c_; }
    __host__ __device__ bool next(int i, Unit& u) const {
        const long L = (long)i * G + c; if (L >= nwg) return false;
        order_map((int)L, nM, nN, u); u.aux = i; return true;
    }
    __device__ __forceinline__ void a_ready(const Unit&) const {}
    __device__ __forceinline__ void done(const Unit&) const {}
};
typedef __bf16 bf16x2n __attribute__((ext_vector_type(2)));
__device__ __forceinline__ unsigned cvt_pk_bf16(float lo, float hi) { const f32x2 v = {lo, hi}; return __builtin_bit_cast(unsigned, __builtin_convertvector(v, bf16x2n)); }

template <class Epi, class Sched, bool ALIGN_EPI = false, bool SP2 = false, bool FP8 = false>
__device__ __forceinline__ void gemm_phase(PG8_LAS unsigned char* lds, const Gemm g, const Sched& S, const Epi& E) {
    int tid_ = threadIdx.x; asm volatile("" : "+v"(tid_));
    const int tid = tid_, wid = __builtin_amdgcn_readfirstlane(tid >> 6), lane = tid & 63, wr = wid >> 2, wc = wid & 3, fr = lane & 15, fq = lane >> 4;
    const int K = g.K, nt = K / BK;
    unsigned voffA[2], voffB[2];
#pragma unroll
    for (int i = 0; i < 2; ++i) { int R, C; stage_rc(tid * 16 + i * 8192, R, C); const int Rb = Epi::PERM ? ((R & ~31) + perm32(R & 31)) : R;
        voffA[i] = (unsigned)(R * K + C) * 2u; voffB[i] = (unsigned)(Rb * K + C) * 2u; }
    const size_t kstep = (size_t)(BK * 2);
    const size_t hstep = (size_t)HALF * K * 2;
    const size_t tstep = 2 * hstep;
    const unsigned ldsw = (unsigned)wid * 1024u;
    const int aoff = lds_byte(wr * 64 + fr, fq * 8), boff = lds_byte(wc * 32 + fr, fq * 8);
#define PG8_SA(b, h) (((b) * 2 + (h)) * HTB)
#define PG8_SB(b, h) ((4 + (b) * 2 + (h)) * HTB)
#define PG8_STAGE(bufoff, gbase, voff) do { _Pragma("unroll") for (int _i = 0; _i < 2; ++_i) \
        __builtin_amdgcn_global_load_lds((const unsigned*)((const char*)(gbase) + (voff)[_i]), (PG8_LAS unsigned*)(lds + (bufoff) + ldsw + _i * 8192), 16, 0, 0); } while (0)
#define PG8_LDA(dst, b, h) do { _Pragma("unroll") for (int m = 0; m < 4; ++m) { if constexpr (FP8) { dst##w[m] = __builtin_shufflevector(*(const PG8_LAS bf16x8*)(lds + PG8_SA(b, h) + aoff + m * 2048), *(const PG8_LAS bf16x8*)(lds + PG8_SA(b, h) + aoff + m * 2048 + 1024), 0, 1, 2, 3, 4, 5, 6, 7, 8, 9, 10, 11, 12, 13, 14, 15); } \
        else { _Pragma("unroll") for (int k = 0; k < 2; ++k) dst[m][k] = *(const PG8_LAS bf16x8*)(lds + PG8_SA(b, h) + aoff + m * 2048 + k * 1024); } } } while (0)
#define PG8_LDB(dst, b, h) do { _Pragma("unroll") for (int n = 0; n < 2; ++n) { if constexpr (FP8) { dst##w[n] = __builtin_shufflevector(*(const PG8_LAS bf16x8*)(lds + PG8_SB(b, h) + boff + n * 2048), *(const PG8_LAS bf16x8*)(lds + PG8_SB(b, h) + boff + n * 2048 + 1024), 0, 1, 2, 3, 4, 5, 6, 7, 8, 9, 10, 11, 12, 13, 14, 15); } \
        else { _Pragma("unroll") for (int k = 0; k < 2; ++k) dst[n][k] = *(const PG8_LAS bf16x8*)(lds + PG8_SB(b, h) + boff + n * 2048 + k * 1024); } } } while (0)
#define PG8_MMA(ai, bj, At, Bt) do { __builtin_amdgcn_s_setprio(1); _Pragma("unroll") for (int m = 0; m < 4; ++m) _Pragma("unroll") for (int n = 0; n < 2; ++n) { \
        if constexpr (FP8) { typedef int v8i_ __attribute__((ext_vector_type(8))); \
            asm volatile("v_mfma_scale_f32_16x16x128_f8f6f4 %0, %1, %2, %0, %3, %3 op_sel_hi:[0,0,0]" : "+v"(acc[ai][bj][m][n]) : "v"(__builtin_bit_cast(v8i_, Bt##w[n])), "v"(__builtin_bit_cast(v8i_, At##w[m])), "v"(sc8)); } \
        else { _Pragma("unroll") for (int k = 0; k < 2; ++k) acc[ai][bj][m][n] = __builtin_amdgcn_mfma_f32_16x16x32_bf16(Bt[n][k], At[m][k], acc[ai][bj][m][n], 0, 0, 0); } } \
        __builtin_amdgcn_s_setprio(0); } while (0)
#define PG8_WAIT_V(n) asm volatile("s_waitcnt vmcnt(" #n ")" ::: "memory")
#define PG8_WAIT_L(n) asm volatile("s_waitcnt lgkmcnt(" #n ")" ::: "memory")
#define PG8_BAR __builtin_amdgcn_s_barrier()
#define PG8_SCHED __builtin_amdgcn_sched_barrier(0)
    Unit cur, nxt; int ui = 0;
    if (!S.next(0, cur)) return;
    f32x4 acc[2][2][4][2];
#pragma unroll
    for (int a = 0; a < 2; ++a)
#pragma unroll
        for (int b = 0; b < 2; ++b)
#pragma unroll
            for (int m = 0; m < 4; ++m)
#pragma unroll
                for (int n = 0; n < 2; ++n) acc[a][b][m][n] = (f32x4){0.f, 0.f, 0.f, 0.f};
    bf16x8 At[4][2], B0[2][2], B1[2][2];
    typedef short bf16x16_ __attribute__((ext_vector_type(16))); bf16x16_ Atw[4], B0w[2], B1w[2];
    unsigned sc8 = 0x7F7F7F7Fu; asm volatile("" : "+v"(sc8));
    const char* cA = (const char*)g.A + (size_t)cur.pm * tstep; const char* cB = (const char*)g.Bt + (size_t)cur.pn * tstep;
    int cnt = nt;
    if constexpr (Sched::VARK) { cnt = cur.nt; cA += cur.koff; cB += cur.koff; }
    S.a_ready(cur);
    if constexpr (SP2) {
        PG8_STAGE(PG8_SB(0, 0), cB, voffB); PG8_STAGE(PG8_SB(0, 1), cB + hstep, voffB); PG8_STAGE(PG8_SA(0, 0), cA, voffA); PG8_STAGE(PG8_SA(0, 1), cA + hstep, voffA);
        if (wr == 1) PG8_BAR;
        PG8_WAIT_V(2); PG8_BAR;
        PG8_STAGE(PG8_SB(1, 0), cB + kstep, voffB); PG8_STAGE(PG8_SA(1, 0), cA + kstep, voffA); PG8_STAGE(PG8_SB(1, 1), cB + hstep + kstep, voffB);
        PG8_WAIT_V(6); PG8_BAR;
    } else {
        PG8_STAGE(PG8_SB(0, 0), cB, voffB); PG8_STAGE(PG8_SA(0, 0), cA, voffA); PG8_STAGE(PG8_SB(0, 1), cB + hstep, voffB); PG8_STAGE(PG8_SA(0, 1), cA + hstep, voffA);
        if (wr == 1) PG8_BAR;
        PG8_WAIT_V(4); PG8_BAR;
        PG8_STAGE(PG8_SB(1, 0), cB + kstep, voffB); PG8_STAGE(PG8_SA(1, 0), cA + kstep, voffA); PG8_STAGE(PG8_SB(1, 1), cB + hstep + kstep, voffB);
        PG8_WAIT_V(6); PG8_BAR;
    }
    for (;;) {
        const bool has_next = S.next(ui + 1, nxt);
        const char* nA = has_next ? (const char*)g.A + (size_t)nxt.pm * tstep : cA; const char* nB = has_next ? (const char*)g.Bt + (size_t)nxt.pn * tstep : cB;
        if constexpr (Sched::VARK) { if (has_next) { nA += nxt.koff; nB += nxt.koff; } }
        for (int t = 0; t < cnt; t += 2) {
            const bool last = (t == cnt - 2);
            const char* a1 = cA + (size_t)(t + 1) * kstep;
            const char* a2 = last ? nA : cA + (size_t)(t + 2) * kstep; const char* b2 = last ? nB : cB + (size_t)(t + 2) * kstep;
            const char* a3 = a2 + kstep; const char* b3 = b2 + kstep;
            if (last && has_next) S.a_ready(nxt);
            if constexpr (Epi::MIDK) { if (t == Epi::MID0 || t == Epi::MID1) { int tz_ = tid; asm volatile("" : "+v"(tz_)); const int ln_ = tz_ & 63; E.mid(acc, cur, t, wr, wc, ln_ & 15, ln_ >> 4); } }
            if constexpr (SP2) {
            PG8_LDB(B0, 0, 0); PG8_LDB(B1, 0, 1); PG8_SCHED; PG8_LDA(At, 0, 0); PG8_STAGE(PG8_SA(1, 1), a1 + hstep, voffA);
            PG8_WAIT_V(8); PG8_WAIT_L(0); PG8_BAR; PG8_MMA(0, 0, At, B0); PG8_MMA(0, 1, At, B1); PG8_BAR; PG8_SCHED;
            PG8_LDA(At, 0, 1); PG8_STAGE(PG8_SB(0, 0), b2, voffB); PG8_STAGE(PG8_SB(0, 1), b2 + hstep, voffB); PG8_STAGE(PG8_SA(0, 0), a2, voffA);
            PG8_WAIT_V(8); PG8_WAIT_L(0); PG8_BAR; PG8_MMA(1, 0, At, B0); PG8_MMA(1, 1, At, B1); PG8_BAR; PG8_SCHED;
            PG8_LDB(B0, 1, 0); PG8_LDB(B1, 1, 1); PG8_SCHED; PG8_LDA(At, 1, 0); PG8_STAGE(PG8_SA(0, 1), a2 + hstep, voffA);
            PG8_WAIT_V(8); PG8_WAIT_L(0); PG8_BAR; PG8_MMA(0, 0, At, B0); PG8_MMA(0, 1, At, B1); PG8_BAR; PG8_SCHED;
            PG8_LDA(At, 1, 1); PG8_STAGE(PG8_SB(1, 0), b3, voffB); PG8_STAGE(PG8_SB(1, 1), b3 + hstep, voffB); PG8_STAGE(PG8_SA(1, 0), a3, voffA);
            PG8_WAIT_V(8); PG8_WAIT_L(0); PG8_BAR; PG8_MMA(1, 0, At, B0); PG8_MMA(1, 1, At, B1); PG8_BAR; PG8_SCHED;
            } else {
            PG8_LDB(B0, 0, 0); PG8_SCHED; PG8_LDA(At, 0, 0); PG8_STAGE(PG8_SA(1, 1), a1 + hstep, voffA);
            PG8_WAIT_L(8); PG8_BAR; PG8_WAIT_L(0); PG8_MMA(0, 0, At, B0); PG8_BAR; PG8_SCHED;
            PG8_LDB(B1, 0, 1); PG8_STAGE(PG8_SB(0, 0), b2, voffB);
            PG8_BAR; PG8_WAIT_L(0); PG8_MMA(0, 1, At, B1); PG8_BAR;
            PG8_LDA(At, 0, 1); PG8_STAGE(PG8_SA(0, 0), a2, voffA);
            PG8_BAR; PG8_WAIT_L(0); PG8_MMA(1, 0, At, B0); PG8_BAR; PG8_SCHED;
            PG8_STAGE(PG8_SB(0, 1), b2 + hstep, voffB);
            PG8_WAIT_V(6); PG8_BAR; PG8_MMA(1, 1, At, B1); PG8_BAR;
            PG8_LDB(B0, 1, 0); PG8_SCHED; PG8_LDA(At, 1, 0); PG8_STAGE(PG8_SA(0, 1), a2 + hstep, voffA);
            PG8_WAIT_L(8); PG8_BAR; PG8_WAIT_L(0); PG8_MMA(0, 0, At, B0); PG8_BAR; PG8_SCHED;
            PG8_LDB(B1, 1, 1); PG8_STAGE(PG8_SB(1, 0), b3, voffB);
            PG8_BAR; PG8_WAIT_L(0); PG8_MMA(0, 1, At, B1); PG8_BAR;
            PG8_LDA(At, 1, 1); PG8_STAGE(PG8_SA(1, 0), a3, voffA);
            PG8_BAR; PG8_WAIT_L(0); PG8_MMA(1, 0, At, B0); PG8_BAR; PG8_SCHED;
            PG8_STAGE(PG8_SB(1, 1), b3 + hstep, voffB);
            PG8_WAIT_V(6); PG8_BAR; PG8_MMA(1, 1, At, B1); PG8_BAR;
            }
        }
        if constexpr (ALIGN_EPI) { if (wr == 0) PG8_BAR; }
        if constexpr (FP8) asm volatile("s_nop 15\n\ts_nop 15" ::: "memory");
        if constexpr (!Epi::AFTER_DRAIN) { int tz_ = tid; asm volatile("" : "+v"(tz_)); const int ln_ = tz_ & 63;
            E(acc, cur, wr, wc, ln_ & 15, ln_ >> 4); S.done(cur); }
        if (!has_next) break;
#pragma unroll
        for (int a = 0; a < 2; ++a)
#pragma unroll
            for (int b = 0; b < 2; ++b)
#pragma unroll
                for (int m = 0; m < 4; ++m)
#pragma unroll
                    for (int n = 0; n < 2; ++n) acc[a][b][m][n] = (f32x4){0.f, 0.f, 0.f, 0.f};
        cur = nxt; cA = nA; cB = nB; ++ui; if constexpr (Sched::VARK) cnt = cur.nt;
        if constexpr (ALIGN_EPI) { if (wr == 1) PG8_BAR; }
    }
    PG8_WAIT_V(0);
    if constexpr (!ALIGN_EPI) { if (wr == 0) PG8_BAR; }
    PG8_BAR;
    if constexpr (Epi::AFTER_DRAIN) { E.fused(acc, cur, wr, wc, fr, fq, lds, wid, lane); S.done(cur); }
#undef PG8_SA
#undef PG8_SB
#undef PG8_STAGE
#undef PG8_LDA
#undef PG8_LDB
#undef PG8_MMA
#undef PG8_WAIT_V
#undef PG8_WAIT_L
#undef PG8_BAR
#undef PG8_SCHED
}

__device__ __forceinline__ float bfl(unsigned w) { return __uint_as_float(w << 16); }
__device__ __forceinline__ float bfh(unsigned w) { return __uint_as_float(w & 0xffff0000u); }
__device__ __forceinline__ float sigmoid_clamped(float l) { l = fminf(fmaxf(l, -30.f), 30.f); return __builtin_amdgcn_rcpf(1.f + __expf(-l)); }
__device__ __forceinline__ float onepexp_clamped(float l) { l = fminf(fmaxf(l, -30.f), 30.f); return 1.f + __expf(-l); }

__device__ __forceinline__ float sum_fq(float x) {
    { const auto r = __builtin_amdgcn_permlane16_swap(__float_as_uint(x), __float_as_uint(x), false, false); x = __uint_as_float(r[0]) + __uint_as_float(r[1]); }
    { const auto r = __builtin_amdgcn_permlane32_swap(__float_as_uint(x), __float_as_uint(x), false, false); x = __uint_as_float(r[0]) + __uint_as_float(r[1]); }
    return x;
}
__device__ __forceinline__ float row_rstd(const float* ssp, int r, int fq) {
    const f32x4 p4 = *(const f32x4*)(ssp + (size_t)r * 16 + 4 * fq);
    float s = (p4[0] + p4[1]) + (p4[2] + p4[3]);
    s = sum_fq(s);
    return __builtin_amdgcn_rsqf(s * (1.0f / 1024.0f) + 1e-6f);
}
__device__ __forceinline__ void row_rstd8(const float* ssp, int row0, int fq, float (&rs)[2][4]) {
    f32x4 p4[2][4];
#pragma unroll
    for (int ai = 0; ai < 2; ++ai)
#pragma unroll
        for (int m = 0; m < 4; ++m) p4[ai][m] = *(const f32x4*)(ssp + (size_t)(row0 + ai * HALF + m * 16) * 16 + 4 * fq);
#pragma unroll
    for (int ai = 0; ai < 2; ++ai)
#pragma unroll
        for (int m = 0; m < 4; ++m) { float s = (p4[ai][m][0] + p4[ai][m][1]) + (p4[ai][m][2] + p4[ai][m][3]); s = sum_fq(s); rs[ai][m] = __builtin_amdgcn_rsqf(s * (1.0f / 1024.0f) + 1e-6f); }
}
__device__ __forceinline__ void rstd8(const PG8_LAS float* rtab, const float* ssp, const Unit& u, int row0, int rloc, int fq, float (&rs)[2][4]) {
    if (u.aux < 8) {
#pragma unroll
        for (int ai = 0; ai < 2; ++ai)
#pragma unroll
            for (int m = 0; m < 4; ++m) rs[ai][m] = rtab[u.aux * 256 + rloc + ai * HALF + m * 16];
    } else row_rstd8(ssp, row0, fq, rs);
}
struct EpiStoreBf16 {
    static constexpr bool PERM = true, AFTER_DRAIN = false, MIDK = false; static constexpr int MID0 = -1, MID1 = -1;
    bf16_t* O; int ldc; int nct;
    __device__ __forceinline__ void operator()(const f32x4 (&acc)[2][2][4][2], const Unit& u, int wr, int wc, int fr, int fq) const {
        const int row0 = u.pm * BM + wr * 64 + fr, col0 = (u.pn % nct) * BM + wc * 32 + 8 * fq;
#pragma unroll
        for (int ai = 0; ai < 2; ++ai)
#pragma unroll
            for (int m = 0; m < 4; ++m) { bf16_t* rowp = O + (size_t)(row0 + ai * HALF + m * 16) * ldc + col0;
#pragma unroll
                for (int bj = 0; bj < 2; ++bj) { const f32x4 v0 = acc[ai][bj][m][0], v1 = acc[ai][bj][m][1];
                    u32x4 w; w.x = cvt_pk_bf16(v0[0], v0[1]); w.y = cvt_pk_bf16(v0[2], v0[3]); w.z = cvt_pk_bf16(v1[0], v1[1]); w.w = cvt_pk_bf16(v1[2], v1[3]);
                    *(u32x4*)(rowp + bj * HALF) = w; } }
    }
};
struct EpiProj {
    static constexpr bool PERM = true, AFTER_DRAIN = false, MIDK = false; static constexpr int MID0 = -1, MID1 = -1;
    bf16_t* O; int ldc; int gate_tile0; const float* ssp; const PG8_LAS float* rtab; int col_off; float scale;
    __device__ __forceinline__ void operator()(const f32x4 (&acc)[2][2][4][2], const Unit& u, int wr, int wc, int fr, int fq) const {
        const int row0 = u.pm * BM + wr * 64 + fr, col0 = col_off + u.pn * BM + wc * 32 + 8 * fq;
        const bool gate = u.pn >= gate_tile0;
        float rsv[2][4]; rstd8(rtab, ssp, u, row0, wr * 64 + fr, fq, rsv);
        const __amdgpu_buffer_rsrc_t rs_ = __builtin_amdgcn_make_buffer_rsrc((void*)O, (short)0, 0x7ffffff0, 0x00020000);
#pragma unroll
        for (int ai = 0; ai < 2; ++ai)
#pragma unroll
            for (int m = 0; m < 4; ++m) { const int rowb = (int)(((size_t)(row0 + ai * HALF + m * 16) * ldc + col0) * 2);
                const float rs = rsv[ai][m] * scale;
                if (gate) { const float k1 = rs * -1.4426950408889634f;
#pragma unroll
                    for (int bj = 0; bj < 2; ++bj) { u32x4 w;
#pragma unroll
                        for (int q = 0; q < 4; ++q) { const f32x2 a2 = {acc[ai][bj][m][q >> 1][2 * (q & 1)], acc[ai][bj][m][q >> 1][2 * (q & 1) + 1]}; const f32x2 t = a2 * k1;
                            const f32x2 ex = {__builtin_amdgcn_exp2f(__builtin_amdgcn_fmed3f(t.x, -43.280851f, 43.280851f)), __builtin_amdgcn_exp2f(__builtin_amdgcn_fmed3f(t.y, -43.280851f, 43.280851f))};
                            const f32x2 o = ex + 1.0f; w[q] = cvt_pk_bf16(o.x, o.y); }
                        __builtin_amdgcn_raw_buffer_store_b128(w, rs_, rowb + bj * HALF * 2, 0, 16); } }
                else {
#pragma unroll
                    for (int bj = 0; bj < 2; ++bj) { const f32x4 v0 = acc[ai][bj][m][0] * rs, v1 = acc[ai][bj][m][1] * rs;
                        u32x4 w; w.x = cvt_pk_bf16(v0[0], v0[1]); w.y = cvt_pk_bf16(v0[2], v0[3]); w.z = cvt_pk_bf16(v1[0], v1[1]); w.w = cvt_pk_bf16(v1[2], v1[3]);
                        __builtin_amdgcn_raw_buffer_store_b128(w, rs_, rowb + bj * HALF * 2, 0, 16); } } }
    }
};
__device__ __forceinline__ unsigned pk4_fp8(float a, float b, float c, float d) {
    a = fminf(fmaxf(a, -448.f), 448.f); b = fminf(fmaxf(b, -448.f), 448.f); c = fminf(fmaxf(c, -448.f), 448.f); d = fminf(fmaxf(d, -448.f), 448.f);
    int p = __builtin_amdgcn_cvt_pk_fp8_f32(a, b, 0, false); p = __builtin_amdgcn_cvt_pk_fp8_f32(c, d, p, true); return (unsigned)p;
}
struct EpiSwiglu8 {
    static constexpr bool PERM = true, AFTER_DRAIN = false, MIDK = false; static constexpr int MID0 = -1, MID1 = -1;
    unsigned char* O; int ldc; int nct; float k1, cden;
    __device__ __forceinline__ void operator()(const f32x4 (&acc)[2][2][4][2], const Unit& u, int wr, int wc, int fr, int fq) const {
        const int row0 = u.pm * BM + wr * 64 + fr, col0 = (u.pn % nct) * HALF + wc * 32 + 8 * fq;
#pragma unroll
        for (int ai = 0; ai < 2; ++ai)
#pragma unroll
            for (int m = 0; m < 4; ++m) { unsigned char* rowp = O + (size_t)(row0 + ai * HALF + m * 16) * ldc + col0;
                float r[8];
#pragma unroll
                for (int n = 0; n < 2; ++n)
#pragma unroll
                    for (int h = 0; h < 2; ++h) { const f32x2 g2 = {acc[ai][0][m][n][2 * h], acc[ai][0][m][n][2 * h + 1]}, u2 = {acc[ai][1][m][n][2 * h], acc[ai][1][m][n][2 * h + 1]};
                        const f32x2 t = g2 * k1; const f32x2 ex = {__builtin_amdgcn_exp2f(t.x), __builtin_amdgcn_exp2f(t.y)}; const f32x2 d = ex * cden + cden;
                        const f32x2 rr = {__builtin_amdgcn_rcpf(d.x), __builtin_amdgcn_rcpf(d.y)}; const f32x2 o = (g2 * u2) * rr; r[n * 4 + 2 * h] = o.x; r[n * 4 + 2 * h + 1] = o.y; }
                typedef unsigned u32x2v __attribute__((ext_vector_type(2))); u32x2v w; w.x = pk4_fp8(r[0], r[1], r[2], r[3]); w.y = pk4_fp8(r[4], r[5], r[6], r[7]);
                *(u32x2v*)rowp = w; }
    }
};
struct EpiMoeDown {
    static constexpr bool PERM = true, AFTER_DRAIN = false, MIDK = false; static constexpr int MID0 = -1, MID1 = -1;
    bf16_t* O; int ldc; int nct; bf16_t* O2; float scale;
    __device__ __forceinline__ void operator()(const f32x4 (&acc)[2][2][4][2], const Unit& u, int wr, int wc, int fr, int fq) const {
        const bool second = u.aux >= 0;
        bf16_t* base = second ? O2 + (size_t)u.aux * 65536 + (size_t)(wr * 64 + fr) * 256 + wc * 32 + 8 * fq
                              : O + (size_t)(u.pm * BM + wr * 64 + fr) * ldc + (u.pn % nct) * BM + wc * 32 + 8 * fq;
        const int ld = second ? 256 : ldc;
#pragma unroll
        for (int ai = 0; ai < 2; ++ai)
#pragma unroll
            for (int m = 0; m < 4; ++m) { bf16_t* rowp = base + (size_t)(ai * HALF + m * 16) * ld;
#pragma unroll
                for (int bj = 0; bj < 2; ++bj) { const f32x4 v0 = acc[ai][bj][m][0] * scale, v1 = acc[ai][bj][m][1] * scale;
                    u32x4 w; w.x = cvt_pk_bf16(v0[0], v0[1]); w.y = cvt_pk_bf16(v0[2], v0[3]); w.z = cvt_pk_bf16(v1[0], v1[1]); w.w = cvt_pk_bf16(v1[2], v1[3]);
                    *(u32x4*)(rowp + bj * HALF) = w; } }
    }
};
template <int NORMOUT, bool BASE16> struct EpiResid {
    static constexpr bool PERM = true, AFTER_DRAIN = false, MIDK = false; static constexpr int MID0 = -1, MID1 = -1;
    const void* base; bf16_t* hb; int ldc; float* ssp; unsigned char* hb8; float hb8_scale; float ascale;
    __device__ __forceinline__ void row_out(const f32x4 (&o)[2][2], size_t off, int r, int pn, int wc, int fq) const {
        float q = 0.f;
#pragma unroll
        for (int bj = 0; bj < 2; ++bj) { const f32x4 o0 = o[bj][0], o1 = o[bj][1];
            if (NORMOUT & 1) q += ((o0[0] * o0[0] + o0[1] * o0[1]) + (o0[2] * o0[2] + o0[3] * o0[3])) + ((o1[0] * o1[0] + o1[1] * o1[1]) + (o1[2] * o1[2] + o1[3] * o1[3]));
            u32x4 w; w.x = cvt_pk_bf16(o0[0], o0[1]); w.y = cvt_pk_bf16(o0[2], o0[3]); w.z = cvt_pk_bf16(o1[0], o1[1]); w.w = cvt_pk_bf16(o1[2], o1[3]); *(u32x4*)(hb + off + bj * HALF) = w;
            if (NORMOUT & 2) { typedef unsigned u32x2v __attribute__((ext_vector_type(2))); u32x2v w8; w8.x = pk4_fp8(o0[0] * hb8_scale, o0[1] * hb8_scale, o0[2] * hb8_scale, o0[3] * hb8_scale); w8.y = pk4_fp8(o1[0] * hb8_scale, o1[1] * hb8_scale, o1[2] * hb8_scale, o1[3] * hb8_scale); *(u32x2v*)(hb8 + off + bj * HALF) = w8; } }
        if (NORMOUT & 1) { q = sum_fq(q); if (fq == 0) ssp[(size_t)r * 16 + 4 * pn + wc] = q; }
    }
    __device__ __forceinline__ void operator()(const f32x4 (&acc)[2][2][4][2], const Unit& u, int wr, int wc, int fr, int fq) const {
        const int row0 = u.pm * BM + wr * 64 + fr, col0 = u.pn * BM + wc * 32 + 8 * fq;
        if constexpr (BASE16) { const bf16_t* b16 = (const bf16_t*)base;
#pragma unroll
            for (int ai = 0; ai < 2; ++ai) { u32x4 bs[4][2];
#pragma unroll
                for (int m = 0; m < 4; ++m)
#pragma unroll
                    for (int bj = 0; bj < 2; ++bj) bs[m][bj] = *(const u32x4*)(b16 + (size_t)(row0 + ai * HALF + m * 16) * ldc + col0 + bj * HALF);
#pragma unroll
                for (int m = 0; m < 4; ++m) { const int r = row0 + ai * HALF + m * 16; f32x4 o[2][2];
#pragma unroll
                    for (int bj = 0; bj < 2; ++bj) { const u32x4 b = bs[m][bj];
                        o[bj][0] = (f32x4){bfl(b.x), bfh(b.x), bfl(b.y), bfh(b.y)} + acc[ai][bj][m][0] * ascale; o[bj][1] = (f32x4){bfl(b.z), bfh(b.z), bfl(b.w), bfh(b.w)} + acc[ai][bj][m][1] * ascale; }
                    row_out(o, (size_t)r * ldc + col0, r, u.pn, wc, fq); }
                asm volatile("" ::: "memory"); }
        } else { const float* b32 = (const float*)base;
#pragma unroll
            for (int ai = 0; ai < 2; ++ai)
#pragma unroll
                for (int mp = 0; mp < 2; ++mp) { f32x4 bs[2][2][2];
#pragma unroll
                    for (int mm = 0; mm < 2; ++mm) { const size_t off = (size_t)(row0 + ai * HALF + (2 * mp + mm) * 16) * ldc + col0;
#pragma unroll
                        for (int bj = 0; bj < 2; ++bj)
#pragma unroll
                            for (int n = 0; n < 2; ++n) bs[mm][bj][n] = *(const f32x4*)(b32 + off + bj * HALF + n * 4); }
#pragma unroll
                    for (int mm = 0; mm < 2; ++mm) { const int r = row0 + ai * HALF + (2 * mp + mm) * 16; f32x4 o[2][2];
#pragma unroll
                        for (int bj = 0; bj < 2; ++bj) { o[bj][0] = bs[mm][bj][0] + acc[ai][bj][2 * mp + mm][0] * ascale; o[bj][1] = bs[mm][bj][1] + acc[ai][bj][2 * mp + mm][1] * ascale; }
                        row_out(o, (size_t)r * ldc + col0, r, u.pn, wc, fq); }
                    asm volatile("" ::: "memory"); }
        }
    }
};
template <bool RS, bool OUT8 = false> struct EpiSwiglu {
    static constexpr bool PERM = true, AFTER_DRAIN = false, MIDK = false; static constexpr int MID0 = -1, MID1 = -1;
    bf16_t* O; int ldc; int nct; const float* ssp; const PG8_LAS float* rtab; float out_scale;
    __device__ __forceinline__ void operator()(const f32x4 (&acc)[2][2][4][2], const Unit& u, int wr, int wc, int fr, int fq) const {
        const int row0 = u.pm * BM + wr * 64 + fr, col0 = (u.pn % nct) * HALF + wc * 32 + 8 * fq;
        float rsv[2][4]; if (RS) rstd8(rtab, ssp, u, row0, wr * 64 + fr, fq, rsv);
#pragma unroll
        for (int ai = 0; ai < 2; ++ai)
#pragma unroll
            for (int m = 0; m < 4; ++m) { bf16_t* rowp = O + (size_t)(row0 + ai * HALF + m * 16) * ldc + col0;
                float r[8]; float rs = 1.f; if (RS) rs = rsv[ai][m];
                const float k1 = rs * -1.4426950408889634f, cden = (RS || OUT8) ? __builtin_amdgcn_rcpf(rs * rs * (OUT8 ? out_scale : 1.f)) : 1.f;
#pragma unroll
                for (int n = 0; n < 2; ++n)
#pragma unroll
                    for (int h = 0; h < 2; ++h) { const f32x2 g2 = {acc[ai][0][m][n][2 * h], acc[ai][0][m][n][2 * h + 1]}, u2 = {acc[ai][1][m][n][2 * h], acc[ai][1][m][n][2 * h + 1]};
                        const f32x2 t = g2 * k1; const f32x2 ex = {__builtin_amdgcn_exp2f(t.x), __builtin_amdgcn_exp2f(t.y)}; const f32x2 d = ex * cden + cden;
                        const f32x2 rr = {__builtin_amdgcn_rcpf(d.x), __builtin_amdgcn_rcpf(d.y)}; const f32x2 o = (g2 * u2) * rr; r[n * 4 + 2 * h] = o.x; r[n * 4 + 2 * h + 1] = o.y; }
                if constexpr (OUT8) { typedef unsigned u32x2v __attribute__((ext_vector_type(2))); u32x2v w; w.x = pk4_fp8(r[0], r[1], r[2], r[3]); w.y = pk4_fp8(r[4], r[5], r[6], r[7]);
                    *(u32x2v*)((unsigned char*)O + (size_t)(row0 + ai * HALF + m * 16) * ldc + col0) = w; }
                else { u32x4 w; w.x = cvt_pk_bf16(r[0], r[1]); w.y = cvt_pk_bf16(r[2], r[3]); w.z = cvt_pk_bf16(r[4], r[5]); w.w = cvt_pk_bf16(r[6], r[7]);
                    *(u32x4*)rowp = w; } }
    }
};
struct EpiBranch {
    static constexpr bool PERM = true, AFTER_DRAIN = false, MIDK = true; static constexpr int MID0 = 8, MID1 = 12;
    const bf16_t* G; int ldg; bf16_t* O; int ldc;
    __device__ __forceinline__ void mid(f32x4 (&acc)[2][2][4][2], const Unit& u, int t, int wr, int wc, int fr, int fq) const {
        int row0 = u.pm * BM + wr * 64 + fr, col0 = u.pn * BM + wc * 32 + 8 * fq;
        asm volatile("" : "+v"(row0), "+v"(col0));
        const bf16_t* gp = G + (t == MID0 ? 0 : 1024);
        u32x4 ld_[2][2][2], ln_[2][2][2];
#define BR_LOAD(bf, ai, mp) do { _Pragma("unroll") for (int mm = 0; mm < 2; ++mm) { const bf16_t* rp = gp + (size_t)(row0 + (ai) * HALF + (2 * (mp) + mm) * 16) * ldg + col0; \
            _Pragma("unroll") for (int bj = 0; bj < 2; ++bj) { ld_[bf][mm][bj] = *(const u32x4*)(rp + bj * HALF); ln_[bf][mm][bj] = *(const u32x4*)(rp + bj * HALF + 1024); } } } while (0)
#define BR_APPLY(bf, ai, mp) do { _Pragma("unroll") for (int mm = 0; mm < 2; ++mm) _Pragma("unroll") for (int bj = 0; bj < 2; ++bj) _Pragma("unroll") for (int q = 0; q < 4; ++q) { \
            const unsigned dw = ld_[bf][mm][bj][q], nw = ln_[bf][mm][bj][q];        \
            const f32x2 rd = {__builtin_amdgcn_rcpf(bfl(dw)), __builtin_amdgcn_rcpf(bfh(dw))}, nm = {bfl(nw), bfh(nw)}; const f32x2 ra = nm * rd; \
            acc[ai][bj][2 * (mp) + mm][q >> 1][2 * (q & 1)] *= ra.x; acc[ai][bj][2 * (mp) + mm][q >> 1][2 * (q & 1) + 1] *= ra.y; } } while (0)
        BR_LOAD(0, 0, 0); BR_LOAD(1, 0, 1); asm volatile("" ::: "memory");
        BR_APPLY(0, 0, 0); asm volatile("" ::: "memory"); BR_LOAD(0, 1, 0); asm volatile("" ::: "memory");
        BR_APPLY(1, 0, 1); asm volatile("" ::: "memory"); BR_LOAD(1, 1, 1); asm volatile("" ::: "memory");
        BR_APPLY(0, 1, 0); asm volatile("" ::: "memory"); BR_APPLY(1, 1, 1); asm volatile("" ::: "memory");
#undef BR_LOAD
#undef BR_APPLY
    }
    __device__ __forceinline__ void operator()(const f32x4 (&acc)[2][2][4][2], const Unit& u, int wr, int wc, int fr, int fq) const {
        const int row0 = u.pm * BM + wr * 64 + fr, col0 = u.pn * BM + wc * 32 + 8 * fq;
        u32x4 l2[2][2][2];
#define BR_LOAD(bf, ai, mp) do { _Pragma("unroll") for (int mm = 0; mm < 2; ++mm) _Pragma("unroll") for (int bj = 0; bj < 2; ++bj) \
            l2[bf][mm][bj] = *(const u32x4*)(G + 2048 + (size_t)(row0 + (ai) * HALF + (2 * (mp) + mm) * 16) * ldg + col0 + bj * HALF); } while (0)
#define BR_APPLY(bf, ai, mp) do { _Pragma("unroll") for (int mm = 0; mm < 2; ++mm) _Pragma("unroll") for (int bj = 0; bj < 2; ++bj) { u32x4 w; \
            _Pragma("unroll") for (int q = 0; q < 4; ++q) { const unsigned dw = l2[bf][mm][bj][q]; const f32x2 rd = {__builtin_amdgcn_rcpf(bfl(dw)), __builtin_amdgcn_rcpf(bfh(dw))}; \
                const f32x2 a2 = {acc[ai][bj][2 * (mp) + mm][q >> 1][2 * (q & 1)], acc[ai][bj][2 * (mp) + mm][q >> 1][2 * (q & 1) + 1]}; const f32x2 o = a2 * rd; w[q] = cvt_pk_bf16(o.x, o.y); } \
            *(u32x4*)(O + (size_t)(row0 + (ai) * HALF + (2 * (mp) + mm) * 16) * ldc + col0 + bj * HALF) = w; } } while (0)
        BR_LOAD(0, 0, 0); BR_LOAD(1, 0, 1); asm volatile("" ::: "memory");
        BR_APPLY(0, 0, 0); asm volatile("" ::: "memory"); BR_LOAD(0, 1, 0); asm volatile("" ::: "memory");
        BR_APPLY(1, 0, 1); asm volatile("" ::: "memory"); BR_LOAD(1, 1, 1); asm volatile("" ::: "memory");
        BR_APPLY(0, 1, 0); asm volatile("" ::: "memory"); BR_APPLY(1, 1, 1);
#undef BR_LOAD
#undef BR_APPLY
    }
};

}

constexpr int NWAVES = 8, NTHR = 512;
constexpr int BATCH = 4, SEQ = 4096, D = 1024, M = BATCH * SEQ, INC = 5632, FF = 3584, NE = 8, NHEAD = 8, HD = 64;
constexpr int C_Q = 0, C_K = 512, C_V = 1024, C_U = 1536, C_CH = 1792, C_CB = 2048, C_CC = 2304, C_G = 2560;
constexpr int MPAD = 2 * M + 2048;
constexpr int NCHUNK = M / 64;
constexpr float EPS = 1e-6f;
constexpr float SB_EXIT = -150.1f;

constexpr size_t MiB = 1u << 20;
constexpr size_t WS_CTL = 0, CTL_ZERO_BYTES = 65536;
constexpr int CW_BAR = 4096, CW_MOECNT = 8192;
constexpr size_t WS_TOPI = 1 * MiB, WS_TOPW = WS_TOPI + 256 * 1024, WS_SLOT = WS_TOPI + 512 * 1024;
constexpr size_t WS_TAB = 2 * MiB, TAB_STRIDE = 512 * 1024, TAB_ABAR = 0, TAB_BBAR = 64 * 1024, TAB_CMATB = 256 * 1024, TAB_BBF = 320 * 1024;
constexpr size_t WS_HB8 = 236 * MiB;
constexpr size_t WS_WING8 = 77 * MiB;
constexpr size_t WS_Y2 = 224 * MiB;
constexpr size_t WS_E = 4 * MiB, WS_SSP = 6 * MiB;
constexpr size_t WS_XNN = 8 * MiB;
constexpr size_t WS_WIN0 = 72 * MiB, WS_WCAT0 = 83 * MiB, WS_WOUT0 = 85 * MiB, WS_WGLU0 = 87 * MiB, WS_WGU0 = 88 * MiB, WS_WD0 = 102 * MiB;
constexpr size_t WS_WIN1 = 109 * MiB, WS_WCAT1 = 120 * MiB, WS_WOUT1 = 122 * MiB, WS_WGLU1 = 124 * MiB;
constexpr size_t WS_LSTRIDE = WS_WIN1 - WS_WIN0;
static_assert(WS_WCAT1 - WS_WCAT0 == WS_LSTRIDE && WS_WOUT1 - WS_WOUT0 == WS_LSTRIDE && WS_WGLU1 - WS_WGLU0 == WS_LSTRIDE, "layer stride");
constexpr size_t WS_YCAT0 = 125 * MiB, WS_MERGED0 = 157 * MiB, WS_XN = 252 * MiB, WS_BIG = 284 * MiB;
constexpr size_t WS_YCAT1 = 72 * MiB, WS_MERGED1 = 460 * MiB;
constexpr size_t WS_XS = 72 * MiB, WS_WMOE = 140 * MiB, WS_WD8 = 196 * MiB, WS_ACTM = 284 * MiB, WS_YS = 404 * MiB, WS_END = 492 * MiB;
constexpr float SC_XS = 4.f, SC_W = 64.f, SC_ACT = 8.f;
static_assert(WS_XS + (size_t)MPAD * D <= WS_WIN1 && WS_WMOE + (size_t)NE * 2 * FF * D <= WS_WD8 && WS_WD8 + (size_t)NE * FF * D <= 224 * MiB && WS_ACTM + (size_t)MPAD * FF <= WS_YS && WS_YS + (size_t)MPAD * D * 2 <= WS_END, "MoE map");
static_assert(WS_BIG + (size_t)M * INC * 2 <= WS_END && WS_XN + (size_t)M * D * 2 <= WS_BIG && WS_MERGED0 + (size_t)M * D * 2 <= WS_XN && WS_MERGED1 + (size_t)M * D * 2 <= WS_END && WS_YCAT1 + (size_t)M * D * 2 <= WS_WIN1, "mixer map");

constexpr int RING_BYTES = 131072, MISC_OFF = RING_BYTES, LDS_BYTES = 147456;

#define LAS __attribute__((address_space(3)))
#ifndef TP_A
#define TP_A -2
#define TP_B -2
#endif
#define TP_MUL 8
__device__ __forceinline__ void tp_stamp(LAS unsigned char* lds, int k) {
    if (TP_A == -2) return;
    if (threadIdx.x == 0 && blockIdx.x == 0) { if (k == TP_A) *(volatile LAS long long*)(lds + 140288) = wall_clock64(); if (k == TP_B) *(volatile LAS long long*)(lds + 140296) = wall_clock64(); }
}
typedef unsigned short bf16;
typedef unsigned v4u __attribute__((ext_vector_type(4)));
typedef unsigned v2u __attribute__((ext_vector_type(2)));
typedef float f32x4 __attribute__((ext_vector_type(4)));
typedef float f32x16 __attribute__((ext_vector_type(16)));
typedef float f32x2v __attribute__((ext_vector_type(2)));
typedef short bf16x8 __attribute__((ext_vector_type(8)));
#define RLX_AGENT __ATOMIC_RELAXED, __HIP_MEMORY_SCOPE_AGENT
#define LDS_WAIT() asm volatile("s_waitcnt lgkmcnt(0)" ::: "memory")
__device__ __forceinline__ float bfl(unsigned w) { return __uint_as_float(w << 16); }
__device__ __forceinline__ float bfh(unsigned w) { return __uint_as_float(w & 0xffff0000u); }
__device__ __forceinline__ float bf2f(bf16 x) { return __uint_as_float(((unsigned)x) << 16); }
typedef float f32x2c __attribute__((ext_vector_type(2))); typedef __bf16 bf16x2c __attribute__((ext_vector_type(2)));
__device__ __forceinline__ unsigned pk2(float lo, float hi) { const f32x2c v = {lo, hi}; return __builtin_bit_cast(unsigned, __builtin_convertvector(v, bf16x2c)); }
__device__ __forceinline__ unsigned f2bf(float f) { return pk2(f, f) & 0xffffu; }
#define DPP_ADD(v, ctrl) ((v) + __builtin_bit_cast(float, __builtin_amdgcn_update_dpp(0, __builtin_bit_cast(int, (v)), (ctrl), 0xf, 0xf, true)))
__device__ __forceinline__ float half_sum(float x) {
    const auto r = __builtin_amdgcn_permlane32_swap(__float_as_uint(x), __float_as_uint(x), false, false); return __uint_as_float(r[0]) + __uint_as_float(r[1]);
}
__device__ __forceinline__ float wave_sum(float v) {
    v = DPP_ADD(v, 0xB1);
    v = DPP_ADD(v, 0x4E);
    v = DPP_ADD(v, 0x124);
    v = DPP_ADD(v, 0x128);
    { const auto r = __builtin_amdgcn_permlane16_swap(__float_as_uint(v), __float_as_uint(v), false, false); v = __uint_as_float(r[0]) + __uint_as_float(r[1]); }
    return half_sum(v);
}

#define XB_TMO      128
#define XB_XCNT(j)  (256  + 64 * (j))
#define XB_XSUB(j)  (1280 + 64 * (j))
#define XB_XGEN(j)  (2304 + 64 * (j))
#define XB_TOP      3328
#define XB_TOPGEN   3392
#define XCD_BAR_WORDS 3456
#define XB_SPIN_CAP (1u << 18)
__device__ __forceinline__ unsigned xb_ld(unsigned* p)              { return __hip_atomic_load(p, __ATOMIC_RELAXED, __HIP_MEMORY_SCOPE_AGENT); }
__device__ __forceinline__ unsigned xb_add(unsigned* p, unsigned v) { return __hip_atomic_fetch_add(p, v, __ATOMIC_RELAXED, __HIP_MEMORY_SCOPE_AGENT); }
__device__ __forceinline__ unsigned xb_xcc_id() { return (unsigned)__builtin_amdgcn_s_getreg((3 << 11) | 20) & 0xFu; }
#define XB_SPIN(cond, bar) do { unsigned _sp = 0; while (cond) { __builtin_amdgcn_s_sleep(1); \
    if ((++_sp & 255u) == 0u) { if (xb_ld(&(bar)[XB_TMO])) break; if (_sp > XB_SPIN_CAP) { atomicAdd(&(bar)[XB_TMO], 1u); break; } } } } while (0)
struct XcdBarrier { unsigned* bar; unsigned x; volatile LAS unsigned* st; };
__device__ __forceinline__ XcdBarrier xcd_barrier_post(unsigned* bar, volatile LAS unsigned* st) {
    XcdBarrier b; b.bar = bar; b.x = xb_xcc_id(); b.st = st;
    if (threadIdx.x == 0) (void)xb_add(&bar[XB_XCNT(b.x)], 1u);
    return b;
}
__device__ __forceinline__ void xcd_barrier_complete(unsigned* bar, unsigned x, unsigned& nloc, unsigned& nx) {
    const unsigned G = gridDim.x * gridDim.y * gridDim.z;
    unsigned sum, cnt, mine, sp = 0u;
    for (;;) {
        sum = 0u; cnt = 0u; mine = 0u;
#pragma unroll
        for (unsigned j = 0; j < 16; ++j) { const unsigned c = xb_ld(&bar[XB_XCNT(j)]); sum += c; cnt += (c > 0u) ? 1u : 0u; mine = (j == x) ? c : mine; }
        if (sum == G) break;
        __builtin_amdgcn_s_sleep(1);
        if ((++sp & 255u) == 0u) { if (xb_ld(&bar[XB_TMO])) break; if (sp > XB_SPIN_CAP) { atomicAdd(&bar[XB_TMO], 1u); break; } }
    }
    nloc = mine > 0u ? mine : 1u; nx = cnt > 0u ? cnt : 1u;
}
__device__ __forceinline__ void xcd_barrier(const XcdBarrier& b) {
    asm volatile("s_waitcnt vmcnt(0)" ::: "memory");
    __syncthreads();
    if (threadIdx.x == 0) {
        unsigned* bar = b.bar;
        __builtin_amdgcn_s_waitcnt(0);
        unsigned nloc = b.st[0], nx = b.st[1];
        if (nloc == 0u) { xcd_barrier_complete(bar, b.x, nloc, nx); b.st[0] = nloc; b.st[1] = nx; }
        const unsigned old = xb_add(&bar[XB_XSUB(b.x)], 1u);
        const unsigned gen = old / nloc;
        if (old + 1u == (gen + 1u) * nloc) {
            __builtin_amdgcn_fence(__ATOMIC_RELEASE, "agent");
            asm volatile("s_waitcnt vmcnt(0)" ::: "memory");
            const unsigned og = xb_add(&bar[XB_TOP], 1u);
            const unsigned tg = og / nx;
            if (og + 1u == (tg + 1u) * nx) xb_add(&bar[XB_TOPGEN], 1u);
            else XB_SPIN(xb_ld(&bar[XB_TOPGEN]) == tg, bar);
            __builtin_amdgcn_fence(__ATOMIC_ACQUIRE, "agent");
            xb_add(&bar[XB_XGEN(b.x)], 1u);
            asm volatile("s_waitcnt vmcnt(0)" ::: "memory");
        } else {
            XB_SPIN(xb_ld(&bar[XB_XGEN(b.x)]) == gen, bar);
            __builtin_amdgcn_fence(__ATOMIC_ACQUIRE, "agent");
            asm volatile("s_waitcnt vmcnt(0)" ::: "memory");
        }
    }
    __syncthreads();
}

struct Args { const float* in[26]; float* out; unsigned char* ws; int ph_lo, ph_hi; };
enum InIdx { I_X = 0, I_NORM_MIX, I_W_IN, I_LAM_RE, I_LAM_IM, I_LOG_DT, I_B_RE, I_B_IM, I_C_RE, I_C_IM, I_SSM_D, I_W_GLU, I_CONV_W, I_W_BR_A, I_W_BR_B, I_W_BR_C, I_W_OUT,
             I_NORM_FFN, I_DW_GATE, I_DW_UP, I_DW_DOWN, I_ROUTER, I_MW_GATE, I_MW_UP, I_MW_DOWN, I_FINAL_NORM };
struct Frame {
    LAS unsigned char* lds;
    unsigned* ctl;
    unsigned char* ws;
    const float* const* in;
    float* out;
    int tid, lane, wave, vcu, G;
    size_t ycat_off;
};

struct CvtJob { const float* src; bf16* dst; int K, N, ld, koff, mode; const float* gain; int fp8; int src_ld, c0; };
__device__ __forceinline__ CvtJob get_job(const Frame& F, int j) {
    CvtJob J; J.koff = 0; J.mode = 0; J.gain = nullptr; J.fp8 = 0; J.src_ld = 0; J.c0 = 0;
    if (j >= 39) { const int l = j - 39;
        J.src = F.in[I_W_IN] + (size_t)l * D * INC; J.K = D; J.N = INC - C_G; J.src_ld = INC; J.c0 = C_G; J.dst = (bf16*)(F.ws + WS_WING8 + (size_t)l * WS_LSTRIDE); J.ld = D; J.gain = F.in[I_NORM_MIX] + l * D; J.fp8 = 1; return J; }
    if (j < 12) { const int l = j / 6, r = j % 6; unsigned char* wl = F.ws + (size_t)l * WS_LSTRIDE;
        if (r == 0)      { J.src = F.in[I_W_IN] + (size_t)l * D * INC;   J.K = D;   J.N = C_G; J.src_ld = INC; J.dst = (bf16*)(wl + WS_WIN0);  J.ld = D; J.gain = F.in[I_NORM_MIX] + l * D; }
        else if (r == 1) { J.src = F.in[I_W_BR_A] + (size_t)l * 512 * D; J.K = 512; J.N = D;   J.dst = (bf16*)(wl + WS_WCAT0); J.ld = D; }
        else if (r == 2) { J.src = F.in[I_W_BR_B] + (size_t)l * 256 * D; J.K = 256; J.N = D;   J.dst = (bf16*)(wl + WS_WCAT0); J.ld = D; J.koff = 512; }
        else if (r == 3) { J.src = F.in[I_W_BR_C] + (size_t)l * 256 * D; J.K = 256; J.N = D;   J.dst = (bf16*)(wl + WS_WCAT0); J.ld = D; J.koff = 768; }
        else if (r == 4) { J.src = F.in[I_W_OUT] + (size_t)l * D * D;    J.K = D;   J.N = D;   J.dst = (bf16*)(wl + WS_WOUT0); J.ld = D; }
        else             { J.src = F.in[I_W_GLU] + (size_t)l * 256 * 256; J.K = 256; J.N = 256; J.dst = (bf16*)(wl + WS_WGLU0); J.ld = 256; }
    } else if (j == 12) { J.src = F.in[I_DW_GATE]; J.K = D; J.N = FF; J.dst = (bf16*)(F.ws + WS_WGU0); J.ld = D; J.mode = 1; J.gain = F.in[I_NORM_FFN]; }
    else if (j == 13)   { J.src = F.in[I_DW_UP];   J.K = D; J.N = FF; J.dst = (bf16*)(F.ws + WS_WGU0); J.ld = D; J.mode = 2; J.gain = F.in[I_NORM_FFN]; }
    else if (j == 14)   { J.src = F.in[I_DW_DOWN]; J.K = FF; J.N = D; J.dst = (bf16*)(F.ws + WS_WD0);  J.ld = FF; J.fp8 = 1; }
    else if (j < 31)    { const int e = (j - 15) >> 1, up = (j - 15) & 1; const float* sg = F.in[I_MW_GATE]; const float* su = F.in[I_MW_UP]; J.src = (up ? su : sg) + (size_t)e * D * FF; J.K = D; J.N = FF;
                          J.dst = (bf16*)(F.ws + WS_WMOE + (size_t)e * 2 * FF * D); J.ld = D; J.mode = 1 + up; J.fp8 = 1; }
    else                { const int e = j - 31; J.src = F.in[I_MW_DOWN] + (size_t)e * FF * D; J.K = FF; J.N = D; J.dst = (bf16*)(F.ws + WS_WD8 + (size_t)e * D * FF); J.ld = FF; J.fp8 = 1; }
    if (!J.src_ld) J.src_ld = J.N;
    return J;
}
__device__ __forceinline__ void cvt_load(const CvtJob& J, int item, int lane, f32x4 (&ld)[16]) {
    const int nblk = J.N / 64, kb = item / nblk, nb = item % nblk;
    const float* p = J.src + (size_t)(64 * kb + (lane >> 4)) * J.src_ld + J.c0 + 64 * nb + (lane & 15) * 4;
#pragma unroll
    for (int i = 0; i < 16; ++i) ld[i] = __builtin_nontemporal_load((const f32x4*)(p + (size_t)(4 * i) * J.src_ld));
}
__device__ __forceinline__ void cvt_to_lds(const CvtJob& J, int item, int lane, f32x4 (&ld)[16], LAS float* scr) {
    const int nblk = J.N / 64, kb = item / nblk, k0 = 64 * kb;
    if (J.gain) {
#pragma unroll
        for (int i = 0; i < 16; ++i) ld[i] = ld[i] * J.gain[k0 + (lane >> 4) + 4 * i]; }
#pragma unroll
    for (int i = 0; i < 16; ++i) { const int k = (lane >> 4) + 4 * i; *(LAS f32x4*)(scr + k * 64 + 4 * ((lane & 15) ^ (((k >> 3) ^ k) & 7))) = ld[i]; }
    LDS_WAIT(); asm volatile("" ::: "memory");
}
__device__ __forceinline__ void cvt_store(const CvtJob& J, int item, int lane, const LAS float* scr) {
    const int nblk = J.N / 64, kb = item / nblk, nb = item % nblk, k0 = 64 * kb, n0 = 64 * nb;
    const int drow0 = (J.mode == 0) ? n0 : ((n0 >> 7) * 256 + (n0 & 127) + (J.mode == 2 ? 128 : 0));
    const int c = lane & 7;
#pragma unroll
    for (int j = 0; j < 8; ++j) { const int n = (lane >> 3) + 8 * j; float v[8];
#pragma unroll
        for (int q = 0; q < 8; ++q) v[q] = scr[(8 * c + q) * 64 + 4 * ((n >> 2) ^ ((c ^ q) & 7)) + (n & 3)];
        if (J.fp8) { v2u o8; o8.x = pg8::pk4_fp8(v[0] * SC_W, v[1] * SC_W, v[2] * SC_W, v[3] * SC_W); o8.y = pg8::pk4_fp8(v[4] * SC_W, v[5] * SC_W, v[6] * SC_W, v[7] * SC_W);
            __builtin_nontemporal_store(o8, (v2u*)((unsigned char*)J.dst + (size_t)(drow0 + n) * J.ld + J.koff + k0 + 8 * c)); }
        else { v4u o; o.x = pk2(v[0], v[1]); o.y = pk2(v[2], v[3]); o.z = pk2(v[4], v[5]); o.w = pk2(v[6], v[7]);
            *(v4u*)(J.dst + (size_t)(drow0 + n) * J.ld + J.koff + k0 + 8 * c) = o; } }
    LDS_WAIT(); asm volatile("" ::: "memory");
}
struct CvtCursor { int j, base, n; CvtJob J; };
__device__ __forceinline__ bool cvt_advance(const Frame& F, CvtCursor& C, int jb, int jc, int jd, int flat, int& item) {
    while (flat - C.base >= C.n) { C.base += C.n; ++C.j; if (C.j == jb) C.j = jc; if (C.j >= jd) { C.n = 0x3fffffff; return false; } C.J = get_job(F, C.j); C.n = (C.J.K / 64) * (C.J.N / 64); }
    item = flat - C.base; return true;
}
__device__ __forceinline__ void convert_jobs(const Frame& F, int ja, int jb, int jc, int jd, int widx, int nw) {
    if (widx < 0) return;
    LAS float* scr = (LAS float*)(F.lds + F.wave * 16384);
    CvtCursor C; C.j = (ja < jb) ? ja : jc; if (C.j >= jd) return; C.base = 0; C.J = get_job(F, C.j); C.n = (C.J.K / 64) * (C.J.N / 64);
    int flat = widx, itc = 0; bool ok = cvt_advance(F, C, jb, jc, jd, flat, itc);
    CvtJob Jc = C.J; f32x4 ld[16];
    if (ok) cvt_load(Jc, itc, F.lane, ld);
    while (ok) {
        cvt_to_lds(Jc, itc, F.lane, ld, scr);
        flat += nw; int itn = 0; const bool okn = cvt_advance(F, C, jb, jc, jd, flat, itn); const CvtJob Jn = C.J;
        if (okn) cvt_load(Jn, itn, F.lane, ld);
        asm volatile("" ::: "memory");
        cvt_store(Jc, itc, F.lane, scr);
        Jc = Jn; itc = itn; ok = okn;
    }
}
__device__ __forceinline__ void convert_jobs(const Frame& F, int jlo, int jhi, int widx, int nw) { convert_jobs(F, jlo, jhi, jhi, jhi, widx, nw); }

__device__ __forceinline__ void ssm_tables(const Frame& F, int gt, int NT) {
    for (int i = gt; i < 2 * 16 * 64; i += NT) {
        const int l = i >> 10, g = (i >> 6) & 15, p = i & 63;
        unsigned char* tab = F.ws + WS_TAB + (size_t)l * TAB_STRIDE;
        const float lr = fminf(F.in[I_LAM_RE][i], -1e-4f), li = F.in[I_LAM_IM][i], dt = expf(F.in[I_LOG_DT][l * 16 + g]);
        const float mag = expf(lr * dt), ar = mag * cosf(li * dt), ai = mag * sinf(li * dt);
        const float den = lr * lr + li * li, nr = ar - 1.0f, ni = ai;
        const float fr = (nr * lr + ni * li) / den, fi = (ni * lr - nr * li) / den;
        const double ang = (double)li * (double)dt * 64.0; const double rev = ang * 0.15915494309189535; const float rf = (float)((rev - rint(rev)) * 6.283185307179586);
        const float magT = expf(64.0f * lr * dt);
        ((f32x4*)(tab + TAB_ABAR))[g * 64 + p] = (f32x4){ar, ai, magT * cosf(rf), magT * sinf(rf)};
        float* bb = (float*)(tab + TAB_BBAR) + (size_t)(g * 64 + p) * 32;
        const float* bre = F.in[I_B_RE] + (size_t)i * 16; const float* bim = F.in[I_B_IM] + (size_t)i * 16;
#pragma unroll
        for (int h = 0; h < 16; ++h) { const float br = bre[h], bi = bim[h]; bb[2 * h] = fr * br - fi * bi; bb[2 * h + 1] = fr * bi + fi * br; }
    }
    for (int i = gt; i < 2 * 16 * 8 * 64; i += NT) {
        const int l = i >> 13, g = (i >> 9) & 15, cbk = (i >> 6) & 7, ln = i & 63;
        const int c = cbk * 16 + (ln & 15), p = c >> 1, ri = c & 1, kh = ln >> 4;
        unsigned w[4] = {0u, 0u, 0u, 0u};
        if (kh < 2) {
            const int idx = (l * 16 + g) * 64 + p;
            const float lr = fminf(F.in[I_LAM_RE][idx], -1e-4f), li = F.in[I_LAM_IM][idx], dt = expf(F.in[I_LOG_DT][l * 16 + g]);
            const float mag = expf(lr * dt), ar = mag * cosf(li * dt), ai = mag * sinf(li * dt);
            const float den = lr * lr + li * li, nr = ar - 1.0f, ni = ai;
            const float fr = (nr * lr + ni * li) / den, fi = (ni * lr - nr * li) / den;
            const float* bre = F.in[I_B_RE] + (size_t)idx * 16 + 8 * kh; const float* bim = F.in[I_B_IM] + (size_t)idx * 16 + 8 * kh;
            float v[8];
#pragma unroll
            for (int j = 0; j < 8; ++j) { const float br = bre[j], bi = bim[j]; v[j] = ri ? (fr * bi + fi * br) : (fr * br - fi * bi); }
            w[0] = pk2(v[0], v[1]); w[1] = pk2(v[2], v[3]); w[2] = pk2(v[4], v[5]); w[3] = pk2(v[6], v[7]);
        }
        ((v4u*)(F.ws + WS_TAB + (size_t)l * TAB_STRIDE + TAB_BBF))[i & 8191] = (v4u){w[0], w[1], w[2], w[3]};
    }
    for (int i = gt; i < 2 * 16 * 4 * 64; i += NT) {
        const int l = i >> 12, g = (i >> 8) & 15, ks = (i >> 6) & 3, ln = i & 63;
        const int hp = ln & 15;
        const float* cre = F.in[I_C_RE] + ((size_t)(l * 16 + g) * 16 + hp) * 64; const float* cim = F.in[I_C_IM] + ((size_t)(l * 16 + g) * 16 + hp) * 64;
        unsigned w[4];
#pragma unroll
        for (int jj = 0; jj < 4; ++jj) { const int k = ks * 32 + 8 * (ln >> 4) + 2 * jj, p = k >> 1; w[jj] = pk2(cre[p], -cim[p]); }
        ((v4u*)(F.ws + WS_TAB + (size_t)l * TAB_STRIDE + TAB_CMATB))[i & 4095] = (v4u){w[0], w[1], w[2], w[3]};
    }
}

__device__ __forceinline__ void router_fill(const Frame& F) {
    LAS float* wrt = (LAS float*)F.lds; const float* wr = F.in[I_ROUTER];
    for (int i = F.tid; i < D * NE; i += NTHR) wrt[(i & 7) * D + (i >> 3)] = wr[i];
    __syncthreads();
}
template <bool ROUTER>
__device__ __forceinline__ void norm_rows(const Frame& F, const bf16* src, const float* gain, bf16* dst, int gw, int NGW) {
    LAS float* wrt = (LAS float*)F.lds;
    f32x4 gv[4];
#pragma unroll
    for (int j = 0; j < 4; ++j) gv[j] = ((const f32x4*)gain)[F.lane + 64 * j];
    v2u nv[4];
    if (gw < M) {
#pragma unroll
        for (int j = 0; j < 4; ++j) nv[j] = ((const v2u*)(src + (size_t)gw * D) + F.lane)[64 * j]; }
    for (int m = gw; m < M; m += NGW) {
        f32x4 v[4]; float s = 0.f;
#pragma unroll
        for (int j = 0; j < 4; ++j) v[j] = (f32x4){bfl(nv[j].x), bfh(nv[j].x), bfl(nv[j].y), bfh(nv[j].y)};
        if (m + NGW < M) {
#pragma unroll
            for (int j = 0; j < 4; ++j) nv[j] = ((const v2u*)(src + (size_t)(m + NGW) * D) + F.lane)[64 * j]; }
#pragma unroll
        for (int j = 0; j < 4; ++j) s += (v[j].x * v[j].x + v[j].y * v[j].y) + (v[j].z * v[j].z + v[j].w * v[j].w);
        const float rstd = 1.0f / sqrtf(wave_sum(s) * (1.0f / D) + EPS);
        if (ROUTER) { unsigned* o4 = (unsigned*)((unsigned char*)dst + (size_t)m * D) + F.lane;
#pragma unroll
            for (int j = 0; j < 4; ++j) { v[j] = v[j] * rstd * gv[j]; o4[64 * j] = pg8::pk4_fp8(v[j].x * SC_XS, v[j].y * SC_XS, v[j].z * SC_XS, v[j].w * SC_XS); } }
        else { unsigned long long* o8 = (unsigned long long*)(dst + (size_t)m * D) + F.lane;
#pragma unroll
            for (int j = 0; j < 4; ++j) { v[j] = v[j] * rstd * gv[j]; o8[64 * j] = (unsigned long long)pk2(v[j].x, v[j].y) | ((unsigned long long)pk2(v[j].z, v[j].w) << 32); } }
        if (ROUTER) {
            float lg[8];
#pragma unroll
            for (int e = 0; e < 8; ++e) { float a = 0.f;
#pragma unroll
                for (int j = 0; j < 4; ++j) { const f32x4 w = *(const LAS f32x4*)(wrt + e * D + 4 * F.lane + 256 * j); a += (v[j].x * w.x + v[j].y * w.y) + (v[j].z * w.z + v[j].w * w.w); }
                lg[e] = wave_sum(a); }
            if (F.lane == 0) {
                int i1 = 0; float v1 = lg[0];
#pragma unroll
                for (int e = 1; e < 8; ++e) if (lg[e] > v1) { v1 = lg[e]; i1 = e; }
                int i2 = -1; float v2 = -INFINITY;
#pragma unroll
                for (int e = 0; e < 8; ++e) if (e != i1 && lg[e] > v2) { v2 = lg[e]; i2 = e; }
                const float e2 = expf(v2 - v1), w1 = 1.0f / (1.0f + e2);
                ((int2*)(F.ws + WS_TOPI))[m] = make_int2(i1, i2);
                ((float2*)(F.ws + WS_TOPW))[m] = make_float2(w1, e2 * w1);
            }
        }
    }
}

__device__ __forceinline__ void cast_rows(const Frame& F, const float* src, bf16* dst, int gw, int NGW) {
    float* ssp = (float*)(F.ws + WS_SSP);
    for (int m0 = gw; m0 < M; m0 += 4 * NGW) {
        f32x4 v[4][4];
#pragma unroll
        for (int r = 0; r < 4; ++r) { const int m = (m0 + r * NGW < M) ? m0 + r * NGW : m0;
#pragma unroll
            for (int j = 0; j < 4; ++j) v[r][j] = __builtin_nontemporal_load(&((const f32x4*)(src + (size_t)m * D) + F.lane)[64 * j]); }
#pragma unroll
        for (int r = 0; r < 4; ++r) { const int m = m0 + r * NGW; if (m < M) {
            float s = 0.f;
#pragma unroll
            for (int j = 0; j < 4; ++j) s += (v[r][j].x * v[r][j].x + v[r][j].y * v[r][j].y) + (v[r][j].z * v[r][j].z + v[r][j].w * v[r][j].w);
            s = wave_sum(s);
            unsigned long long* o8 = (unsigned long long*)(dst + (size_t)m * D) + F.lane;
#pragma unroll
            for (int j = 0; j < 4; ++j) o8[64 * j] = (unsigned long long)pk2(v[r][j].x, v[r][j].y) | ((unsigned long long)pk2(v[r][j].z, v[r][j].w) << 32);
            unsigned* o4 = (unsigned*)(F.ws + WS_HB8 + (size_t)m * D) + F.lane;
#pragma unroll
            for (int j = 0; j < 4; ++j) o4[64 * j] = pg8::pk4_fp8(v[r][j].x * SC_XS, v[r][j].y * SC_XS, v[r][j].z * SC_XS, v[r][j].w * SC_XS);
            if (F.lane < 16) ssp[(size_t)m * 16 + F.lane] = (F.lane == 0) ? s : 0.f; } }
    }
}
__device__ __forceinline__ void cfma(float& sr, float& si, float ar, float ai, float br, float bi) {
    float t1, t2, nr, ni; const float nai = -ai;
    asm volatile("v_fma_f32 %0, %1, %2, %3" : "=v"(t1) : "v"(ar), "v"(sr), "v"(br));
    asm volatile("v_fma_f32 %0, %1, %2, %3" : "=v"(nr) : "v"(nai), "v"(si), "v"(t1));
    asm volatile("v_fma_f32 %0, %1, %2, %3" : "=v"(t2) : "v"(ar), "v"(si), "v"(bi));
    asm volatile("v_fma_f32 %0, %1, %2, %3" : "=v"(ni) : "v"(ai), "v"(sr), "v"(t2));
    sr = nr; si = ni;
}
constexpr int BUP = 132;
__device__ __forceinline__ bf16x8 ssm_u_frag(const bf16* proj, int tokb, int g, int lane) {
    bf16x8 a = {0, 0, 0, 0, 0, 0, 0, 0};
    if ((lane >> 4) < 2) a = *(const bf16x8*)(proj + (size_t)(tokb + (lane & 15)) * INC + C_U + g * 16 + 8 * (lane >> 4));
    return a;
}
__device__ __forceinline__ void ssm_bu_block(LAS float* bu, const bf16x8 (&bbf)[8], bf16x8 a, int lane) {
    const int kh = lane >> 4;
#pragma unroll
    for (int cb = 0; cb < 8; ++cb) {
        const pg8::f32x4 d = __builtin_amdgcn_mfma_f32_16x16x32_bf16(a, bbf[cb], (pg8::f32x4){0.f, 0.f, 0.f, 0.f}, 0, 0, 0);
#pragma unroll
        for (int r = 0; r < 4; ++r) bu[(4 * kh + r) * BUP + cb * 16 + (lane & 15)] = d[r];
    }
    LDS_WAIT(); asm volatile("" ::: "memory");
}
#define SSM_STEP(tt_) do { const f32x2v b_ = *(const LAS f32x2v*)(bu + (tt_) * BUP + 2 * p); \
    cfma(sr, si, ab.x, ab.y, b_.x, b_.y); } while (0)

__device__ __forceinline__ void ssm1_conv_unit(const Frame& F, int l, int unit) {
    const bf16* proj = (const bf16*)(F.ws + WS_BIG); bf16* ycat = (bf16*)(F.ws + F.ycat_off);
    const unsigned char* tab = F.ws + WS_TAB + (size_t)l * TAB_STRIDE;
    const float* cw = F.in[I_CONV_W] + (size_t)l * 3 * 256;
    LAS float* bu = (LAS float*)(F.lds + F.wave * (16 * BUP * 4));
    const int p = F.lane, tok0 = unit * 64;
    v4u hv[2][3], cv[2][3], bv[2];
#define CONV_LOAD(trip) do { _Pragma("unroll") for (int k = 0; k < 2; ++k) { const int it = F.tid + (2 * (trip) + k) * NTHR, tt = it >> 5, cg = (it & 31) * 8, tok = tok0 + tt, tl = tok & (SEQ - 1); \
            const bf16* row = proj + (size_t)tok * INC; \
            _Pragma("unroll") for (int d = 0; d < 3; ++d) { const size_t back = (tl >= d) ? (size_t)d * INC : 0; hv[k][d] = *(const v4u*)(row - back + C_CH + cg); cv[k][d] = *(const v4u*)(row - back + C_CC + cg); } \
            bv[k] = *(const v4u*)(row + C_CB + cg); } } while (0)
#define CONV_FIN(trip) do { _Pragma("unroll") for (int k = 0; k < 2; ++k) { const int it = F.tid + (2 * (trip) + k) * NTHR, tt = it >> 5, cg = (it & 31) * 8, tok = tok0 + tt, tl = tok & (SEQ - 1); \
            float u[3][8]; \
            _Pragma("unroll") for (int d = 0; d < 3; ++d) { const float keep = (tl >= d) ? 1.f : 0.f;              \
                const unsigned hw[4] = {hv[k][d].x, hv[k][d].y, hv[k][d].z, hv[k][d].w}, cww[4] = {cv[k][d].x, cv[k][d].y, cv[k][d].z, cv[k][d].w}; \
                _Pragma("unroll") for (int q = 0; q < 4; ++q) { u[d][2 * q] = keep * (bfl(hw[q]) * bfl(cww[q])); u[d][2 * q + 1] = keep * (bfh(hw[q]) * bfh(cww[q])); } } \
            const unsigned bw[4] = {bv[k].x, bv[k].y, bv[k].z, bv[k].w}; float o[8]; \
            _Pragma("unroll") for (int q = 0; q < 8; ++q) { const float y = cw[cg + q] * u[2][q] + cw[256 + cg + q] * u[1][q] + cw[512 + cg + q] * u[0][q]; const float bg = (q & 1) ? bfh(bw[q >> 1]) : bfl(bw[q >> 1]); o[q] = bg * y; } \
            *(v4u*)(ycat + (size_t)tok * D + 768 + cg) = (v4u){pk2(o[0], o[1]), pk2(o[2], o[3]), pk2(o[4], o[5]), pk2(o[6], o[7])}; } } while (0)
    CONV_LOAD(0); asm volatile("" ::: "memory");
#pragma unroll
    for (int gi = 0; gi < 2; ++gi) {
        const int g = F.wave * 2 + gi;
        bf16x8 bbf[8];
#pragma unroll
        for (int cb = 0; cb < 8; ++cb) bbf[cb] = ((const bf16x8*)(tab + TAB_BBF))[(g * 8 + cb) * 64 + F.lane];
        const f32x4 ab = ((const f32x4*)(tab + TAB_ABAR))[g * 64 + p];
        bf16x8 af[4];
#pragma unroll
        for (int tb = 0; tb < 4; ++tb) af[tb] = ssm_u_frag(proj, tok0 + tb * 16, g, F.lane);
        float sr = 0.f, si = 0.f;
#pragma unroll
        for (int tb = 0; tb < 4; ++tb) {
            ssm_bu_block(bu, bbf, af[tb], F.lane);
#pragma unroll
            for (int tt = 0; tt < 16; ++tt) SSM_STEP(tt);
        }
        ((float2*)(F.ws + WS_E))[((size_t)unit * 16 + g) * 64 + p] = make_float2(sr, si);
        LDS_WAIT(); asm volatile("" ::: "memory");
        if (gi == 0) { CONV_FIN(0); CONV_LOAD(1); asm volatile("" ::: "memory"); } else CONV_FIN(1);
    }
#undef CONV_LOAD
#undef CONV_FIN
}
__device__ __forceinline__ int crow(int r, int hi) { return (r & 3) + 8 * (r >> 2) + 4 * hi; }
constexpr int VPITCH = 144;
typedef short v4i16_t __attribute__((ext_vector_type(4)));
__device__ __forceinline__ bf16x8 pack8(float a, float b, float c, float d, float e, float f, float g, float h) {
    v4u w = {pk2(a, b), pk2(c, d), pk2(e, f), pk2(g, h)}; return __builtin_bit_cast(bf16x8, w); }
__device__ __forceinline__ void attn_unit(const Frame& F, int uidx, LAS unsigned char* vl) {
    const int lane = F.lane, r32 = lane & 31, hh = lane >> 5;
    const int bh = uidx >> 7, qb = uidx & 127, b = bh >> 3, h = bh & 7, t0 = qb * 32, tq = t0 + r32;
    const bf16* P = (const bf16*)(F.ws + WS_BIG) + (size_t)b * SEQ * INC;
    bf16* ycat = (bf16*)(F.ws + F.ycat_off);
    bf16x8 qf[4];
#pragma unroll
    for (int ks = 0; ks < 4; ++ks) qf[ks] = *(const bf16x8*)(P + (size_t)tq * INC + C_Q + h * 64 + 16 * ks + 8 * hh);
    f32x16 o0 = {}, o1 = {};
    float carry = 0.f;
    const int trb = ((lane & 15) >> 2) * VPITCH + (16 * ((lane >> 4) & 1) + 4 * (lane & 3)) * 2 + 4 * hh * VPITCH;
    bf16x8 kf0[4], kf1[4];
    v4u vv[8];
    const unsigned vlo = (unsigned)(((lane >> 3) * INC + (lane & 7) * 8) * 2), klo = (unsigned)((r32 * INC + 8 * hh) * 2);
    const char* Pv = (const char*)(P + C_V + h * 64); const char* Pk = (const char*)(P + C_K + h * 64);
#define AT_LOADV(KSB) do { const char* vb_ = Pv + (size_t)(KSB) * (INC * 2); _Pragma("unroll") for (int i = 0; i < 8; ++i) vv[i] = *(const v4u*)(vb_ + (size_t)(8 * i) * (INC * 2) + vlo); } while (0)
#define AT_LOADK(KSB) do { const char* kb_ = Pk + (size_t)(KSB) * (INC * 2); \
            _Pragma("unroll") for (int ks = 0; ks < 4; ++ks) { kf0[ks] = *(const bf16x8*)(kb_ + klo + 32 * ks); kf1[ks] = *(const bf16x8*)(kb_ + (size_t)32 * (INC * 2) + klo + 32 * ks); } } while (0)
    { const int kb0 = t0 - 32 < 0 ? 0 : t0 - 32; AT_LOADV(kb0); AT_LOADK(kb0); }
    for (int kend = t0 + 32; kend > 0; kend -= 64) {
        const int ks0 = kend - 64;
        asm volatile("" : "+v"(vv[0]), "+v"(vv[1]), "+v"(vv[2]), "+v"(vv[3]), "+v"(vv[4]), "+v"(vv[5]), "+v"(vv[6]), "+v"(vv[7]));
#pragma unroll
        for (int i = 0; i < 8; ++i) { const int row = (lane >> 3) + 8 * i; *(LAS v4u*)(vl + row * VPITCH + (lane & 7) * 16) = vv[i]; }
        const int ksb = ks0 < 0 ? 0 : ks0, ksn = ks0 - 64 < 0 ? 0 : ks0 - 64;
        AT_LOADV(ksn); asm volatile("" ::: "memory");
        f32x16 s0 = {}, s1 = {};
#pragma unroll
        for (int ks = 0; ks < 4; ++ks) { s0 = __builtin_amdgcn_mfma_f32_32x32x16_bf16(kf0[ks], qf[ks], s0, 0, 0, 0); s1 = __builtin_amdgcn_mfma_f32_32x32x16_bf16(kf1[ks], qf[ks], s1, 0, 0, 0); }
        asm volatile("" : "+v"(s0), "+v"(s1));
        AT_LOADK(ksn); asm volatile("" ::: "memory");
        f32x16 c0, c1; float tot = 0.f; const int kmax = kend < tq ? kend : tq;
#define SP_ELEM(S, C, I, KEY, MASKED) do { const float z2 = 0.18033688011112042f * S[I]; const float sp = fmaxf(z2, 0.f) + __builtin_amdgcn_logf(1.f + __builtin_amdgcn_exp2f(-fabsf(z2))); \
            if (MASKED) { const bool valid = (KEY) < kmax; C[I] = valid ? (z2 - sp) + carry : -INFINITY; S[I] = valid ? -sp : 0.f; } else { C[I] = (z2 - sp) + carry; S[I] = -sp; } tot += S[I]; } while (0)
        if (ks0 >= 0 && kend <= t0) {
#pragma unroll
            for (int i = 0; i < 16; ++i) SP_ELEM(s1, c1, i, 0, false);
            tot += __shfl_xor(tot, 32); carry += tot; tot = 0.f;
#pragma unroll
            for (int i = 0; i < 16; ++i) SP_ELEM(s0, c0, i, 0, false);
        } else {
#pragma unroll
            for (int i = 0; i < 16; ++i) { const int key1 = ksb + 32 + crow(i, hh); SP_ELEM(s1, c1, i, key1, true); }
            tot += __shfl_xor(tot, 32); carry += tot; tot = 0.f;
#pragma unroll
            for (int i = 0; i < 16; ++i) { const int key0 = ksb + crow(i, hh); SP_ELEM(s0, c0, i, key0, true); }
        }
#undef SP_ELEM
        tot += __shfl_xor(tot, 32); carry += tot;
        {
#define HIW(S, q8) ((v4u){pk2(S[(q8)], S[(q8) + 1]), pk2(S[(q8) + 2], S[(q8) + 3]), pk2(S[(q8) + 4], S[(q8) + 5]), pk2(S[(q8) + 6], S[(q8) + 7])})
#define LOW(S, q8, H) ((v4u){pk2(S[(q8)] - bfl((H).x), S[(q8) + 1] - bfh((H).x)), pk2(S[(q8) + 2] - bfl((H).y), S[(q8) + 3] - bfh((H).y)), pk2(S[(q8) + 4] - bfl((H).z), S[(q8) + 5] - bfh((H).z)), pk2(S[(q8) + 6] - bfl((H).w), S[(q8) + 7] - bfh((H).w))})
#define CUM6(X00, X01, X10, X11) do { c0 = __builtin_amdgcn_mfma_f32_32x32x16_bf16(T0, X00, c0, 0, 0, 0); c0 = __builtin_amdgcn_mfma_f32_32x32x16_bf16(T1, X01, c0, 0, 0, 0); \
            c1 = __builtin_amdgcn_mfma_f32_32x32x16_bf16(T0, X10, c1, 0, 0, 0); c1 = __builtin_amdgcn_mfma_f32_32x32x16_bf16(T1, X11, c1, 0, 0, 0); } while (0)
            bf16x8 T0, T1;
            { int lt = lane; asm volatile("" : "+v"(lt)); const int rt = lt & 31, ht = lt >> 5;
#pragma unroll
              for (int j = 0; j < 8; ++j) { const int ko = 8 * (j >> 2) + 4 * ht + (j & 3); T0[j] = (ko > rt) ? (short)0x3F80 : (short)0; T1[j] = (16 + ko > rt) ? (short)0x3F80 : (short)0; } }
            const v4u h00 = HIW(s0, 0), h01 = HIW(s0, 8), h10 = HIW(s1, 0), h11 = HIW(s1, 8);
            CUM6(__builtin_bit_cast(bf16x8, h00), __builtin_bit_cast(bf16x8, h01), __builtin_bit_cast(bf16x8, h10), __builtin_bit_cast(bf16x8, h11));
            const v4u l00 = LOW(s0, 0, h00), l01 = LOW(s0, 8, h01), l10 = LOW(s1, 0, h10), l11 = LOW(s1, 8, h11);
            CUM6(__builtin_bit_cast(bf16x8, l00), __builtin_bit_cast(bf16x8, l01), __builtin_bit_cast(bf16x8, l10), __builtin_bit_cast(bf16x8, l11));
#undef HIW
#undef LOW
#undef CUM6
        }
#pragma unroll
        for (int i = 0; i < 16; ++i) { c0[i] = __builtin_amdgcn_exp2f(c0[i]); c1[i] = __builtin_amdgcn_exp2f(c1[i]); }
#pragma unroll
        for (int kq = 0; kq < 4; ++kq) {
            const bf16x8 wa = (kq & 2) ? pack8(c1[8 * (kq & 1)], c1[8 * (kq & 1) + 1], c1[8 * (kq & 1) + 2], c1[8 * (kq & 1) + 3], c1[8 * (kq & 1) + 4], c1[8 * (kq & 1) + 5], c1[8 * (kq & 1) + 6], c1[8 * (kq & 1) + 7])
                                       : pack8(c0[8 * (kq & 1)], c0[8 * (kq & 1) + 1], c0[8 * (kq & 1) + 2], c0[8 * (kq & 1) + 3], c0[8 * (kq & 1) + 4], c0[8 * (kq & 1) + 5], c0[8 * (kq & 1) + 6], c0[8 * (kq & 1) + 7]);
#pragma unroll
            for (int db = 0; db < 2; ++db) {
                LAS unsigned char* vp = vl + trb + 16 * kq * VPITCH + 64 * db;
                const v4i16_t lo = __builtin_amdgcn_ds_read_tr16_b64_v4i16((LAS v4i16_t*)vp), hi = __builtin_amdgcn_ds_read_tr16_b64_v4i16((LAS v4i16_t*)(vp + 8 * VPITCH));
                const bf16x8 vf = {lo[0], lo[1], lo[2], lo[3], hi[0], hi[1], hi[2], hi[3]};
                if (db == 0) o0 = __builtin_amdgcn_mfma_f32_32x32x16_bf16(wa, vf, o0, 0, 0, 0); else o1 = __builtin_amdgcn_mfma_f32_32x32x16_bf16(wa, vf, o1, 0, 0, 0);
            }
        }
        if (__all(carry < SB_EXIT)) break;
    }
#undef AT_LOADV
#undef AT_LOADK
    int lz = lane; asm volatile("" : "+v"(lz));
    bf16* op = ycat + (size_t)(b * SEQ + t0 + 4 * (lz >> 5)) * D + h * 64 + (lz & 31);
#pragma unroll
    for (int i = 0; i < 16; ++i) { const int q = crow(i, 0); op[(size_t)q * D] = (bf16)f2bf(o0[i]); op[(size_t)q * D + 32] = (bf16)f2bf(o1[i]); }
    LDS_WAIT(); asm volatile("" ::: "memory");
}
__device__ __forceinline__ void mixer_b(const Frame& F, int l, int nrep_s, int nrep_a) {
    for (int rep = 0; rep < nrep_s; ++rep)
    for (int u = blockIdx.x; u < NCHUNK; u += F.G) ssm1_conv_unit(F, l, u);
    __syncthreads();
    LAS unsigned char* vl = F.lds + 32768 + F.wave * (64 * VPITCH);
    const int gw = blockIdx.x * NWAVES + F.wave, NGW = F.G * NWAVES;
    for (int rep = 0; rep < nrep_a; ++rep)
    for (int uidx = gw; uidx < BATCH * NHEAD * (SEQ / 32); uidx += NGW) attn_unit(F, uidx, vl);
}

__device__ __forceinline__ void ssm_pass2_unit(const Frame& F, int l, int unit) {
    const bf16* proj = (const bf16*)(F.ws + WS_BIG); bf16* ycat = (bf16*)(F.ws + F.ycat_off);
    const unsigned char* tab = F.ws + WS_TAB + (size_t)l * TAB_STRIDE;
    const float* dsk = F.in[I_SSM_D] + l * 256;
    const bf16* wglu = (const bf16*)(F.ws + WS_WGLU0 + (size_t)l * WS_LSTRIDE);
    LAS float* bu = (LAS float*)(F.lds + F.wave * (16 * BUP * 4));
    LAS unsigned char* sst = (LAS unsigned char*)bu;
    LAS unsigned char* yg = F.lds + 8 * (16 * BUP * 4);
    const int lane = F.lane, p = lane, tok0 = unit * 64, cfirst = unit & ~63;
    float s0r = 0.f, s0i = 0.f, s1r = 0.f, s1i = 0.f;
    { const f32x4 ab0 = ((const f32x4*)(tab + TAB_ABAR))[(F.wave * 2) * 64 + p], ab1 = ((const f32x4*)(tab + TAB_ABAR))[(F.wave * 2 + 1) * 64 + p];
      const float2* ep = (const float2*)(F.ws + WS_E) + (size_t)(F.wave * 2) * 64 + p;
      float2 e0[8], e1[8], f0[8], f1[8];
#define HORNER_LOAD(A0, A1, CC) do { _Pragma("unroll") for (int q = 0; q < 8; ++q) { const int ci = ((CC) + q < unit) ? (CC) + q : cfirst; A0[q] = ep[(size_t)ci * 1024]; A1[q] = ep[(size_t)ci * 1024 + 64]; } } while (0)
#define HORNER_APPLY(A0, A1, CC) do { _Pragma("unroll") for (int q = 0; q < 8; ++q) if ((CC) + q < unit) { cfma(s0r, s0i, ab0.z, ab0.w, A0[q].x, A0[q].y); cfma(s1r, s1i, ab1.z, ab1.w, A1[q].x, A1[q].y); } } while (0)
      if (cfirst < unit) HORNER_LOAD(e0, e1, cfirst);
      for (int cc = cfirst; cc < unit; cc += 16) {
          if (cc + 8 < unit) HORNER_LOAD(f0, f1, cc + 8);
          asm volatile("" ::: "memory");
          HORNER_APPLY(e0, e1, cc);
          if (cc + 16 < unit) HORNER_LOAD(e0, e1, cc + 16);
          asm volatile("" ::: "memory");
          if (cc + 8 < unit) HORNER_APPLY(f0, f1, cc + 8);
      }
#undef HORNER_LOAD
#undef HORNER_APPLY
    }
    for (int gi = 0; gi < 2; ++gi) {
        const int g = F.wave * 2 + gi;
        bf16x8 bbf[8];
#pragma unroll
        for (int cb = 0; cb < 8; ++cb) bbf[cb] = ((const bf16x8*)(tab + TAB_BBF))[(g * 8 + cb) * 64 + lane];
        const f32x4 ab = ((const f32x4*)(tab + TAB_ABAR))[g * 64 + p];
        bf16x8 cb4[4];
#pragma unroll
        for (int ks = 0; ks < 4; ++ks) cb4[ks] = ((const bf16x8*)(tab + TAB_CMATB))[(g * 4 + ks) * 64 + lane];
        bf16x8 af[4]; bf16 uvs[4][4];
#pragma unroll
        for (int tb = 0; tb < 4; ++tb) { af[tb] = ssm_u_frag(proj, tok0 + tb * 16, g, lane);
#pragma unroll
            for (int r = 0; r < 4; ++r) uvs[tb][r] = proj[(size_t)(tok0 + tb * 16 + 4 * (lane >> 4) + r) * INC + C_U + g * 16 + (lane & 15)]; }
        float sr = gi ? s1r : s0r, si = gi ? s1i : s0i;
        const float dk = dsk[g * 16 + (lane & 15)];
#pragma unroll
        for (int tb = 0; tb < 4; ++tb) {
            ssm_bu_block(bu, bbf, af[tb], lane);
            { f32x2v bq[16];
#pragma unroll
              for (int tt = 0; tt < 16; ++tt) bq[tt] = *(const LAS f32x2v*)(bu + tt * BUP + 2 * p);
              LDS_WAIT(); asm volatile("" ::: "memory");
#pragma unroll
              for (int tt = 0; tt < 16; ++tt) { cfma(sr, si, ab.x, ab.y, bq[tt].x, bq[tt].y); *(LAS unsigned*)(sst + tt * (BUP * 4) + p * 4) = pk2(sr, si); } }
            pg8::f32x4 acc = {0.f, 0.f, 0.f, 0.f};
#pragma unroll
            for (int ks = 0; ks < 4; ++ks) { const bf16x8 a = *(const LAS bf16x8*)(sst + (lane & 15) * (BUP * 4) + (ks * 32 + 8 * (lane >> 4)) * 2); acc = __builtin_amdgcn_mfma_f32_16x16x32_bf16(a, cb4[ks], acc, 0, 0, 0); }
#pragma unroll
            for (int r = 0; r < 4; ++r) { const int t = tb * 16 + 4 * (lane >> 4) + r; const float y = acc[r] + dk * bf2f(uvs[tb][r]);
                const float gl = y * __builtin_amdgcn_rcpf(1.f + __builtin_amdgcn_exp2f(-2.3022081986f * (y + 0.044715f * y * y * y)));
                *(LAS bf16*)(yg + t * 528 + (g * 16 + (lane & 15)) * 2) = (bf16)f2bf(gl); }
        }
        LDS_WAIT(); asm volatile("" ::: "memory");
    }
    const int n0 = 32 * F.wave, r32 = lane & 31, hh = lane >> 5;
    bf16x8 wfr[16];
    { const bf16* wrow = wglu + (size_t)(n0 + r32) * 256 + 8 * hh;
#pragma unroll
      for (int ks = 0; ks < 16; ++ks) wfr[ks] = *(const bf16x8*)(wrow + 16 * ks); }
    __syncthreads();
    {
        f32x16 a0 = {}, a1 = {};
#pragma unroll
        for (int ks = 0; ks < 16; ++ks) {
            const bf16x8 bfr = wfr[ks];
            const bf16x8 x0 = *(const LAS bf16x8*)(yg + r32 * 528 + (16 * ks + 8 * hh) * 2), x1 = *(const LAS bf16x8*)(yg + (32 + r32) * 528 + (16 * ks + 8 * hh) * 2);
            a0 = __builtin_amdgcn_mfma_f32_32x32x16_bf16(x0, bfr, a0, 0, 0, 0); a1 = __builtin_amdgcn_mfma_f32_32x32x16_bf16(x1, bfr, a1, 0, 0, 0);
        }
#pragma unroll
        for (int r = 0; r < 16; ++r) { const int t = crow(r, hh);
            { const float yv = bf2f(*(const LAS bf16*)(yg + t * 528 + (n0 + r32) * 2)); ycat[(size_t)(tok0 + t) * D + 512 + n0 + r32] = (bf16)f2bf(yv * __builtin_amdgcn_rcpf(1.f + __builtin_amdgcn_exp2f(-1.4426950409f * a0[r]))); }
            { const float yv = bf2f(*(const LAS bf16*)(yg + (32 + t) * 528 + (n0 + r32) * 2)); ycat[(size_t)(tok0 + 32 + t) * D + 512 + n0 + r32] = (bf16)f2bf(yv * __builtin_amdgcn_rcpf(1.f + __builtin_amdgcn_exp2f(-1.4426950409f * a1[r]))); } }
    }
    __syncthreads();
}

__device__ __forceinline__ void moe_gather(const Frame& F) {
    LAS int* cnt = (LAS int*)F.lds;
    LAS int* tot = (LAS int*)(F.lds + 16384);
    LAS int* slot_l = (LAS int*)(F.lds + 16384 + 256);
    const int2* topi = (const int2*)(F.ws + WS_TOPI);
    const unsigned char* xn = F.ws + WS_XNN; unsigned char* xs = F.ws + WS_XS;
    v4u ra[8];
    { const int u0 = ((int)blockIdx.x < NCHUNK) ? (int)blockIdx.x : 0;
#pragma unroll
      for (int j = 0; j < 8; ++j) ra[j] = __builtin_nontemporal_load(&((const v4u*)(xn + (size_t)(64 * u0 + F.wave * 8 + j) * D))[F.lane]); }
    {   int c0 = 0, c1 = 0, c2 = 0, c3 = 0, c4 = 0, c5 = 0, c6 = 0, c7 = 0;
        for (int k = 0; k < 32; ++k) { const int2 ti = topi[F.tid * 32 + k];
            c0 += (ti.x == 0) + (ti.y == 0); c1 += (ti.x == 1) + (ti.y == 1); c2 += (ti.x == 2) + (ti.y == 2); c3 += (ti.x == 3) + (ti.y == 3);
            c4 += (ti.x == 4) + (ti.y == 4); c5 += (ti.x == 5) + (ti.y == 5); c6 += (ti.x == 6) + (ti.y == 6); c7 += (ti.x == 7) + (ti.y == 7); }
        cnt[0 * 512 + F.tid] = c0; cnt[1 * 512 + F.tid] = c1; cnt[2 * 512 + F.tid] = c2; cnt[3 * 512 + F.tid] = c3;
        cnt[4 * 512 + F.tid] = c4; cnt[5 * 512 + F.tid] = c5; cnt[6 * 512 + F.tid] = c6; cnt[7 * 512 + F.tid] = c7; }
    __syncthreads();
    {   LAS int* ce = cnt + F.wave * 512 + F.lane * 8;
        int v[8], s = 0;
#pragma unroll
        for (int q = 0; q < 8; ++q) { v[q] = ce[q]; s += v[q]; }
        int inc = s;
#pragma unroll
        for (int d = 1; d < 64; d <<= 1) { const int y = __shfl_up(inc, d); if (F.lane >= d) inc += y; }
        int run = inc - s;
#pragma unroll
        for (int q = 0; q < 8; ++q) { ce[q] = run; run += v[q]; }
        if (F.lane == 63) tot[F.wave] = inc; }
    __syncthreads();
    int seg[8]; { int a = 0;
#pragma unroll
        for (int e = 0; e < 8; ++e) { seg[e] = a; a += (tot[e] + 255) & ~255; } }
    if (blockIdx.x == 0 && F.tid < 8) __hip_atomic_store(F.ctl + CW_MOECNT + F.tid, (unsigned)tot[F.tid], RLX_AGENT);
    for (int u = blockIdx.x; u < NCHUNK; u += F.G) {
        if (F.wave == 0) {
            const int tk = 64 * u + F.lane, tp = tk >> 5; const int2 ti = topi[tk];
            const unsigned long long low = ((1ull << F.lane) - 1ull) & (F.lane >= 32 ? 0xFFFFFFFF00000000ull : 0x00000000FFFFFFFFull);
            int s1 = 0, s2 = 0;
#pragma unroll
            for (int e = 0; e < 8; ++e) { const unsigned long long mk = __ballot(ti.x == e || ti.y == e); const int within = __popcll(mk & low); const int pos = seg[e] + cnt[e * 512 + tp] + within;
                if (ti.x == e) s1 = pos; if (ti.y == e) s2 = pos; }
            ((int2*)(F.ws + WS_SLOT))[tk] = make_int2(s1, s2);
            slot_l[F.lane * 2] = s1; slot_l[F.lane * 2 + 1] = s2;
        }
        __syncthreads();
        {   if (u != (int)blockIdx.x) {
#pragma unroll
                for (int j = 0; j < 8; ++j) ra[j] = ((const v4u*)(xn + (size_t)(64 * u + F.wave * 8 + j) * D))[F.lane]; }
#pragma unroll
            for (int j = 0; j < 8; ++j) { const int s1 = slot_l[(F.wave * 8 + j) * 2], s2 = slot_l[(F.wave * 8 + j) * 2 + 1];
                ((v4u*)(xs + (size_t)s1 * D))[F.lane] = ra[j]; ((v4u*)(xs + (size_t)s2 * D))[F.lane] = ra[j]; }
        }
        __syncthreads();
    }
}
template <bool TS> struct MoeOrder {
    static constexpr bool VARK = TS;
    int nM, nN, G, c; int cs[9]; int nfull, nsplit, ntk, parts;
    __device__ __forceinline__ void init(unsigned* cntw, int nN_, int G_, int c_, int ntk_) { nN = nN_; G = G_; c = c_; ntk = ntk_; cs[0] = 0;
#pragma unroll
        for (int e = 0; e < 8; ++e) cs[e + 1] = cs[e] + (int)((__hip_atomic_load(cntw + e, RLX_AGENT) + 255u) >> 8);
        nM = cs[8]; const int total = nM * nN; nfull = TS ? (total / G) * G : total; nsplit = total - nfull;
        if (nsplit > 32) { nfull = total; nsplit = 0; }
        parts = 2; }
    __device__ __forceinline__ bool next(int i, pg8::Unit& u) const {
        const long L = (long)i * G + c; if (L >= (long)nfull + parts * nsplit) return false;
        int base = (int)L; u.nt = ntk; u.koff = 0; u.aux = -1;
        if (TS && L >= nfull) { const int q = ((int)L - nfull) / parts, part = ((int)L - nfull) % parts; base = nfull + q; u.nt = ntk / parts; u.koff = part * (ntk / parts) * 128; u.aux = part ? q * 3 + part - 1 : -1; }
        pg8::order_map(base, nM, nN, u);
        int e = 0;
#pragma unroll
        for (int k = 1; k < 8; ++k) e += (u.pm >= cs[k]) ? 1 : 0;
        u.pn += e * nN; return true; }
    __device__ __forceinline__ void a_ready(const pg8::Unit&) const {}
    __device__ __forceinline__ void done(const pg8::Unit&) const {}
};
__device__ __forceinline__ void final_rows(const Frame& F) {
    const int gw = F.vcu * NWAVES + F.wave, NGW = F.G * NWAVES;
    const bf16* H = (const bf16*)(F.ws + WS_XN); const bf16* ys = (const bf16*)(F.ws + WS_YS); const bf16* y2 = (const bf16*)(F.ws + WS_Y2);
    const int2* slot = (const int2*)(F.ws + WS_SLOT); const float2* tw = (const float2*)(F.ws + WS_TOPW);
    LAS int* stab = (LAS int*)F.lds;
    int nside;
    { MoeOrder<true> S; S.init(F.ctl + CW_MOECNT, D / 256, F.G, 0, FF / 128); nside = S.parts - 1;
      for (int i = F.tid; i < S.nM * 4; i += NTHR) stab[i] = -1;
      __syncthreads();
      for (int q = F.tid; q < S.nsplit; q += NTHR) { pg8::Unit u; pg8::order_map(S.nfull + q, S.nM, 4, u); stab[u.pm * 4 + u.pn] = q; }
      __syncthreads(); }
    f32x4 gv[4];
#pragma unroll
    for (int j = 0; j < 4; ++j) gv[j] = ((const f32x4*)F.in[I_FINAL_NORM])[F.lane + 64 * j];
    for (int m0 = gw; m0 < M; m0 += 8 * NGW) {
        int2 sls[8]; float2 tws[8];
#pragma unroll
        for (int k = 0; k < 8; ++k) { const int m = (m0 + k * NGW < M) ? m0 + k * NGW : m0; sls[k] = slot[m]; tws[k] = tw[m]; }
        v2u ya_[2][4], yb_[2][4], hx_[2][4];
#define FR_LOAD(bf, k) do { const int m_ = (m0 + (k) * NGW < M) ? m0 + (k) * NGW : m0; const v2u* xr_ = (const v2u*)(H + (size_t)m_ * D) + F.lane; \
            const v2u* y1p_ = (const v2u*)(ys + (size_t)sls[k].x * D) + F.lane; const v2u* y2p_ = (const v2u*)(ys + (size_t)sls[k].y * D) + F.lane; \
            _Pragma("unroll") for (int j = 0; j < 4; ++j) { ya_[bf][j] = __builtin_nontemporal_load(&y1p_[64 * j]); yb_[bf][j] = __builtin_nontemporal_load(&y2p_[64 * j]); hx_[bf][j] = __builtin_nontemporal_load(&xr_[64 * j]); } } while (0)
        FR_LOAD(0, 0);
#pragma unroll
        for (int k = 0; k < 8; ++k) {
            if (k + 1 < 8) { if (k & 1) FR_LOAD(0, (k + 1 < 8 ? k + 1 : 7)); else FR_LOAD(1, (k + 1 < 8 ? k + 1 : 7)); }
            asm volatile("" ::: "memory");
            const int m = m0 + k * NGW; const int2 sl = sls[k]; const float2 w = tws[k];
            if (m < M) {
                f32x4 v[4]; float s = 0.f; bool side = false;
#pragma unroll
                for (int j = 0; j < 4; ++j) { const v2u a = ya_[k & 1][j], b = yb_[k & 1][j], hx = hx_[k & 1][j];
                    const f32x4 ya = (f32x4){bfl(a.x), bfh(a.x), bfl(a.y), bfh(a.y)}, yb = (f32x4){bfl(b.x), bfh(b.x), bfl(b.y), bfh(b.y)};
                    v[j] = (f32x4){bfl(hx.x), bfh(hx.x), bfl(hx.y), bfh(hx.y)} + w.x * ya + w.y * yb;
                    side = side || (stab[(sl.x >> 8) * 4 + j] >= 0) || (stab[(sl.y >> 8) * 4 + j] >= 0); }
                if (side) {
#pragma unroll
                    for (int j = 0; j < 4; ++j) { const int qa = stab[(sl.x >> 8) * 4 + j], qb = stab[(sl.y >> 8) * 4 + j];
                        if (qa >= 0) { for (int pc = 0; pc < nside; ++pc) { const v2u t = *((const v2u*)(y2 + (size_t)(qa * 3 + pc) * 65536 + (size_t)(sl.x & 255) * 256) + F.lane); v[j] += w.x * (f32x4){bfl(t.x), bfh(t.x), bfl(t.y), bfh(t.y)}; } }
                        if (qb >= 0) { for (int pc = 0; pc < nside; ++pc) { const v2u t = *((const v2u*)(y2 + (size_t)(qb * 3 + pc) * 65536 + (size_t)(sl.y & 255) * 256) + F.lane); v[j] += w.y * (f32x4){bfl(t.x), bfh(t.x), bfl(t.y), bfh(t.y)}; } } } }
#pragma unroll
                for (int j = 0; j < 4; ++j) s += (v[j].x * v[j].x + v[j].y * v[j].y) + (v[j].z * v[j].z + v[j].w * v[j].w);
                const float rstd = 1.0f / sqrtf(wave_sum(s) * (1.0f / D) + EPS);
                f32x4* o = (f32x4*)(F.out + (size_t)m * D) + F.lane;
#pragma unroll
                for (int j = 0; j < 4; ++j) __builtin_nontemporal_store(v[j] * rstd * gv[j], &o[64 * j]);
            }
        }
#undef FR_LOAD
    }
}

constexpr int RTAB_OFF = MISC_OFF + 1024;
__device__ __forceinline__ void build_rstd_tables(const Frame& F, const pg8::StaticOrder& S, const float* ssp) {
    LAS float* rtab = (LAS float*)(F.lds + RTAB_OFF);
    const int r = F.tid & 255, ih = F.tid >> 8;
    f32x4 pa[4][4]; bool ok[4];
#pragma unroll
    for (int k = 0; k < 4; ++k) { pg8::Unit u; ok[k] = S.next(2 * k + ih, u); const int pm = ok[k] ? u.pm : 0;
        const f32x4* p = (const f32x4*)(ssp + (size_t)(pm * 256 + r) * 16);
#pragma unroll
        for (int q = 0; q < 4; ++q) pa[k][q] = p[q]; }
#pragma unroll
    for (int k = 0; k < 4; ++k) if (ok[k]) {
        const float P0 = (pa[k][0][0] + pa[k][0][1]) + (pa[k][0][2] + pa[k][0][3]), P1 = (pa[k][1][0] + pa[k][1][1]) + (pa[k][1][2] + pa[k][1][3]);
        const float P2 = (pa[k][2][0] + pa[k][2][1]) + (pa[k][2][2] + pa[k][2][3]), P3 = (pa[k][3][0] + pa[k][3][1]) + (pa[k][3][2] + pa[k][3][3]);
        rtab[(2 * k + ih) * 256 + r] = __builtin_amdgcn_rsqf(((P0 + P1) + (P2 + P3)) * (1.0f / 1024.0f) + 1e-6f); }
    __syncthreads();
}

#ifndef PHMASK
#define PHMASK 0xFFFFu
#endif
#define EN(b) ((PHMASK >> (b)) & 1u)
#ifndef PROBE_MASK
#define PROBE_MASK 0u
#endif
#define NREP(b) (1 + (int)((PROBE_MASK >> (b)) & 1u))
constexpr int PH_PRO = 0, PH_L = 1, PH_PER_LAYER = 10, PH_FINAL = 21, NPH = 22;
__global__ void __launch_bounds__(NTHR, 2) mk_fwd(Args args) {
    extern __shared__ __attribute__((aligned(16))) unsigned char lds_raw[];
    Frame F;
    F.lds = (LAS unsigned char*)lds_raw;
    F.tid = threadIdx.x; F.lane = F.tid & 63; F.wave = __builtin_amdgcn_readfirstlane(F.tid >> 6);
    F.G = gridDim.x; { const int bx = blockIdx.x; F.vcu = (F.G % 8 == 0) ? (bx % 8) * (F.G / 8) + bx / 8 : bx; }
    F.ws = args.ws; F.ctl = (unsigned*)(args.ws + WS_CTL); F.in = args.in; F.out = args.out;
    volatile LAS unsigned* MISC = (volatile LAS unsigned*)(F.lds + MISC_OFF);
    for (int u = F.tid; u < (LDS_BYTES - MISC_OFF) / 4; u += NTHR) MISC[u] = 0u;
    __syncthreads();
    const int lo = args.ph_lo, hi = args.ph_hi;
    XcdBarrier bar; bar.bar = F.ctl + CW_BAR; bar.x = 0; bar.st = nullptr;
    if (hi - lo > 1) bar = xcd_barrier_post(F.ctl + CW_BAR, MISC + 8);
#define IN(k) (lo <= (k) && (k) < hi)
#define FRESH() do { int tz_ = threadIdx.x; asm volatile("" : "+v"(tz_)); F.tid = tz_; F.lane = tz_ & 63; F.wave = __builtin_amdgcn_readfirstlane(tz_ >> 6); } while (0)
#define SEAM(k) do { if (IN(k) && IN((k) + 1)) xcd_barrier(bar); STAMP(k); } while (0)
#define STAMP(k) tp_stamp(F.lds, (k))
    STAMP(-1);
    unsigned char* ws = args.ws;
    bf16* XN = (bf16*)(ws + WS_XN); bf16* PROJ = (bf16*)(ws + WS_BIG);

    if (EN(0) && IN(PH_PRO)) { FRESH();
        if (F.wave < 4) { cast_rows(F, F.in[I_X], XN, F.vcu * 4 + F.wave, F.G * 4); STAMP(500); }
        else { convert_jobs(F, 0, 1, 39, 40, F.vcu * 4 + F.wave - 4, F.G * 4); ssm_tables(F, F.vcu * 256 + F.tid - 256, F.G * 256); } }
    SEAM(PH_PRO);
    for (int l = 0; l < 2; ++l) {
        const int pb = PH_L + l * PH_PER_LAYER;
        unsigned char* wl = ws + (size_t)l * WS_LSTRIDE;
        F.ycat_off = l ? WS_YCAT1 : WS_YCAT0;
        bf16* YCAT = (bf16*)(ws + F.ycat_off); bf16* MERGED = (bf16*)(ws + (l ? WS_MERGED1 : WS_MERGED0));
        if (EN(1) && IN(pb + 0)) {
            pg8::Gemm g{XN, (const bf16*)(wl + WS_WIN0), M, C_G, D}; pg8::StaticOrder S; S.init(M, C_G, F.G, (int)blockIdx.x);
            FRESH(); build_rstd_tables(F, S, (const float*)(ws + WS_SSP));
            pg8::EpiProj E{PROJ, INC, 1 << 30, (const float*)(ws + WS_SSP), (const LAS float*)(F.lds + RTAB_OFF), 0, 1.f};
            for (int rep = 0; rep < NREP(1); ++rep) pg8::gemm_phase<pg8::EpiProj, pg8::StaticOrder, true, true>(F.lds, g, S, E);
            STAMP(100 + 10 * l);
            const int nfull = S.nwg % F.G;
            if (nfull != 0) { FRESH(); const int widx = ((int)blockIdx.x >= nfull) ? ((int)blockIdx.x - nfull) * NWAVES + F.wave : -1, nw = (F.G - nfull) * NWAVES;
                if (l == 0) convert_jobs(F, 1, 6, 7, 15, widx, nw); else convert_jobs(F, 23, 26, widx, nw);
                const int wall = F.vcu * NWAVES + F.wave, nall = F.G * NWAVES; if (l == 0) convert_jobs(F, 6, 7, 40, 41, wall, nall); else convert_jobs(F, 26, 27, wall, nall); }
            else { FRESH(); const int widx = F.vcu * NWAVES + F.wave, nw = F.G * NWAVES; if (l == 0) convert_jobs(F, 1, 15, 40, 41, widx, nw); else convert_jobs(F, 23, 27, widx, nw); }
            __syncthreads();
            STAMP(101 + 10 * l);
            pg8::Gemm g8{(const bf16*)(ws + WS_HB8), (const bf16*)(wl + WS_WING8), M, INC - C_G, D / 2}; pg8::StaticOrder S8; S8.init(M, INC - C_G, F.G, (int)blockIdx.x);
            FRESH(); build_rstd_tables(F, S8, (const float*)(ws + WS_SSP));
            pg8::EpiProj E8{PROJ, INC, 0, (const float*)(ws + WS_SSP), (const LAS float*)(F.lds + RTAB_OFF), C_G, 1.0f / (SC_XS * SC_W)};
            for (int rep = 0; rep < NREP(1); ++rep) pg8::gemm_phase<pg8::EpiProj, pg8::StaticOrder, true, true, true>(F.lds, g8, S8, E8);
            STAMP(103 + 10 * l);
        }
        SEAM(pb + 0);
        if (EN(2) && IN(pb + 1)) { FRESH(); mixer_b(F, l, NREP(9), NREP(2)); }
        SEAM(pb + 1);
        if (EN(3) && IN(pb + 2)) { FRESH(); for (int rep = 0; rep < NREP(3); ++rep) for (int u = blockIdx.x; u < NCHUNK; u += F.G) ssm_pass2_unit(F, l, u); STAMP(202 + 10 * l); }
        SEAM(pb + 2);
        if (EN(4) && IN(pb + 3)) {
            pg8::Gemm g{YCAT, (const bf16*)(wl + WS_WCAT0), M, D, D}; pg8::StaticOrder S; S.init(M, D, F.G, (int)blockIdx.x);
            pg8::EpiBranch E{PROJ + C_G, INC, MERGED, D};
            for (int rep = 0; rep < NREP(4); ++rep) pg8::gemm_phase<pg8::EpiBranch, pg8::StaticOrder, false, true>(F.lds, g, S, E);
            STAMP(300 + 10 * l);
        }
        SEAM(pb + 3);
        if (EN(5) && IN(pb + 4)) {
            pg8::Gemm g{MERGED, (const bf16*)(wl + WS_WOUT0), M, D, D}; pg8::StaticOrder S; S.init(M, D, F.G, (int)blockIdx.x);
            if (l == 0) { pg8::EpiResid<1, false> E{F.in[I_X], (pg8::bf16_t*)XN, D, (float*)(ws + WS_SSP), nullptr, 1.f, 1.f};
                pg8::gemm_phase<pg8::EpiResid<1, false>, pg8::StaticOrder, false, true>(F.lds, g, S, E); }
            else { for (int rep = 0; rep < NREP(5); ++rep) { pg8::EpiResid<0, true> E{XN, (rep + 1 < NREP(5)) ? (pg8::bf16_t*)PROJ : (pg8::bf16_t*)XN, D, nullptr, nullptr, 1.f, 1.f};
                pg8::gemm_phase<pg8::EpiResid<0, true>, pg8::StaticOrder, false, true>(F.lds, g, S, E); } }
        }
        SEAM(pb + 4);
        if (l == 0) {
            if (EN(7) && IN(pb + 6)) {
                pg8::Gemm g{XN, (const bf16*)(ws + WS_WGU0), M, 2 * FF, D}; pg8::StaticOrder S; S.init(M, 2 * FF, F.G, (int)blockIdx.x);
                FRESH(); build_rstd_tables(F, S, (const float*)(ws + WS_SSP));
                pg8::EpiSwiglu<true, true> E{PROJ, FF, 2 * FF / 256, (const float*)(ws + WS_SSP), (const LAS float*)(F.lds + RTAB_OFF), SC_ACT};
                for (int rep = 0; rep < NREP(7); ++rep) pg8::gemm_phase<pg8::EpiSwiglu<true, true>, pg8::StaticOrder, true, true>(F.lds, g, S, E);
            }
            SEAM(pb + 6);
            if (EN(8) && IN(pb + 7)) {
                pg8::Gemm g{PROJ, (const bf16*)(ws + WS_WD0), M, D, FF / 2}; pg8::StaticOrder S; S.init(M, D, F.G, (int)blockIdx.x);
                pg8::EpiResid<3, true> E{XN, (pg8::bf16_t*)XN, D, (float*)(ws + WS_SSP), ws + WS_HB8, SC_XS, 1.0f / (SC_ACT * SC_W)};
                pg8::gemm_phase<pg8::EpiResid<3, true>, pg8::StaticOrder, false, true, true>(F.lds, g, S, E);
            }
            SEAM(pb + 7);
        } else {
            if (EN(10) && IN(pb + 5)) { FRESH(); router_fill(F);
                if (F.wave < 3) norm_rows<true>(F, XN, F.in[I_NORM_FFN] + D, (bf16*)(ws + WS_XNN), F.vcu * 3 + F.wave, F.G * 3);
                else convert_jobs(F, 15, 23, 27, 39, F.vcu * 5 + F.wave - 3, F.G * 5);
                STAMP(400); }
            SEAM(pb + 5);
            if (EN(11) && IN(pb + 6)) { FRESH(); for (int rep = 0; rep < NREP(11); ++rep) moe_gather(F); }
            SEAM(pb + 6);
            if (EN(12) && IN(pb + 7)) {
                pg8::Gemm g{(const bf16*)(ws + WS_XS), (const bf16*)(ws + WS_WMOE), MPAD, 2 * FF, D / 2}; MoeOrder<false> S; S.init(F.ctl + CW_MOECNT, 2 * FF / 256, F.G, (int)blockIdx.x, D / 128);
                pg8::EpiSwiglu8 E{ws + WS_ACTM, FF, 2 * FF / 256, -1.4426950408889634f / (SC_XS * SC_W), (SC_XS * SC_W) * (SC_XS * SC_W) / SC_ACT};
                for (int rep = 0; rep < NREP(12); ++rep) pg8::gemm_phase<pg8::EpiSwiglu8, MoeOrder<false>, true, true, true>(F.lds, g, S, E);
            }
            if (IN(pb + 7) && IN(pb + 9)) xcd_barrier(bar);
            STAMP(pb + 7);
            if (EN(14) && IN(pb + 9)) {
                pg8::Gemm g{(const bf16*)(ws + WS_ACTM), (const bf16*)(ws + WS_WD8), MPAD, D, FF / 2}; MoeOrder<true> S; S.init(F.ctl + CW_MOECNT, D / 256, F.G, (int)blockIdx.x, FF / 128);
                pg8::EpiMoeDown E{(bf16*)(ws + WS_YS), D, D / 256, (bf16*)(ws + WS_Y2), 1.0f / (SC_ACT * SC_W)};
                for (int rep = 0; rep < NREP(14); ++rep) pg8::gemm_phase<pg8::EpiMoeDown, MoeOrder<true>, false, true, true>(F.lds, g, S, E);
            }
            SEAM(pb + 9);
        }
    }
    if (EN(15) && IN(PH_FINAL)) { FRESH(); for (int rep = 0; rep < NREP(15); ++rep) final_rows(F); }
    STAMP(PH_FINAL);
    if (TP_A != -2 && blockIdx.x == 0 && threadIdx.x == 0) { const long long tend = wall_clock64(), hold = (*(volatile LAS long long*)(F.lds + 140296) - *(volatile LAS long long*)(F.lds + 140288)) * TP_MUL; while (wall_clock64() - tend < hold) __builtin_amdgcn_s_sleep(32); }
#undef IN
#undef SEAM
}

extern "C" void kernel_launch(void* const* d_in, const int* in_sizes, int n_in, void* d_out, int out_size, void* d_ws, size_t ws_size, hipStream_t stream) {
    static int grid = 0;
    if (grid == 0) {
        if (n_in != 26 || in_sizes[0] != M * D || out_size != M * D || ws_size < WS_END) { fprintf(stderr, "kernel_launch: unexpected shapes (n_in %d, in0 %d, out %d, ws %zu < %zu); nothing launched\n", n_in, n_in > 0 ? in_sizes[0] : -1, out_size, ws_size, (size_t)WS_END); grid = -1; return; }
        int dev = 0, cus = 0;
        if (hipGetDevice(&dev) != hipSuccess || hipDeviceGetAttribute(&cus, hipDeviceAttributeMultiprocessorCount, dev) != hipSuccess) { fprintf(stderr, "kernel_launch: device query failed\n"); grid = -1; return; }
        if (hipFuncSetAttribute((const void*)mk_fwd, hipFuncAttributeMaxDynamicSharedMemorySize, LDS_BYTES) != hipSuccess) { fprintf(stderr, "kernel_launch: hipFuncSetAttribute failed\n"); grid = -1; return; }
        int per_cu = 0;
        if (hipOccupancyMaxActiveBlocksPerMultiprocessor(&per_cu, (const void*)mk_fwd, NTHR, LDS_BYTES) != hipSuccess || per_cu < 1) fprintf(stderr, "kernel_launch: occupancy query reports %d blocks per CU\n", per_cu);
        (void)hipGetLastError();
        grid = cus;
    }
    if (grid < 0) return;
    if (hipMemsetAsync((char*)d_ws + WS_CTL, 0, CTL_ZERO_BYTES, stream) != hipSuccess) { fprintf(stderr, "kernel_launch: memset failed\n"); return; }
    Args a{};
    for (int i = 0; i < 26; ++i) a.in[i] = (const float*)d_in[i];
    a.out = (float*)d_out; a.ws = (unsigned char*)d_ws;
#if MK_ONE_LAUNCH
    a.ph_lo = 0; a.ph_hi = NPH;
    hipLaunchKernelGGL(mk_fwd, dim3(grid), dim3(NTHR), LDS_BYTES, stream, a);
#else
    for (int ph = 0; ph < NPH; ++ph) {
        if (ph == PH_L + 9) continue;
        a.ph_lo = ph; a.ph_hi = ph + 1;
        hipLaunchKernelGGL(mk_fwd, dim3(grid), dim3(NTHR), LDS_BYTES, stream, a);
    }
#endif
    const hipError_t le = hipPeekAtLastError();
    if (le != hipSuccess) fprintf(stderr, "kernel_launch: launch failed: %s\n", hipGetErrorName(le));
}
```
